# Optimizing an MI355X kernel written in HIP

```python
import math
import jax
import jax.numpy as jnp
from jax import lax
import numpy as np

D_MODEL = 1024
BATCH = 8
SEQ = 4096
DEPTH = 2

CHUNK = 64
Q_BLOCK = 128
D_MIX = D_MODEL
D_FF = 2816
CONV_K = 4
EPS = 1e-6
ROPE_THETA = 10000.0

GDN_HEADS = 4
GDN_DK = 64
GDN_DV = 64
GDN_QK_W = GDN_HEADS * GDN_DK
GDN_W = GDN_HEADS * GDN_DV

DIFF_HEADS = 4
DIFF_DH = 32
DIFF_DV = 2 * DIFF_DH
DIFF_QK_W = 2 * DIFF_HEADS * DIFF_DH
DIFF_W = DIFF_HEADS * DIFF_DV

SSD_HEADS = 4
SSD_P = 64
SSD_N = 128
SSD_G = 2
SSD_W = SSD_HEADS * SSD_P

MLSTM_HEADS = 4
MLSTM_DH = 64
MLSTM_W = MLSTM_HEADS * MLSTM_DH

IN_SPLITS = (GDN_QK_W, GDN_QK_W, GDN_W, GDN_W, GDN_HEADS, GDN_HEADS,
             DIFF_QK_W, DIFF_QK_W, DIFF_W,
             SSD_W, SSD_W + 2 * SSD_G * SSD_N, SSD_HEADS,
             MLSTM_W, MLSTM_W, MLSTM_W, MLSTM_W, MLSTM_HEADS, MLSTM_HEADS)
IN_COLS = sum(IN_SPLITS)

kernel_name = 'hybrid_parallel_head_group_encoder'


def rmsnorm(x, g):
    xf = x.astype(jnp.float32)
    y = xf * lax.rsqrt(jnp.mean(xf * xf, axis=-1, keepdims=True) + EPS)
    return (y * g.astype(jnp.float32)).astype(x.dtype)


def l2norm(t):
    return t * lax.rsqrt(jnp.sum(t * t, axis=-1, keepdims=True) + EPS)


def swiglu(h, w_gate, w_up, w_down):
    return (jax.nn.silu(h @ w_gate) * (h @ w_up)) @ w_down


def causal_dwconv(u, w):
    ch = u.shape[-1]
    return lax.conv_general_dilated(u, w.astype(u.dtype)[:, None, :], window_strides=(1,),
                                    padding=[(CONV_K - 1, 0)],
                                    dimension_numbers=('NWC', 'WIO', 'NWC'),
                                    feature_group_count=ch)


def causal_tril():
    return jnp.tril(jnp.ones((CHUNK, CHUNK), dtype=bool))


def masked_decay(cum):
    diff = cum[..., :, None] - cum[..., None, :]
    return jnp.exp(jnp.where(causal_tril(), diff, -jnp.inf))


def heads_to_chunks(t):
    b, s = t.shape[:2]
    t = t.reshape((b, s // CHUNK, CHUNK) + t.shape[2:])
    perm = (1, 0, 3, 2) + tuple(range(4, t.ndim))
    return t.transpose(perm)


def chunks_to_heads(t):
    n, b, h, c, d = t.shape
    return t.transpose(1, 0, 3, 2, 4).reshape(b, n * c, h, d)


def rope_tables(seq, dim):
    inv_freq = ROPE_THETA ** (-jnp.arange(0, dim, 2, dtype=jnp.float32) / dim)
    ang = jnp.arange(seq, dtype=jnp.float32)[:, None] * inv_freq[None, :]
    return jnp.cos(ang), jnp.sin(ang)


def apply_rope(t, cos, sin):
    half = t.shape[-1] // 2
    t1, t2 = t[..., :half], t[..., half:]
    c, s = cos[None, :, None, :], sin[None, :, None, :]
    return jnp.concatenate([t1 * c - t2 * s, t2 * c + t1 * s], axis=-1)


def gated_deltanet(q, k, v, gate, beta_raw, a_raw, conv_w, a_log, dt_bias, norm_g):
    bsz, seq, _ = q.shape
    qkv = jax.nn.silu(causal_dwconv(jnp.concatenate([q, k, v], axis=-1), conv_w))
    q, k, v = jnp.split(qkv, [GDN_QK_W, 2 * GDN_QK_W], axis=-1)
    q = l2norm(q.reshape(bsz, seq, GDN_HEADS, GDN_DK)) * (GDN_DK ** -0.5)
    k = l2norm(k.reshape(bsz, seq, GDN_HEADS, GDN_DK))
    v = v.reshape(bsz, seq, GDN_HEADS, GDN_DV)
    beta = jax.nn.sigmoid(beta_raw)
    g = -jnp.exp(a_log) * jax.nn.softplus(a_raw + dt_bias)
    qc, kc, vc = heads_to_chunks(q), heads_to_chunks(k), heads_to_chunks(v)
    gc = jnp.cumsum(heads_to_chunks(g), axis=-1)
    bc = heads_to_chunks(beta)[..., None]
    decay = masked_decay(gc)
    eye = jnp.eye(CHUNK, dtype=jnp.float32)
    kb = kc * bc
    lower = jnp.einsum('nbhcd,nbhmd->nbhcm', kb, kc) * decay * (1.0 - eye)
    t_mat = lax.linalg.triangular_solve(eye + lower, jnp.broadcast_to(eye, lower.shape),
                                        left_side=True, lower=True, unit_diagonal=True)
    u = t_mat @ (vc * bc)
    w = t_mat @ (kb * jnp.exp(gc)[..., None])
    attn = jnp.einsum('nbhcd,nbhmd->nbhcm', qc, kc) * decay
    q_dec = qc * jnp.exp(gc)[..., None]
    k_dec = kc * jnp.exp(gc[..., -1:] - gc)[..., None]
    g_last = jnp.exp(gc[..., -1])

    def step(state, inp):
        q_i, k_i, u_i, w_i, a_i, gl_i = inp
        v_new = u_i - w_i @ state
        o_i = q_i @ state + a_i @ v_new
        state = state * gl_i[..., None, None] + jnp.einsum('bhcd,bhce->bhde', k_i, v_new)
        return state, o_i

    s0 = jnp.zeros((bsz, GDN_HEADS, GDN_DK, GDN_DV), jnp.float32)
    _, o = lax.scan(step, s0, (q_dec, k_dec, u, w, attn, g_last))
    o = chunks_to_heads(o)
    o = rmsnorm(o, norm_g) * jax.nn.silu(gate.reshape(bsz, seq, GDN_HEADS, GDN_DV))
    return o.reshape(bsz, seq, GDN_W)


def diff_attention(q, k, v, lam_q1, lam_k1, lam_q2, lam_k2, norm_g, lambda_init, cos, sin):
    bsz, seq, _ = q.shape
    q = apply_rope(q.reshape(bsz, seq, 2 * DIFF_HEADS, DIFF_DH), cos, sin)
    k = apply_rope(k.reshape(bsz, seq, 2 * DIFF_HEADS, DIFF_DH), cos, sin)
    v = v.reshape(bsz, seq, DIFF_HEADS, DIFF_DV)
    lam = (jnp.exp(jnp.sum(lam_q1 * lam_k1)) - jnp.exp(jnp.sum(lam_q2 * lam_k2))
           + lambda_init).astype(jnp.float32)
    nb = seq // Q_BLOCK
    qb = q.reshape(bsz, nb, Q_BLOCK, 2 * DIFF_HEADS, DIFF_DH).transpose(1, 0, 3, 2, 4) * (DIFF_DH ** -0.5)
    kt = k.transpose(0, 2, 1, 3)
    vt = v.transpose(0, 2, 1, 3)
    key_chunk = jnp.arange(seq) // CHUNK

    def block(args):
        q_blk, blk = args
        scores = jnp.einsum('bhqd,bhkd->bhqk', q_blk, kt)
        q_chunk = (blk * Q_BLOCK + jnp.arange(Q_BLOCK)) // CHUNK
        allowed = key_chunk[None, :] <= q_chunk[:, None]
        p = jax.nn.softmax(jnp.where(allowed, scores, -jnp.inf), axis=-1)
        p = p.reshape(bsz, DIFF_HEADS, 2, Q_BLOCK, seq)
        return jnp.einsum('bhqk,bhkd->bhqd', p[:, :, 0] - lam * p[:, :, 1], vt)

    o = lax.map(block, (qb, jnp.arange(nb)))
    o = o.transpose(1, 0, 3, 2, 4).reshape(bsz, seq, DIFF_HEADS, DIFF_DV)
    o = rmsnorm(o, norm_g) * (1.0 - lambda_init)
    return o.reshape(bsz, seq, DIFF_W)


def ssd_mixer(z, xbc, dt_raw, conv_w, conv_b, a_log, dt_bias, d_skip, norm_g):
    bsz, seq, _ = z.shape
    xbc = jax.nn.silu(causal_dwconv(xbc, conv_w) + conv_b)
    xs, bm, cm = jnp.split(xbc, [SSD_W, SSD_W + SSD_G * SSD_N], axis=-1)
    x = xs.reshape(bsz, seq, SSD_HEADS, SSD_P)
    rep = SSD_HEADS // SSD_G
    bm = jnp.repeat(bm.reshape(bsz, seq, SSD_G, SSD_N), rep, axis=2)
    cm = jnp.repeat(cm.reshape(bsz, seq, SSD_G, SSD_N), rep, axis=2)
    dt = jax.nn.softplus(dt_raw + dt_bias)
    da = dt * (-jnp.exp(a_log))
    nch = seq // CHUNK
    xc = (x * dt[..., None]).reshape(bsz, nch, CHUNK, SSD_HEADS, SSD_P)
    bc = bm.reshape(bsz, nch, CHUNK, SSD_HEADS, SSD_N)
    cc = cm.reshape(bsz, nch, CHUNK, SSD_HEADS, SSD_N)
    acs = jnp.cumsum(da.reshape(bsz, nch, CHUNK, SSD_HEADS).transpose(0, 3, 1, 2), axis=-1)
    l_mat = masked_decay(acs)
    y_diag = jnp.einsum('bclhn,bcmhn,bhclm,bcmhp->bclhp', cc, bc, l_mat, xc)
    decay_states = jnp.exp(acs[..., -1:] - acs)
    states = jnp.einsum('bclhn,bhcl,bclhp->bchpn', bc, decay_states, xc)

    def step(st, inp):
        s_c, d_c = inp
        return st * d_c[..., None, None] + s_c, st

    s0 = jnp.zeros((bsz, SSD_HEADS, SSD_P, SSD_N), jnp.float32)
    _, prev = lax.scan(step, s0, (states.transpose(1, 0, 2, 3, 4),
                                  jnp.exp(acs[..., -1]).transpose(2, 0, 1)))
    prev = prev.transpose(1, 0, 2, 3, 4)
    y_off = jnp.einsum('bclhn,bchpn,bhcl->bclhp', cc, prev, jnp.exp(acs))
    y = (y_diag + y_off).reshape(bsz, seq, SSD_HEADS, SSD_P) + x * d_skip[:, None]
    y = y.reshape(bsz, seq, SSD_W) * jax.nn.silu(z)
    gw = SSD_W // SSD_G
    y = rmsnorm(y.reshape(bsz, seq, SSD_G, gw), norm_g.reshape(SSD_G, gw))
    return y.reshape(bsz, seq, SSD_W)


def mlstm(q, k, v, o_raw, i_raw, f_raw, i_bias, f_bias, norm_g):
    bsz, seq, _ = q.shape
    shp = (bsz, seq, MLSTM_HEADS, MLSTM_DH)
    qc = heads_to_chunks(q.reshape(shp))
    kc = heads_to_chunks(k.reshape(shp) * (MLSTM_DH ** -0.5))
    vc = heads_to_chunks(v.reshape(shp))
    li = heads_to_chunks(i_raw + i_bias)
    lf = heads_to_chunks(jax.nn.log_sigmoid(f_raw + f_bias))
    b = jnp.cumsum(lf, axis=-1)
    d_log = jnp.where(causal_tril(), b[..., :, None] - b[..., None, :] + li[..., None, :], -jnp.inf)
    d_max = jnp.max(d_log, axis=-1)
    qk = jnp.einsum('nbhcd,nbhmd->nbhcm', qc, kc)
    g_end = b[..., -1:] - b + li

    def step(carry, inp):
        c_st, n_st, m_st = carry
        q_i, k_i, v_i, b_i, dl_i, dm_i, qk_i, ge_i = inp
        m_t = jnp.maximum(b_i + m_st[..., None], dm_i)
        w_st = jnp.exp(b_i + m_st[..., None] - m_t)
        s_i = qk_i * jnp.exp(dl_i - m_t[..., None])
        num = w_st[..., None] * (q_i @ c_st) + s_i @ v_i
        den = w_st * jnp.einsum('bhcd,bhd->bhc', q_i, n_st) + jnp.sum(s_i, axis=-1)
        h_i = num / jnp.maximum(jnp.abs(den), jnp.exp(-m_t))[..., None]
        m_new = jnp.maximum(b_i[..., -1] + m_st, jnp.max(ge_i, axis=-1))
        w_old = jnp.exp(b_i[..., -1] + m_st - m_new)
        k_w = k_i * jnp.exp(ge_i - m_new[..., None])[..., None]
        c_st = c_st * w_old[..., None, None] + jnp.einsum('bhcd,bhce->bhde', k_w, v_i)
        n_st = n_st * w_old[..., None] + jnp.sum(k_w, axis=-2)
        return (c_st, n_st, m_new), h_i

    init = (jnp.zeros((bsz, MLSTM_HEADS, MLSTM_DH, MLSTM_DH), jnp.float32),
            jnp.zeros((bsz, MLSTM_HEADS, MLSTM_DH), jnp.float32),
            jnp.zeros((bsz, MLSTM_HEADS), jnp.float32))
    _, h = lax.scan(step, init, (qc, kc, vc, b, d_log, d_max, qk, g_end))
    h = chunks_to_heads(h) * jax.nn.sigmoid(o_raw.reshape(shp))
    h = rmsnorm(h, norm_g.reshape(MLSTM_HEADS, MLSTM_DH))
    return h.reshape(bsz, seq, MLSTM_W)


def hybrid_mixer(h, w_in, w_out, gdn_conv_w, gdn_a_log, gdn_dt_bias, gdn_norm_g,
                 diff_lam_q1, diff_lam_k1, diff_lam_q2, diff_lam_k2, diff_norm_g,
                 ssd_conv_w, ssd_conv_b, ssd_a_log, ssd_dt_bias, ssd_d, ssd_norm_g,
                 mlstm_i_bias, mlstm_f_bias, mlstm_norm_g, lambda_init, cos, sin):
    proj = (h @ w_in).astype(jnp.float32)
    points = np.cumsum(np.array(IN_SPLITS))[:-1].tolist()
    (a_q, a_k, a_v, a_g, a_beta, a_a,
     b_q, b_k, b_v,
     c_z, c_xbc, c_dt,
     d_q, d_k, d_v, d_o, d_i, d_f) = jnp.split(proj, points, axis=-1)
    out_a = gated_deltanet(a_q, a_k, a_v, a_g, a_beta, a_a, gdn_conv_w, gdn_a_log, gdn_dt_bias, gdn_norm_g)
    out_b = diff_attention(b_q, b_k, b_v, diff_lam_q1, diff_lam_k1, diff_lam_q2, diff_lam_k2,
                           diff_norm_g, lambda_init, cos, sin)
    out_c = ssd_mixer(c_z, c_xbc, c_dt, ssd_conv_w, ssd_conv_b, ssd_a_log, ssd_dt_bias, ssd_d, ssd_norm_g)
    out_d = mlstm(d_q, d_k, d_v, d_o, d_i, d_f, mlstm_i_bias, mlstm_f_bias, mlstm_norm_g)
    mixed = jnp.concatenate([out_a, out_b, out_c, out_d], axis=-1)
    return mixed.astype(h.dtype) @ w_out


def setup_inputs(seed: int = 0) -> dict:
    key = jax.random.key(seed)
    keys = list(jax.random.split(key, 48))
    f32 = jnp.float32
    L = DEPTH

    def nxt():
        return keys.pop()

    def normal(shape, scale):
        return jax.random.normal(nxt(), shape, f32) * scale

    def gain(n):
        return 1.0 + normal((L, n), 0.02)

    def a_log_init(n):
        return jnp.log(jax.random.uniform(nxt(), (L, n), f32, 1.0, 16.0))

    def dt_bias_init(n):
        dt = jnp.exp(jax.random.uniform(nxt(), (L, n), f32, math.log(1e-3), math.log(1e-1)))
        return dt + jnp.log(-jnp.expm1(-dt))

    xbc_w = SSD_W + 2 * SSD_G * SSD_N
    return {
        'x': normal((BATCH, SEQ, D_MODEL), 1.0),
        'ffn1_pre_g': gain(D_MODEL),
        'ffn1_w_gate': normal((L, D_MODEL, D_FF), D_MODEL ** -0.5),
        'ffn1_w_up': normal((L, D_MODEL, D_FF), D_MODEL ** -0.5),
        'ffn1_w_down': normal((L, D_FF, D_MODEL), D_FF ** -0.5),
        'ffn1_post_g': gain(D_MODEL),
        'mix_pre_g': gain(D_MODEL),
        'w_in': normal((L, D_MODEL, IN_COLS), D_MODEL ** -0.5),
        'gdn_conv_w': normal((L, CONV_K, 2 * GDN_QK_W + GDN_W), CONV_K ** -0.5),
        'gdn_a_log': a_log_init(GDN_HEADS),
        'gdn_dt_bias': dt_bias_init(GDN_HEADS),
        'gdn_norm_g': gain(GDN_DV),
        'diff_lam_q1': normal((L, DIFF_DH), 0.1),
        'diff_lam_k1': normal((L, DIFF_DH), 0.1),
        'diff_lam_q2': normal((L, DIFF_DH), 0.1),
        'diff_lam_k2': normal((L, DIFF_DH), 0.1),
        'diff_norm_g': gain(DIFF_DV),
        'ssd_conv_w': normal((L, CONV_K, xbc_w), CONV_K ** -0.5),
        'ssd_conv_b': normal((L, xbc_w), 0.02),
        'ssd_a_log': a_log_init(SSD_HEADS),
        'ssd_dt_bias': dt_bias_init(SSD_HEADS),
        'ssd_d': 1.0 + normal((L, SSD_HEADS), 0.1),
        'ssd_norm_g': gain(SSD_W),
        'mlstm_i_bias': normal((L, MLSTM_HEADS), 0.1),
        'mlstm_f_bias': jnp.linspace(3.0, 6.0, MLSTM_HEADS, dtype=f32)[None, :] + normal((L, MLSTM_HEADS), 0.1),
        'mlstm_norm_g': gain(MLSTM_W),
        'w_out': normal((L, D_MIX, D_MODEL), D_MIX ** -0.5),
        'mix_post_g': gain(D_MODEL),
        'ffn2_pre_g': gain(D_MODEL),
        'ffn2_w_gate': normal((L, D_MODEL, D_FF), D_MODEL ** -0.5),
        'ffn2_w_up': normal((L, D_MODEL, D_FF), D_MODEL ** -0.5),
        'ffn2_w_down': normal((L, D_FF, D_MODEL), D_FF ** -0.5),
        'ffn2_post_g': gain(D_MODEL),
    }


def reference(x, ffn1_pre_g, ffn1_w_gate, ffn1_w_up, ffn1_w_down, ffn1_post_g,
              mix_pre_g, w_in,
              gdn_conv_w, gdn_a_log, gdn_dt_bias, gdn_norm_g,
              diff_lam_q1, diff_lam_k1, diff_lam_q2, diff_lam_k2, diff_norm_g,
              ssd_conv_w, ssd_conv_b, ssd_a_log, ssd_dt_bias, ssd_d, ssd_norm_g,
              mlstm_i_bias, mlstm_f_bias, mlstm_norm_g,
              w_out, mix_post_g,
              ffn2_pre_g, ffn2_w_gate, ffn2_w_up, ffn2_w_down, ffn2_post_g):
    cos, sin = rope_tables(x.shape[1], DIFF_DH)
    for l in range(DEPTH):
        lambda_init = 0.8 - 0.6 * math.exp(-0.3 * l)
        h = rmsnorm(x, ffn1_pre_g[l])
        x = x + 0.5 * rmsnorm(swiglu(h, ffn1_w_gate[l], ffn1_w_up[l], ffn1_w_down[l]), ffn1_post_g[l])
        h = rmsnorm(x, mix_pre_g[l])
        m = hybrid_mixer(h, w_in[l], w_out[l],
                         gdn_conv_w[l], gdn_a_log[l], gdn_dt_bias[l], gdn_norm_g[l],
                         diff_lam_q1[l], diff_lam_k1[l], diff_lam_q2[l], diff_lam_k2[l], diff_norm_g[l],
                         ssd_conv_w[l], ssd_conv_b[l], ssd_a_log[l], ssd_dt_bias[l], ssd_d[l], ssd_norm_g[l],
                         mlstm_i_bias[l], mlstm_f_bias[l], mlstm_norm_g[l],
                         lambda_init, cos, sin)
        x = x + rmsnorm(m, mix_post_g[l])
        h = rmsnorm(x, ffn2_pre_g[l])
        x = x + 0.5 * rmsnorm(swiglu(h, ffn2_w_gate[l], ffn2_w_up[l], ffn2_w_down[l]), ffn2_post_g[l])
    return x
```

```cpp
#include <hip/hip_runtime.h>
#include <cstdio>
#include <cstdint>
#ifndef MK_N_LAUNCHES
#define MK_N_LAUNCHES 1
#endif
namespace pg8 {
#define PG8_LAS __attribute__((address_space(3)))
typedef unsigned short bf16_t;
typedef short bf16x8 __attribute__((ext_vector_type(8)));
typedef float f32x4 __attribute__((ext_vector_type(4)));
typedef unsigned u32x4 __attribute__((ext_vector_type(4)));
constexpr int BM = 256, BK = 64, HALF = 128, HTB = HALF * BK * 2  , STAGE_BYTES = 8 * HTB, NXCD = 8, WGM = 8;

__host__ __device__ __forceinline__ int lds_byte(int r, int c) { const int st = (r >> 4) * 2 + (c >> 5), rr = r & 15, cc = c & 31, ob = rr * 64 + cc * 2; return st * 1024 + (ob ^ (((ob >> 9) & 1) << 5)); }
__host__ __device__ __forceinline__ void stage_rc(int b, int& R, int& C) { const int st = b / 1024, sb = b % 1024, swz = sb ^ (((sb >> 9) & 1) << 5); R = (st >> 1) * 16 + swz / 64; C = (st & 1) * 32 + (swz % 64) / 2; }
__host__ __device__ __forceinline__ int perm32(int rho) { const int n = rho >> 4, i = rho & 15; return 8 * (i >> 2) + 4 * n + (i & 3); }

struct Unit { int pm, pn; };
struct Gemm { const bf16_t* A; const bf16_t* Bt; int M, N, K; };

struct StaticOrder {
    int nM, nN, nwg, G, c;
    __host__ __device__ void init(int M, int N, int G_, int c_) { nM = M / BM; nN = N / BM; nwg = nM * nN; G = G_; c = c_; }
    __host__ __device__ bool next(int i, Unit& u) const {
        const long L = (long)i * G + c; if (L >= nwg) return false;
        int wgid = (int)L; { const int q = nwg / NXCD, r = nwg % NXCD, xcd = wgid % NXCD, off = wgid / NXCD; wgid = (xcd < r ? xcd * (q + 1) : r * (q + 1) + (xcd - r) * q) + off; }
        const int nig = WGM * nN, gid = wgid / nig, fm = gid * WGM, gsz = (nM - fm) < WGM ? (nM - fm) : WGM;
        u.pm = fm + ((wgid % nig) % gsz); u.pn = (wgid % nig) / gsz; return true;
    }
    __device__ __forceinline__ void a_ready(const Unit&) const {}
    __device__ __forceinline__ void done(const Unit&) const {}
};

__device__ __forceinline__ unsigned cvt_pk_bf16(float lo, float hi) { unsigned r; asm volatile("v_cvt_pk_bf16_f32 %0, %1, %2" : "=v"(r) : "v"(lo), "v"(hi)); return r; }
typedef float f32x2 __attribute__((ext_vector_type(2)));
__device__ __forceinline__ f32x2 gelu_pk(f32x2 v) {
    const f32x2 av = __builtin_elementwise_abs(v), d = av * 0.2316418882f + 1.0f;
    f32x2 t; t.x = __builtin_amdgcn_rcpf(d.x); t.y = __builtin_amdgcn_rcpf(d.y);
    f32x2 q = t * 0.5307027145f + (-0.7265760135f); q = q * t + 0.7107068705f; q = q * t + (-0.142248368f); q = q * t + 0.127414796f; q = q * t;
    const f32x2 s = (v * v) * (-0.72134752044f);
    f32x2 e; e.x = __builtin_amdgcn_exp2f(s.x); e.y = __builtin_amdgcn_exp2f(s.y);
    const f32x2 m = v * (q * e), r = v - m;
    f32x2 o; o.x = v.x < 0.f ? m.x : r.x; o.y = v.y < 0.f ? m.y : r.y; return o;
}

template <int ACT  > struct EpiBf16 {
    static constexpr bool PERM = true, AFTER_DRAIN = false; static_assert(ACT == 0 || ACT == 1, "EpiBf16: ACT is 0 (none) or 1 (gelu_pk)");
    bf16_t* O; int ldc; const float* bias; int split_cols; size_t split_stride; float scale0;
    __device__ __forceinline__ void operator()(const f32x4 (&acc)[2][2][4][2], const Unit& u, int wr, int wc, int fr, int fq) const {
        const int row0 = u.pm * BM + wr * 64 + fr; int colt = u.pn * BM; bf16_t* base = O;
        float sc = 1.f; if (split_cols) { const int t = colt / split_cols; base += (size_t)t * split_stride; colt -= t * split_cols; if (t == 0) sc = scale0; }
        const int col0 = colt + wc * 32 + 8 * fq, bcol0 = u.pn * BM + wc * 32 + 8 * fq;
        f32x4 bv[2][2];
#pragma unroll
        for (int bj = 0; bj < 2; ++bj)
#pragma unroll
            for (int n = 0; n < 2; ++n) bv[bj][n] = bias ? *(const f32x4*)(bias + bcol0 + bj * HALF + 4 * n) : (f32x4){0.f, 0.f, 0.f, 0.f};
#pragma unroll
        for (int ai = 0; ai < 2; ++ai)
#pragma unroll
            for (int m = 0; m < 4; ++m) { bf16_t* rowp = base + (size_t)(row0 + ai * HALF + m * 16) * ldc + col0;
#pragma unroll
                for (int bj = 0; bj < 2; ++bj) { f32x4 v0 = acc[ai][bj][m][0] + bv[bj][0], v1 = acc[ai][bj][m][1] + bv[bj][1];
                    if (ACT == 1) { f32x2 a = gelu_pk((f32x2){v0[0], v0[1]}), b = gelu_pk((f32x2){v0[2], v0[3]}), c = gelu_pk((f32x2){v1[0], v1[1]}), d = gelu_pk((f32x2){v1[2], v1[3]});
                        v0 = (f32x4){a.x, a.y, b.x, b.y}; v1 = (f32x4){c.x, c.y, d.x, d.y}; }
                    v0 = v0 * sc; v1 = v1 * sc; u32x4 w; w.x = cvt_pk_bf16(v0[0], v0[1]); w.y = cvt_pk_bf16(v0[2], v0[3]); w.z = cvt_pk_bf16(v1[0], v1[1]); w.w = cvt_pk_bf16(v1[2], v1[3]);
                    *(u32x4*)(rowp + bj * HALF) = w; } }
    }
};

struct EpiSwiglu {
    static constexpr bool PERM = true, AFTER_DRAIN = false;
    bf16_t* O; int ldc;
    __device__ __forceinline__ void operator()(const f32x4 (&acc)[2][2][4][2], const Unit& u, int wr, int wc, int fr, int fq) const {
        const int row0 = u.pm * BM + wr * 64 + fr; const int col0 = u.pn * 128 + wc * 32 + 8 * fq;
#pragma unroll
        for (int ai = 0; ai < 2; ++ai)
#pragma unroll
            for (int m = 0; m < 4; ++m) { bf16_t* rowp = O + (size_t)(row0 + ai * HALF + m * 16) * ldc + col0;
                float h[8];
#pragma unroll
                for (int n = 0; n < 2; ++n)
#pragma unroll
                    for (int i = 0; i < 4; ++i) { const float g = acc[ai][0][m][n][i], up = acc[ai][1][m][n][i];
                        h[n * 4 + i] = g * __builtin_amdgcn_rcpf(1.0f + __expf(-g)) * up; }
                u32x4 w; w.x = cvt_pk_bf16(h[0], h[1]); w.y = cvt_pk_bf16(h[2], h[3]); w.z = cvt_pk_bf16(h[4], h[5]); w.w = cvt_pk_bf16(h[6], h[7]);
                *(u32x4*)rowp = w; }
    }
};
struct EpiProj {
    static constexpr bool PERM = true, AFTER_DRAIN = false;
    bf16_t* P; float* SM;
    __device__ __forceinline__ void operator()(const f32x4 (&acc)[2][2][4][2], const Unit& u, int wr, int wc, int fr, int fq) const {
        const int row0 = u.pm * BM + wr * 64 + fr;
        if (u.pn < 15) {
            const int col0 = u.pn * BM + wc * 32 + 8 * fq;
#pragma unroll
            for (int ai = 0; ai < 2; ++ai)
#pragma unroll
                for (int m = 0; m < 4; ++m) { bf16_t* rowp = P + (size_t)(row0 + ai * HALF + m * 16) * 3840 + col0;
#pragma unroll
                    for (int bj = 0; bj < 2; ++bj) { const f32x4 v0 = acc[ai][bj][m][0], v1 = acc[ai][bj][m][1];
                        u32x4 w; w.x = cvt_pk_bf16(v0[0], v0[1]); w.y = cvt_pk_bf16(v0[2], v0[3]); w.z = cvt_pk_bf16(v1[0], v1[1]); w.w = cvt_pk_bf16(v1[2], v1[3]);
                        *(u32x4*)(rowp + bj * HALF) = w; } }
        } else if (wc == 0) {
#pragma unroll
            for (int ai = 0; ai < 2; ++ai)
#pragma unroll
                for (int m = 0; m < 4; ++m) { float* rowp = SM + (size_t)(row0 + ai * HALF + m * 16) * 32 + 8 * fq;
                    *(f32x4*)rowp = acc[ai][0][m][0]; *(f32x4*)(rowp + 4) = acc[ai][0][m][1]; }
        }
    }
};
template <class Epi, class Sched, bool ALIGN_EPI = false, bool SP2 = false>
__device__ __forceinline__ void gemm_phase(PG8_LAS unsigned char* lds, const Gemm g, const Sched& S, const Epi& E) {
    const int tid = threadIdx.x, wid = __builtin_amdgcn_readfirstlane(tid >> 6), lane = tid & 63, wr = wid >> 2, wc = wid & 3, fr = lane & 15, fq = lane >> 4;
    const int K = g.K, nt = K / BK;
    unsigned voffA[2], voffB[2];
#pragma unroll
    for (int i = 0; i < 2; ++i) { int R, C; stage_rc(tid * 16 + i * 8192, R, C); const int Rb = Epi::PERM ? ((R & ~31) + perm32(R & 31)) : R;
        voffA[i] = (unsigned)(R * K + C) * 2u; voffB[i] = (unsigned)(Rb * K + C) * 2u; }
    const size_t kstep = (size_t)(BK * 2);
    const size_t hstep = (size_t)HALF * K * 2;
    const size_t tstep = 2 * hstep;
    const unsigned ldsw = (unsigned)wid * 1024u;
    const int aoff = lds_byte(wr * 64 + fr, fq * 8), boff = lds_byte(wc * 32 + fr, fq * 8);
#define PG8_SA(b, h) (((b) * 2 + (h)) * HTB)
#define PG8_SB(b, h) ((4 + (b) * 2 + (h)) * HTB)
#define PG8_STAGE(bufoff, gbase, voff) do { _Pragma("unroll") for (int _i = 0; _i < 2; ++_i) \
        __builtin_amdgcn_global_load_lds((const unsigned*)((const char*)(gbase) + (voff)[_i]), (PG8_LAS unsigned*)(lds + (bufoff) + ldsw + _i * 8192), 16, 0, 0); } while (0)
#define PG8_LDA(dst, b, h) do { _Pragma("unroll") for (int m = 0; m < 4; ++m) _Pragma("unroll") for (int k = 0; k < 2; ++k) dst[m][k] = *(const PG8_LAS bf16x8*)(lds + PG8_SA(b, h) + aoff + m * 2048 + k * 1024); } while (0)
#define PG8_LDB(dst, b, h) do { _Pragma("unroll") for (int n = 0; n < 2; ++n) _Pragma("unroll") for (int k = 0; k < 2; ++k) dst[n][k] = *(const PG8_LAS bf16x8*)(lds + PG8_SB(b, h) + boff + n * 2048 + k * 1024); } while (0)
#define PG8_MMA(ai, bj, At, Bt) do { __builtin_amdgcn_s_setprio(1); _Pragma("unroll") for (int m = 0; m < 4; ++m) _Pragma("unroll") for (int n = 0; n < 2; ++n) _Pragma("unroll") for (int k = 0; k < 2; ++k) \
        acc[ai][bj][m][n] = __builtin_amdgcn_mfma_f32_16x16x32_bf16(Bt[n][k], At[m][k], acc[ai][bj][m][n], 0, 0, 0); __builtin_amdgcn_s_setprio(0); } while (0)
#define PG8_WAIT_V(n) asm volatile("s_waitcnt vmcnt(" #n ")" ::: "memory")
#define PG8_WAIT_L(n) asm volatile("s_waitcnt lgkmcnt(" #n ")" ::: "memory")
#define PG8_BAR __builtin_amdgcn_s_barrier()
#define PG8_SCHED __builtin_amdgcn_sched_barrier(0)
    Unit cur, nxt; int ui = 0;
    if (!S.next(0, cur)) return;
    f32x4 acc[2][2][4][2];
#pragma unroll
    for (int a = 0; a < 2; ++a)
#pragma unroll
        for (int b = 0; b < 2; ++b)
#pragma unroll
            for (int m = 0; m < 4; ++m)
#pragma unroll
                for (int n = 0; n < 2; ++n) acc[a][b][m][n] = (f32x4){0.f, 0.f, 0.f, 0.f};
    bf16x8 At[4][2], B0[2][2], B1[2][2];
    const char* cA = (const char*)g.A + (size_t)cur.pm * tstep; const char* cB = (const char*)g.Bt + (size_t)cur.pn * tstep;
    S.a_ready(cur);
    if constexpr (SP2) {
        PG8_STAGE(PG8_SB(0, 0), cB, voffB); PG8_STAGE(PG8_SB(0, 1), cB + hstep, voffB); PG8_STAGE(PG8_SA(0, 0), cA, voffA); PG8_STAGE(PG8_SA(0, 1), cA + hstep, voffA);
        if (wr == 1) PG8_BAR;
        PG8_WAIT_V(2); PG8_BAR;
        PG8_STAGE(PG8_SB(1, 0), cB + kstep, voffB); PG8_STAGE(PG8_SA(1, 0), cA + kstep, voffA); PG8_STAGE(PG8_SB(1, 1), cB + hstep + kstep, voffB);
        PG8_WAIT_V(6); PG8_BAR;
    } else {
        PG8_STAGE(PG8_SB(0, 0), cB, voffB); PG8_STAGE(PG8_SA(0, 0), cA, voffA); PG8_STAGE(PG8_SB(0, 1), cB + hstep, voffB); PG8_STAGE(PG8_SA(0, 1), cA + hstep, voffA);
        if (wr == 1) PG8_BAR;
        PG8_WAIT_V(4); PG8_BAR;
        PG8_STAGE(PG8_SB(1, 0), cB + kstep, voffB); PG8_STAGE(PG8_SA(1, 0), cA + kstep, voffA); PG8_STAGE(PG8_SB(1, 1), cB + hstep + kstep, voffB);
        PG8_WAIT_V(6); PG8_BAR;
    }
    for (;;) {
        const bool has_next = S.next(ui + 1, nxt);
        const char* nA = has_next ? (const char*)g.A + (size_t)nxt.pm * tstep : cA; const char* nB = has_next ? (const char*)g.Bt + (size_t)nxt.pn * tstep : cB;
        for (int t = 0; t < nt; t += 2) {
            const bool last = (t == nt - 2);
            const char* a1 = cA + (size_t)(t + 1) * kstep;
            const char* a2 = last ? nA : cA + (size_t)(t + 2) * kstep; const char* b2 = last ? nB : cB + (size_t)(t + 2) * kstep;
            const char* a3 = a2 + kstep; const char* b3 = b2 + kstep;
            if (last && has_next) S.a_ready(nxt);
            if constexpr (SP2) {
            PG8_LDB(B0, 0, 0); PG8_LDB(B1, 0, 1); PG8_SCHED; PG8_LDA(At, 0, 0); PG8_STAGE(PG8_SA(1, 1), a1 + hstep, voffA);
            PG8_WAIT_V(8); PG8_WAIT_L(0); PG8_BAR; PG8_MMA(0, 0, At, B0); PG8_MMA(0, 1, At, B1); PG8_BAR; PG8_SCHED;
            PG8_LDA(At, 0, 1); PG8_STAGE(PG8_SB(0, 0), b2, voffB); PG8_STAGE(PG8_SB(0, 1), b2 + hstep, voffB); PG8_STAGE(PG8_SA(0, 0), a2, voffA);
            PG8_WAIT_V(8); PG8_WAIT_L(0); PG8_BAR; PG8_MMA(1, 0, At, B0); PG8_MMA(1, 1, At, B1); PG8_BAR; PG8_SCHED;
            PG8_LDB(B0, 1, 0); PG8_LDB(B1, 1, 1); PG8_SCHED; PG8_LDA(At, 1, 0); PG8_STAGE(PG8_SA(0, 1), a2 + hstep, voffA);
            PG8_WAIT_V(8); PG8_WAIT_L(0); PG8_BAR; PG8_MMA(0, 0, At, B0); PG8_MMA(0, 1, At, B1); PG8_BAR; PG8_SCHED;
            PG8_LDA(At, 1, 1); PG8_STAGE(PG8_SB(1, 0), b3, voffB); PG8_STAGE(PG8_SB(1, 1), b3 + hstep, voffB); PG8_STAGE(PG8_SA(1, 0), a3, voffA);
            PG8_WAIT_V(8); PG8_WAIT_L(0); PG8_BAR; PG8_MMA(1, 0, At, B0); PG8_MMA(1, 1, At, B1); PG8_BAR; PG8_SCHED;
            } else {
            PG8_LDB(B0, 0, 0); PG8_SCHED; PG8_LDA(At, 0, 0); PG8_STAGE(PG8_SA(1, 1), a1 + hstep, voffA);
            PG8_WAIT_L(8); PG8_BAR; PG8_WAIT_L(0); PG8_MMA(0, 0, At, B0); PG8_BAR; PG8_SCHED;
            PG8_LDB(B1, 0, 1); PG8_STAGE(PG8_SB(0, 0), b2, voffB);
            PG8_BAR; PG8_WAIT_L(0); PG8_MMA(0, 1, At, B1); PG8_BAR;
            PG8_LDA(At, 0, 1); PG8_STAGE(PG8_SA(0, 0), a2, voffA);
            PG8_BAR; PG8_WAIT_L(0); PG8_MMA(1, 0, At, B0); PG8_BAR; PG8_SCHED;
            PG8_STAGE(PG8_SB(0, 1), b2 + hstep, voffB);
            PG8_WAIT_V(6); PG8_BAR; PG8_MMA(1, 1, At, B1); PG8_BAR;
            PG8_LDB(B0, 1, 0); PG8_SCHED; PG8_LDA(At, 1, 0); PG8_STAGE(PG8_SA(0, 1), a2 + hstep, voffA);
            PG8_WAIT_L(8); PG8_BAR; PG8_WAIT_L(0); PG8_MMA(0, 0, At, B0); PG8_BAR; PG8_SCHED;
            PG8_LDB(B1, 1, 1); PG8_STAGE(PG8_SB(1, 0), b3, voffB);
            PG8_BAR; PG8_WAIT_L(0); PG8_MMA(0, 1, At, B1); PG8_BAR;
            PG8_LDA(At, 1, 1); PG8_STAGE(PG8_SA(1, 0), a3, voffA);
            PG8_BAR; PG8_WAIT_L(0); PG8_MMA(1, 0, At, B0); PG8_BAR; PG8_SCHED;
            PG8_STAGE(PG8_SB(1, 1), b3 + hstep, voffB);
            PG8_WAIT_V(6); PG8_BAR; PG8_MMA(1, 1, At, B1); PG8_BAR;
            }
        }
        if constexpr (ALIGN_EPI) { if (wr == 0) PG8_BAR; }
        if constexpr (!Epi::AFTER_DRAIN) { E(acc, cur, wr, wc, fr, fq); S.done(cur); }
        if (!has_next) break;
#pragma unroll
        for (int a = 0; a < 2; ++a)
#pragma unroll
            for (int b = 0; b < 2; ++b)
#pragma unroll
                for (int m = 0; m < 4; ++m)
#pragma unroll
                    for (int n = 0; n < 2; ++n) acc[a][b][m][n] = (f32x4){0.f, 0.f, 0.f, 0.f};
        cur = nxt; cA = nA; cB = nB; ++ui;
        if constexpr (ALIGN_EPI) { if (wr == 1) PG8_BAR; }
    }
    PG8_WAIT_V(0);
    if constexpr (!ALIGN_EPI) { if (wr == 0) PG8_BAR; }
    PG8_BAR;
    if constexpr (Epi::AFTER_DRAIN) { E.fused(acc, cur, wr, wc, fr, fq, lds, wid, lane); S.done(cur); }
#undef PG8_SA
#undef PG8_SB
#undef PG8_STAGE
#undef PG8_LDA
#undef PG8_LDB
#undef PG8_MMA
#undef PG8_WAIT_V
#undef PG8_WAIT_L
#undef PG8_BAR
#undef PG8_SCHED
}
}
#ifndef PG8_SP2
#define PG8_SP2 true
#endif
#ifndef PG8_ALIGN
#define PG8_ALIGN true
#endif
constexpr int N_LAUNCHES = MK_N_LAUNCHES;
constexpr int NWAVES = 8;
constexpr int BATCH = 8, SEQ = 4096, D = 1024, FF = 2816, NLAYER = 2;
constexpr int M = BATCH * SEQ;
constexpr int INC = 3860;
constexpr int PP = 3840;
constexpr int A_Q = 0, A_K = 256, A_V = 512, A_G = 768, B_Q = 1024, B_K = 1280, B_V = 1536, C_Z = 1792, C_XBC = 2048, D_Q = 2816, D_K = 3072, D_V = 3328, D_O = 3584;
constexpr int SM_BETA = 0, SM_A = 4, SM_DT = 8, SM_I = 12, SM_F = 16;
constexpr float EPS = 1e-6f;
enum { I_X = 0, I_F1PRE, I_F1G, I_F1U, I_F1D, I_F1POST, I_MIXPRE, I_WIN, I_GCONV, I_GALOG, I_GDTB, I_GNORM, I_LQ1, I_LK1, I_LQ2, I_LK2, I_DNORM,
       I_SCONVW, I_SCONVB, I_SALOG, I_SDTB, I_SD, I_SNORM, I_MIB, I_MFB, I_MNORM, I_WOUT, I_MIXPOST, I_F2PRE, I_F2G, I_F2U, I_F2D, I_F2POST, N_IN };
constexpr size_t MiB = 1u << 20;
constexpr size_t WS_CTL = 0, CTL_ZERO_BYTES = 1 * MiB;
constexpr size_t WS_ROPE = 1 * MiB;
constexpr size_t WS_W = 2 * MiB;
constexpr size_t W_GU = (size_t)2 * FF * D * 2, W_DN = (size_t)D * FF * 2, W_IN = (size_t)4096 * D * 2, W_OUT = (size_t)D * D * 2;
constexpr size_t WL_GU1 = 0, WL_D1 = WL_GU1 + W_GU, WL_IN = WL_D1 + W_DN, WL_OUT = WL_IN + W_IN, WL_GU2 = WL_OUT + W_OUT, WL_D2 = WL_GU2 + W_GU, W_LAYER = WL_D2 + W_DN;
static_assert(W_LAYER == 43 * MiB, "weights per layer");
constexpr size_t WS_XN = 88 * MiB;
constexpr size_t WS_Y = 152 * MiB;
constexpr size_t WS_P = 216 * MiB;
constexpr size_t WS_SM = 456 * MiB;
constexpr size_t WS_END = 460 * MiB;
static_assert(WS_W + 2 * W_LAYER <= WS_XN && WS_P + (size_t)M * PP * 2 <= WS_SM, "d_ws map");
constexpr int CW_TMO = 0, CW_CODE = 1, CW_BAR = 4096;
constexpr int RING_OFF = 0, RING_BYTES = 131072;
constexpr int LDSCTL_OFF = RING_BYTES, MISC_OFF = LDSCTL_OFF + 320;
constexpr int LDS_BYTES = 147456;
#define GAS __attribute__((address_space(1)))
#define LAS __attribute__((address_space(3)))
typedef unsigned short bf16;
typedef unsigned v4u __attribute__((ext_vector_type(4)));
typedef unsigned v2u __attribute__((ext_vector_type(2)));
typedef float f32x4 __attribute__((ext_vector_type(4)));
typedef float f32x16 __attribute__((ext_vector_type(16)));
typedef short bf16x8 __attribute__((ext_vector_type(8)));
typedef short s16x4 __attribute__((ext_vector_type(4)));
typedef GAS unsigned gu32;
#define RLX_AGENT __ATOMIC_RELAXED, __HIP_MEMORY_SCOPE_AGENT
#define LDS_WAIT() asm volatile("s_waitcnt lgkmcnt(0)" ::: "memory")
#define VM_WAIT() asm volatile("s_waitcnt vmcnt(0)" ::: "memory")
__device__ __forceinline__ unsigned f2bf(float f) { unsigned u = __builtin_bit_cast(unsigned, f); return (u + 0x7fffu + ((u >> 16) & 1u)) >> 16; }
__device__ __forceinline__ unsigned pk2(float lo, float hi) { return f2bf(lo) | (f2bf(hi) << 16); }
__device__ __forceinline__ float bf2f(unsigned v) { return __builtin_bit_cast(float, v << 16); }
__device__ __forceinline__ float silu_f(float x) { return x / (1.0f + __expf(-x)); }
__device__ __forceinline__ float sigmoid_f(float x) { return 1.0f / (1.0f + __expf(-x)); }
__device__ __forceinline__ float softplus_f(float x) { return x > 20.f ? x : log1pf(__expf(x)); }
__device__ __forceinline__ float wave_sum(float v) {
#pragma unroll
    for (int o = 1; o < 64; o <<= 1) v += __shfl_xor(v, o);
    return v;
}
#define XB_TMO      128
#define XB_XCNT(j)  (256  + 64 * (j))
#define XB_XSUB(j)  (1280 + 64 * (j))
#define XB_XGEN(j)  (2304 + 64 * (j))
#define XB_TOP      3328
#define XB_TOPGEN   3392
#define XCD_BAR_WORDS 3456
#define XB_SPIN_CAP (1u << 18)

__device__ __forceinline__ unsigned xb_ld(unsigned* p)              { return __hip_atomic_load(p, __ATOMIC_RELAXED, __HIP_MEMORY_SCOPE_AGENT); }
__device__ __forceinline__ unsigned xb_add(unsigned* p, unsigned v) { return __hip_atomic_fetch_add(p, v, __ATOMIC_RELAXED, __HIP_MEMORY_SCOPE_AGENT); }
__device__ __forceinline__ unsigned xb_xcc_id() { return (unsigned)__builtin_amdgcn_s_getreg((3 << 11) | 20) & 0xFu; }
#define XB_SPIN(cond, bar) do { unsigned _sp = 0; while (cond) { __builtin_amdgcn_s_sleep(1); \
    if ((++_sp & 255u) == 0u) { if (xb_ld(&(bar)[XB_TMO])) break; if (_sp > XB_SPIN_CAP) { atomicAdd(&(bar)[XB_TMO], 1u); break; } } } } while (0)

struct XcdBarrier {
    unsigned* bar; unsigned x;
    volatile LAS unsigned* st;
};

__device__ __forceinline__ XcdBarrier xcd_barrier_post(unsigned* bar, volatile LAS unsigned* st) {
    XcdBarrier b; b.bar = bar; b.x = xb_xcc_id(); b.st = st;
    if (threadIdx.x == 0) (void)xb_add(&bar[XB_XCNT(b.x)], 1u);
    return b;
}
__device__ __forceinline__ void xcd_barrier_complete(unsigned* bar, unsigned x, unsigned& nloc, unsigned& nx) {
    const unsigned G = gridDim.x * gridDim.y * gridDim.z;
    unsigned sum, cnt, mine, sp = 0u;
    for (;;) {
        sum = 0u; cnt = 0u; mine = 0u;
#pragma unroll
        for (unsigned j = 0; j < 16; ++j) { const unsigned c = xb_ld(&bar[XB_XCNT(j)]); sum += c; cnt += (c > 0u) ? 1u : 0u; mine = (j == x) ? c : mine; }
        if (sum == G) break;
        __builtin_amdgcn_s_sleep(1);
        if ((++sp & 255u) == 0u) { if (xb_ld(&bar[XB_TMO])) break; if (sp > XB_SPIN_CAP) { atomicAdd(&bar[XB_TMO], 1u); break; } }
    }
    nloc = mine > 0u ? mine : 1u; nx = cnt > 0u ? cnt : 1u;
}

__device__ __forceinline__ void xcd_barrier(const XcdBarrier& b) {
    asm volatile("s_waitcnt vmcnt(0)" ::: "memory");
    __syncthreads();
    if (threadIdx.x == 0) {
        unsigned* bar = b.bar;
        __builtin_amdgcn_s_waitcnt(0);
        unsigned nloc = b.st[0], nx = b.st[1];
        if (nloc == 0u) { xcd_barrier_complete(bar, b.x, nloc, nx); b.st[0] = nloc; b.st[1] = nx; }
        const unsigned old = xb_add(&bar[XB_XSUB(b.x)], 1u);
        const unsigned gen = old / nloc;
        if (old + 1u == (gen + 1u) * nloc) {
            __builtin_amdgcn_fence(__ATOMIC_RELEASE, "agent");
            asm volatile("s_waitcnt vmcnt(0)" ::: "memory");
            const unsigned og = xb_add(&bar[XB_TOP], 1u);
            const unsigned tg = og / nx;
            if (og + 1u == (tg + 1u) * nx) xb_add(&bar[XB_TOPGEN], 1u);
            else XB_SPIN(xb_ld(&bar[XB_TOPGEN]) == tg, bar);
            __builtin_amdgcn_fence(__ATOMIC_ACQUIRE, "agent");
            xb_add(&bar[XB_XGEN(b.x)], 1u);
            asm volatile("s_waitcnt vmcnt(0)" ::: "memory");
        } else {
            XB_SPIN(xb_ld(&bar[XB_XGEN(b.x)]) == gen, bar);
            __builtin_amdgcn_fence(__ATOMIC_ACQUIRE, "agent");
            asm volatile("s_waitcnt vmcnt(0)" ::: "memory");
        }
    }
    __syncthreads();
}
struct Frame {
    unsigned char* lds;
    volatile LAS unsigned* MISC;
    gu32* ctl;
    int tid, lane, wave;
    int vcu, G;
    const float* const* in;
    float* out; unsigned char* ws;
};
__device__ const double ROPE_INVF[16] = {1.0, 0.5623413251903491, 0.31622776601683794, 0.1778279410038923, 0.1, 0.05623413251903491, 0.03162277660168379, 0.01778279410038923,
    0.01, 0.005623413251903491, 0.0031622776601683794, 0.0017782794100389228, 0.001, 0.0005623413251903491, 0.00031622776601683794, 0.00017782794100389227};

template <int MODE> __device__ __forceinline__ int rowmap(int n) {
    if (MODE == 0) return n;
    if (MODE == 1) return (n >> 7) * 256 + (n & 127);
    if (MODE == 2) return (n >> 7) * 256 + 128 + (n & 127);
    if (n < 1024) return n;
    if (n < 1032) return 3840 + (n - 1024);
    if (n < 2824) return n - 8;
    if (n < 2828) return 3848 + (n - 2824);
    if (n < 3852) return n - 12;
    return n;
}
template <int MODE> __device__ __forceinline__ void p0_transpose_item(const float* W, int K, int N, bf16* WT, float* scr, int item, int lane) {
    const int nblk = (N + 31) / 32, kb = item / nblk, nb = item % nblk, k0 = 64 * kb, n0 = 32 * nb;
    const int nn = n0 + (lane & 31);
#pragma unroll 8
    for (int i = 0; i < 32; ++i) { const int kk = 2 * i + (lane >> 5); scr[kk * 33 + (lane & 31)] = nn < N ? W[(size_t)(k0 + kk) * N + nn] : 0.f; }
    LDS_WAIT(); asm volatile("" ::: "memory");
    const int c = lane & 7;
#pragma unroll
    for (int j = 0; j < 4; ++j) { const int n = (lane >> 3) + 8 * j; const float* s = scr + (8 * c) * 33 + n;
        v4u o; o.x = pk2(s[0 * 33], s[1 * 33]); o.y = pk2(s[2 * 33], s[3 * 33]); o.z = pk2(s[4 * 33], s[5 * 33]); o.w = pk2(s[6 * 33], s[7 * 33]);
        if (n0 + n < N) *(v4u*)(WT + (size_t)rowmap<MODE>(n0 + n) * K + k0 + 8 * c) = o; }
    LDS_WAIT(); asm volatile("" ::: "memory");
}
__device__ __forceinline__ void p0_prologue(Frame& F) {
    float* scr = (float*)(F.lds + RING_OFF + F.wave * 16384);
    const int gw = F.vcu * NWAVES + F.wave, NGW = F.G * NWAVES;
    constexpr int I_GATE = (D / 64) * (FF / 32), I_DOWN = (FF / 64) * (D / 32), I_IN = (D / 64) * ((INC + 31) / 32), I_OUT = (D / 64) * (D / 32);
    constexpr int PER_LAYER = 4 * I_GATE + 2 * I_DOWN + I_IN + I_OUT;
    for (int it = gw; it < NLAYER * PER_LAYER; it += NGW) {
        const int l = it / PER_LAYER; int r = it % PER_LAYER;
        unsigned char* wl = F.ws + WS_W + (size_t)l * W_LAYER;
        if (r < I_GATE) { p0_transpose_item<1>(F.in[I_F1G] + (size_t)l * D * FF, D, FF, (bf16*)(wl + WL_GU1), scr, r, F.lane); continue; } r -= I_GATE;
        if (r < I_GATE) { p0_transpose_item<2>(F.in[I_F1U] + (size_t)l * D * FF, D, FF, (bf16*)(wl + WL_GU1), scr, r, F.lane); continue; } r -= I_GATE;
        if (r < I_DOWN) { p0_transpose_item<0>(F.in[I_F1D] + (size_t)l * D * FF, FF, D, (bf16*)(wl + WL_D1), scr, r, F.lane); continue; } r -= I_DOWN;
        if (r < I_IN)   { p0_transpose_item<3>(F.in[I_WIN] + (size_t)l * D * INC, D, INC, (bf16*)(wl + WL_IN), scr, r, F.lane); continue; } r -= I_IN;
        if (r < I_OUT)  { p0_transpose_item<0>(F.in[I_WOUT] + (size_t)l * D * D, D, D, (bf16*)(wl + WL_OUT), scr, r, F.lane); continue; } r -= I_OUT;
        if (r < I_GATE) { p0_transpose_item<1>(F.in[I_F2G] + (size_t)l * D * FF, D, FF, (bf16*)(wl + WL_GU2), scr, r, F.lane); continue; } r -= I_GATE;
        if (r < I_GATE) { p0_transpose_item<2>(F.in[I_F2U] + (size_t)l * D * FF, D, FF, (bf16*)(wl + WL_GU2), scr, r, F.lane); continue; } r -= I_GATE;
        p0_transpose_item<0>(F.in[I_F2D] + (size_t)l * D * FF, FF, D, (bf16*)(wl + WL_D2), scr, r, F.lane);
    }
    const int gt = F.vcu * NWAVES * 64 + F.tid, NGT = F.G * NWAVES * 64;
    for (int i = gt; i < NLAYER * 236 * 128; i += NGT) { const int l = i / (236 * 128), r = i % (236 * 128);
        *(v4u*)(F.ws + WS_W + (size_t)l * W_LAYER + WL_IN + (size_t)INC * D * 2 + (size_t)r * 16) = (v4u){0u, 0u, 0u, 0u}; }
    float* ct = (float*)(F.ws + WS_ROPE); float* st = ct + SEQ * 16;
    for (int i = gt; i < SEQ * 16; i += NGT) { const int pos = i >> 4, f = i & 15;
        const double rev = (double)pos * ROPE_INVF[f] * 0.15915494309189535; const float fr = (float)(rev - __builtin_floor(rev));
        ct[i] = __builtin_amdgcn_cosf(fr); st[i] = __builtin_amdgcn_sinf(fr); }
}
__device__ __forceinline__ void post_rows(Frame& F, const float* xsrc, const bf16* Y, float coef, const float* g_post, float* xdst, const float* g_pre, bf16* XN, bool has_y, bool write_x, bool write_xn) {
    const int gw = F.vcu * NWAVES + F.wave, NGW = F.G * NWAVES;
    f32x4 gp[4], gn[4];
#pragma unroll
    for (int j = 0; j < 4; ++j) { gp[j] = has_y ? *(const f32x4*)(g_post + 4 * F.lane + 256 * j) : (f32x4){0.f, 0.f, 0.f, 0.f}; gn[j] = write_xn ? *(const f32x4*)(g_pre + 4 * F.lane + 256 * j) : (f32x4){0.f, 0.f, 0.f, 0.f}; }
    for (int m = gw; m < M; m += NGW) {
        f32x4 v[4];
#pragma unroll
        for (int j = 0; j < 4; ++j) v[j] = *(const f32x4*)(xsrc + (size_t)m * D + 4 * F.lane + 256 * j);
        if (has_y) {
            f32x4 y[4]; float s = 0.f;
#pragma unroll
            for (int j = 0; j < 4; ++j) { const v2u w = *(const v2u*)(Y + (size_t)m * D + 4 * F.lane + 256 * j);
                y[j] = (f32x4){bf2f(w.x & 0xffffu), bf2f(w.x >> 16), bf2f(w.y & 0xffffu), bf2f(w.y >> 16)};
                s += (y[j].x * y[j].x + y[j].y * y[j].y) + (y[j].z * y[j].z + y[j].w * y[j].w); }
            const float r = coef / sqrtf(wave_sum(s) * (1.f / D) + EPS);
#pragma unroll
            for (int j = 0; j < 4; ++j) v[j] = v[j] + y[j] * gp[j] * r;
        }
        if (write_x) {
#pragma unroll
            for (int j = 0; j < 4; ++j) *(f32x4*)(xdst + (size_t)m * D + 4 * F.lane + 256 * j) = v[j];
        }
        if (write_xn) {
            float s2 = 0.f;
#pragma unroll
            for (int j = 0; j < 4; ++j) s2 += (v[j].x * v[j].x + v[j].y * v[j].y) + (v[j].z * v[j].z + v[j].w * v[j].w);
            const float r2 = 1.f / sqrtf(wave_sum(s2) * (1.f / D) + EPS);
#pragma unroll
            for (int j = 0; j < 4; ++j) { const f32x4 o = v[j] * gn[j] * r2; v2u w; w.x = pk2(o.x, o.y); w.y = pk2(o.z, o.w);
                *(v2u*)(XN + (size_t)m * D + 4 * F.lane + 256 * j) = w; }
        }
    }
}
__device__ __forceinline__ void rope_phase(Frame& F, bf16* P) {
    const float* ct = (const float*)(F.ws + WS_ROPE); const float* st = ct + SEQ * 16;
    const int gt = F.vcu * NWAVES * 64 + F.tid, NGT = F.G * NWAVES * 64;
    for (int it = gt; it < M * 16; it += NGT) {
        const int row = it >> 4, hd = it & 15, pos = row & (SEQ - 1);
        bf16* p = P + (size_t)row * PP + B_Q + 32 * hd;
        const float sc = hd < 8 ? 0.17677669529663687f * 1.4426950408889634f : 1.0f;
        v4u a0 = *(v4u*)p, a1 = *(v4u*)(p + 8), b0 = *(v4u*)(p + 16), b1 = *(v4u*)(p + 24);
        unsigned t1[8] = {a0.x, a0.y, a0.z, a0.w, a1.x, a1.y, a1.z, a1.w}, t2[8] = {b0.x, b0.y, b0.z, b0.w, b1.x, b1.y, b1.z, b1.w};
        unsigned o1[8], o2[8];
#pragma unroll
        for (int i = 0; i < 8; ++i) {
            const float c0 = ct[pos * 16 + 2 * i], c1 = ct[pos * 16 + 2 * i + 1], s0 = st[pos * 16 + 2 * i], s1 = st[pos * 16 + 2 * i + 1];
            const float x0 = bf2f(t1[i] & 0xffffu), x1 = bf2f(t1[i] >> 16), y0 = bf2f(t2[i] & 0xffffu), y1 = bf2f(t2[i] >> 16);
            o1[i] = pk2((x0 * c0 - y0 * s0) * sc, (x1 * c1 - y1 * s1) * sc);
            o2[i] = pk2((y0 * c0 + x0 * s0) * sc, (y1 * c1 + x1 * s1) * sc);
        }
        *(v4u*)p = (v4u){o1[0], o1[1], o1[2], o1[3]}; *(v4u*)(p + 8) = (v4u){o1[4], o1[5], o1[6], o1[7]};
        *(v4u*)(p + 16) = (v4u){o2[0], o2[1], o2[2], o2[3]}; *(v4u*)(p + 24) = (v4u){o2[4], o2[5], o2[6], o2[7]};
    }
}
constexpr int TS = 16;
__device__ __forceinline__ void gdn_seq_wave(Frame& F, const bf16* P, const float* SM, bf16* MIX, int l, int b, int h, float* wl  ) {
    const int c = F.lane;
    const float* cw = F.in[I_GCONV] + (size_t)l * 4 * 768;
    float wq[4], wk[4], wv[4];
#pragma unroll
    for (int j = 0; j < 4; ++j) { wq[j] = cw[j * 768 + 64 * h + c]; wk[j] = cw[j * 768 + 256 + 64 * h + c]; wv[j] = cw[j * 768 + 512 + 64 * h + c]; }
    const float Aneg = -expf(F.in[I_GALOG][l * 4 + h]), dtb = F.in[I_GDTB][l * 4 + h], ng = F.in[I_GNORM][l * 64 + c];
    float* qs = wl; float* ks = wl + TS * 64; float* vs = wl + 2 * TS * 64; float* gs = wl + 3 * TS * 64; float* bl = (float*)(F.lds + LDSCTL_OFF + 1024 + F.wave * 128); float* dl = bl + TS;
    float q1 = 0.f, q2 = 0.f, q3 = 0.f, k1 = 0.f, k2 = 0.f, k3 = 0.f, v1 = 0.f, v2 = 0.f, v3 = 0.f;
    float S[64];
#pragma unroll
    for (int i = 0; i < 64; ++i) S[i] = 0.f;
#pragma unroll 1
    for (int sc = 0; sc < SEQ / TS; ++sc) {
        const int row0 = b * SEQ + sc * TS;
#pragma unroll 2
        for (int t = 0; t < TS; ++t) {
            const bf16* p = P + (size_t)(row0 + t) * PP + 64 * h + c;
            const float rq = bf2f(p[A_Q]), rk = bf2f(p[A_K]), rv = bf2f(p[A_V]), rg = bf2f(p[A_G]);
            const float cq = silu_f(wq[0] * q3 + wq[1] * q2 + wq[2] * q1 + wq[3] * rq); q3 = q2; q2 = q1; q1 = rq;
            const float ck = silu_f(wk[0] * k3 + wk[1] * k2 + wk[2] * k1 + wk[3] * rk); k3 = k2; k2 = k1; k1 = rk;
            const float cv = silu_f(wv[0] * v3 + wv[1] * v2 + wv[2] * v1 + wv[3] * rv); v3 = v2; v2 = v1; v1 = rv;
            const float sq = wave_sum(cq * cq), sk = wave_sum(ck * ck);
            qs[t * 64 + c] = cq * (0.125f / sqrtf(sq + EPS)); ks[t * 64 + c] = ck / sqrtf(sk + EPS); vs[t * 64 + c] = cv; gs[t * 64 + c] = silu_f(rg);
        }
        if (c < TS) { const float* sm = SM + (size_t)(row0 + c) * 32;
            bl[c] = sigmoid_f(sm[SM_BETA + h]); dl[c] = expf(Aneg * softplus_f(sm[SM_A + h] + dtb)); }
        LDS_WAIT(); asm volatile("" ::: "memory");
#pragma unroll 1
        for (int t = 0; t < TS; ++t) {
            const float dec = dl[t], beta = bl[t];
            const f32x4* k4 = (const f32x4*)(ks + t * 64); const f32x4* q4 = (const f32x4*)(qs + t * 64);
            float kS = 0.f;
#pragma unroll
            for (int i = 0; i < 16; ++i) { const f32x4 kk = k4[i];
                S[4 * i] *= dec; S[4 * i + 1] *= dec; S[4 * i + 2] *= dec; S[4 * i + 3] *= dec;
                kS += kk.x * S[4 * i] + kk.y * S[4 * i + 1] + kk.z * S[4 * i + 2] + kk.w * S[4 * i + 3];
                if ((i & 3) == 3) asm volatile("" : "+v"(kS) :: "memory"); }
            const float vn = beta * (vs[t * 64 + c] - kS);
            float o = 0.f;
#pragma unroll
            for (int i = 0; i < 16; ++i) { const f32x4 kk = k4[i], qq = q4[i];
                S[4 * i] += kk.x * vn; S[4 * i + 1] += kk.y * vn; S[4 * i + 2] += kk.z * vn; S[4 * i + 3] += kk.w * vn;
                o += qq.x * S[4 * i] + qq.y * S[4 * i + 1] + qq.z * S[4 * i + 2] + qq.w * S[4 * i + 3];
                if ((i & 3) == 3) asm volatile("" : "+v"(o) :: "memory"); }
            const float ss = wave_sum(o * o);
            const float outv = o / sqrtf(ss * (1.f / 64.f) + EPS) * ng * gs[t * 64 + c];
            MIX[(size_t)(row0 + t) * D + 64 * h + c] = (bf16)f2bf(outv);
        }
        LDS_WAIT(); asm volatile("" ::: "memory");
    }
}
__device__ __forceinline__ void mlstm_seq_wave(Frame& F, const bf16* P, const float* SM, bf16* MIX, int l, int b, int h, float* wl  ) {
    const int c = F.lane;
    const float ib = F.in[I_MIB][l * 4 + h], fb = F.in[I_MFB][l * 4 + h], ng = F.in[I_MNORM][l * 256 + 64 * h + c];
    float* qs = wl; float* ks = wl + TS * 64; unsigned* vo = (unsigned*)(wl + 2 * TS * 64); float* lil = wl + 3 * TS * 64; float* lfl = lil + TS;
    float C[64], n[64]; float m = 0.f;
#pragma unroll
    for (int i = 0; i < 64; ++i) { C[i] = 0.f; n[i] = 0.f; }
#pragma unroll 1
    for (int sc = 0; sc < SEQ / TS; ++sc) {
        const int row0 = b * SEQ + sc * TS;
#pragma unroll 2
        for (int t = 0; t < TS; ++t) {
            const bf16* p = P + (size_t)(row0 + t) * PP + 64 * h + c;
            qs[t * 64 + c] = bf2f(p[D_Q]); ks[t * 64 + c] = bf2f(p[D_K]) * 0.125f; vo[t * 64 + c] = (unsigned)p[D_V] | ((unsigned)p[D_O] << 16);
        }
        if (c < TS) { const float* sm = SM + (size_t)(row0 + c) * 32;
            lil[c] = sm[SM_I + h] + ib; lfl[c] = -softplus_f(-(sm[SM_F + h] + fb)); }
        LDS_WAIT(); asm volatile("" ::: "memory");
#pragma unroll 1
        for (int t = 0; t < TS; ++t) {
            const float li = lil[t], lf = lfl[t];
            const float mn = fmaxf(lf + m, li), fs = expf(lf + m - mn), is = expf(li - mn); m = mn;
            const unsigned w = vo[t * 64 + c]; const float v = bf2f(w & 0xffffu), og = bf2f(w >> 16);
            const float iv = is * v;
            const f32x4* k4 = (const f32x4*)(ks + t * 64); const f32x4* q4 = (const f32x4*)(qs + t * 64);
            float num = 0.f, den = 0.f;
#pragma unroll
            for (int i = 0; i < 16; ++i) { const f32x4 kk = k4[i], qq = q4[i];
#pragma unroll
                for (int e = 0; e < 4; ++e) { C[4 * i + e] = fs * C[4 * i + e] + iv * kk[e]; n[4 * i + e] = fs * n[4 * i + e] + is * kk[e]; num += qq[e] * C[4 * i + e]; den += qq[e] * n[4 * i + e]; }
                if ((i & 3) == 3) asm volatile("" : "+v"(num), "+v"(den) :: "memory"); }
            float hv = num / fmaxf(fabsf(den), expf(-mn));
            hv *= sigmoid_f(og);
            const float ss = wave_sum(hv * hv);
            MIX[(size_t)(row0 + t) * D + 768 + 64 * h + c] = (bf16)f2bf(hv / sqrtf(ss * (1.f / 64.f) + EPS) * ng);
        }
        LDS_WAIT(); asm volatile("" ::: "memory");
    }
}
__device__ __forceinline__ void ssd_seq_block(Frame& F, const bf16* P, const float* SM, bf16* MIX, int l, int b, unsigned char* lds) {
    const int c = F.lane, w = F.wave, h = w >> 1, nh = w & 1, g = h >> 1;
    const float* cw = F.in[I_SCONVW] + (size_t)l * 4 * 768; const float* cb = F.in[I_SCONVB] + (size_t)l * 768;
    const int chx = 64 * h + c, chb = 256 + 128 * g + 64 * nh + c, chc = 512 + 128 * g + 64 * nh + c;
    float wx[4], wb[4], wc4[4];
#pragma unroll
    for (int j = 0; j < 4; ++j) { wx[j] = cw[j * 768 + chx]; wb[j] = cw[j * 768 + chb]; wc4[j] = cw[j * 768 + chc]; }
    const float bx = cb[chx], bb = cb[chb], bc = cb[chc];
    const float Aneg = -expf(F.in[I_SALOG][l * 4 + h]), dtb = F.in[I_SDTB][l * 4 + h], Dh = F.in[I_SD][l * 4 + h], ng = F.in[I_SNORM][l * 256 + 64 * h + c];
    float* BCs = (float*)lds + (size_t)(g * 2 + nh) * 2 * TS * 64; float* Bs = BCs; float* Cs = BCs + TS * 64;
    float* xs = (float*)lds + 8 * TS * 64 + h * TS * 64;
    float* yp = (float*)lds + 12 * TS * 64;
    float* dts = (float*)lds + 20 * TS * 64 + h * TS; float* dAs = (float*)lds + 20 * TS * 64 + 4 * TS + h * TS; float* ssq = (float*)lds + 20 * TS * 64 + 8 * TS;
    float x1 = 0.f, x2 = 0.f, x3 = 0.f, b1 = 0.f, b2 = 0.f, b3 = 0.f, c1 = 0.f, c2 = 0.f, c3 = 0.f;
    float st[64];
#pragma unroll
    for (int i = 0; i < 64; ++i) st[i] = 0.f;
#pragma unroll 1
    for (int sc = 0; sc < SEQ / TS; ++sc) {
        const int row0 = b * SEQ + sc * TS;
#pragma unroll 2
        for (int t = 0; t < TS; ++t) {
            const bf16* p = P + (size_t)(row0 + t) * PP + C_XBC;
            if (nh == 0) { const float rx = bf2f(p[chx]); xs[t * 64 + c] = silu_f(wx[0] * x3 + wx[1] * x2 + wx[2] * x1 + wx[3] * rx + bx); x3 = x2; x2 = x1; x1 = rx; }
            if ((h & 1) == 0) { const float rb = bf2f(p[chb]), rc = bf2f(p[chc]);
                Bs[t * 64 + c] = silu_f(wb[0] * b3 + wb[1] * b2 + wb[2] * b1 + wb[3] * rb + bb); b3 = b2; b2 = b1; b1 = rb;
                Cs[t * 64 + c] = silu_f(wc4[0] * c3 + wc4[1] * c2 + wc4[2] * c1 + wc4[3] * rc + bc); c3 = c2; c2 = c1; c1 = rc; }
        }
        if (nh == 0 && c < TS) { const float dt = softplus_f(SM[(size_t)(row0 + c) * 32 + SM_DT + h] + dtb); dts[c] = dt; dAs[c] = expf(dt * Aneg); }
        __syncthreads();
#pragma unroll 1
        for (int t = 0; t < TS; ++t) {
            const float dA = dAs[t], dtx = dts[t] * xs[t * 64 + c];
            const f32x4* B4 = (const f32x4*)(Bs + t * 64); const f32x4* C4 = (const f32x4*)(Cs + t * 64);
            float y = 0.f;
#pragma unroll
            for (int i = 0; i < 16; ++i) { const f32x4 bv = B4[i], cv = C4[i];
#pragma unroll
                for (int e = 0; e < 4; ++e) { st[4 * i + e] = dA * st[4 * i + e] + dtx * bv[e]; y += st[4 * i + e] * cv[e]; }
                if ((i & 3) == 3) asm volatile("" : "+v"(y) :: "memory"); }
            yp[(w * TS + t) * 64 + c] = y;
        }
        __syncthreads();
        if (nh == 0) {
            for (int t = 0; t < TS; ++t) {
                const float y = yp[(w * TS + t) * 64 + c] + yp[((w + 1) * TS + t) * 64 + c] + Dh * xs[t * 64 + c];
                const float z = bf2f(P[(size_t)(row0 + t) * PP + C_Z + 64 * h + c]);
                const float yz = y * silu_f(z);
                const float ss = wave_sum(yz * yz);
                if (c == 0) ssq[h * TS + t] = ss;
                yp[(w * TS + t) * 64 + c] = yz;
            }
        }
        __syncthreads();
        if (nh == 0) {
            for (int t = 0; t < TS; ++t) {
                const float tot = ssq[(2 * g) * TS + t] + ssq[(2 * g + 1) * TS + t];
                MIX[(size_t)(row0 + t) * D + 512 + 64 * h + c] = (bf16)f2bf(yp[(w * TS + t) * 64 + c] / sqrtf(tot * (1.f / 128.f) + EPS) * ng);
            }
        }
        __syncthreads();
    }
}
constexpr int AT_KS = 0, AT_KROW = 80, AT_VT = 2 * 64 * AT_KROW, AT_VROW = 136, AT_OX = 20480;
__device__ __forceinline__ void attn_unit(Frame& F, const bf16* P, bf16* MIX, int b, int h, int qb, float lam, const float* normg, float oscale, unsigned char* lds) {
    const int tid = F.tid, lane = F.lane, w = F.wave, map = w >> 2, wq = w & 3, r32 = lane & 31, hh = lane >> 5;
    const int q0 = qb * 128 + wq * 32;
    const int my_last = 2 * qb + (wq >> 1), nt = 2 * qb + 2;
    const bf16* qrow = P + (size_t)(b * SEQ + q0 + r32) * PP + B_Q + 32 * (2 * h + map) + 8 * hh;
    const bf16x8 Qf0 = *(const bf16x8*)qrow, Qf1 = *(const bf16x8*)(qrow + 16);
    f32x16 o0, o1;
#pragma unroll
    for (int i = 0; i < 16; ++i) { o0[i] = 0.f; o1[i] = 0.f; }
    float m_run = -1e30f, l_run = 0.f;
    const int kmap = tid >> 8, kkey = (tid >> 2) & 63, kpc = tid & 3, vkey = tid >> 3, vg = tid & 7;
    const bf16* ksrc = P + (size_t)(b * SEQ + kkey) * PP + B_K + 32 * (2 * h + kmap) + 8 * kpc;
    const bf16* vsrc = P + (size_t)(b * SEQ + vkey) * PP + B_V + 64 * h + 8 * vg;
    v4u kreg = *(const v4u*)ksrc, vreg = *(const v4u*)vsrc;
    unsigned char* kdst = lds + AT_KS + kmap * (64 * AT_KROW) + kkey * AT_KROW + kpc * 16;
    unsigned char* vdst = lds + AT_VT + (8 * vg) * AT_VROW + vkey * 2;
    const unsigned char* kA = lds + AT_KS + map * (64 * AT_KROW) + r32 * AT_KROW + hh * 16;
    const unsigned char* vA = lds + AT_VT + r32 * AT_VROW + hh * 8;
    for (int j = 0; j < nt; ++j) {
        __syncthreads();
        *(v4u*)kdst = kreg;
        {
            const unsigned vv[4] = {vreg.x, vreg.y, vreg.z, vreg.w};
#pragma unroll
            for (int i = 0; i < 4; ++i) { *(unsigned short*)(vdst + (2 * i) * AT_VROW) = (unsigned short)(vv[i] & 0xffffu); *(unsigned short*)(vdst + (2 * i + 1) * AT_VROW) = (unsigned short)(vv[i] >> 16); }
        }
        __syncthreads();
        if (j + 1 < nt) { kreg = *(const v4u*)(ksrc + (size_t)(j + 1) * 64 * PP); vreg = *(const v4u*)(vsrc + (size_t)(j + 1) * 64 * PP); }
        if (j <= my_last) {
            f32x16 s0, s1;
#pragma unroll
            for (int i = 0; i < 16; ++i) { s0[i] = 0.f; s1[i] = 0.f; }
            s0 = __builtin_amdgcn_mfma_f32_32x32x16_bf16(*(const bf16x8*)(kA), Qf0, s0, 0, 0, 0);
            s0 = __builtin_amdgcn_mfma_f32_32x32x16_bf16(*(const bf16x8*)(kA + 32), Qf1, s0, 0, 0, 0);
            s1 = __builtin_amdgcn_mfma_f32_32x32x16_bf16(*(const bf16x8*)(kA + 32 * AT_KROW), Qf0, s1, 0, 0, 0);
            s1 = __builtin_amdgcn_mfma_f32_32x32x16_bf16(*(const bf16x8*)(kA + 32 * AT_KROW + 32), Qf1, s1, 0, 0, 0);
            float mx = s0[0];
#pragma unroll
            for (int i = 0; i < 16; ++i) { mx = fmaxf(mx, s0[i]); mx = fmaxf(mx, s1[i]); }
            mx = fmaxf(mx, __shfl_xor(mx, 32));
            const float mn = fmaxf(m_run, mx), alpha = exp2f(m_run - mn); m_run = mn;
            float rs = 0.f;
#pragma unroll
            for (int i = 0; i < 16; ++i) { s0[i] = exp2f(s0[i] - mn); s1[i] = exp2f(s1[i] - mn); rs += s0[i] + s1[i]; }
            l_run = l_run * alpha + rs;
#pragma unroll
            for (int i = 0; i < 16; ++i) { o0[i] *= alpha; o1[i] *= alpha; }
            bf16x8 pf[4];
#pragma unroll
            for (int st = 0; st < 2; ++st) {
                v4u a, c;
                a.x = pk2(s0[8 * st + 0], s0[8 * st + 1]); a.y = pk2(s0[8 * st + 2], s0[8 * st + 3]); a.z = pk2(s0[8 * st + 4], s0[8 * st + 5]); a.w = pk2(s0[8 * st + 6], s0[8 * st + 7]);
                c.x = pk2(s1[8 * st + 0], s1[8 * st + 1]); c.y = pk2(s1[8 * st + 2], s1[8 * st + 3]); c.z = pk2(s1[8 * st + 4], s1[8 * st + 5]); c.w = pk2(s1[8 * st + 6], s1[8 * st + 7]);
                pf[st] = __builtin_bit_cast(bf16x8, a); pf[2 + st] = __builtin_bit_cast(bf16x8, c);
            }
#pragma unroll
            for (int ks = 0; ks < 4; ++ks) {
                const unsigned char* va = vA + (16 * ks) * 2;
                const v2u lo0 = *(const v2u*)(va), hi0 = *(const v2u*)(va + 16);
                const v2u lo1 = *(const v2u*)(va + 32 * AT_VROW), hi1 = *(const v2u*)(va + 32 * AT_VROW + 16);
                const bf16x8 a0 = __builtin_bit_cast(bf16x8, (v4u){lo0.x, lo0.y, hi0.x, hi0.y}), a1 = __builtin_bit_cast(bf16x8, (v4u){lo1.x, lo1.y, hi1.x, hi1.y});
                o0 = __builtin_amdgcn_mfma_f32_32x32x16_bf16(a0, pf[ks], o0, 0, 0, 0);
                o1 = __builtin_amdgcn_mfma_f32_32x32x16_bf16(a1, pf[ks], o1, 0, 0, 0);
            }
        }
    }
    const float lt = l_run + __shfl_xor(l_run, 32), inv = 1.0f / lt;
    float* OX = (float*)(lds + AT_OX);
    if (map == 1) {
#pragma unroll
        for (int i = 0; i < 16; ++i) { const int dv = (i & 3) + 8 * (i >> 2) + 4 * hh;
            OX[(wq * 64 + dv) * 32 + r32] = o0[i] * inv; OX[(wq * 64 + 32 + dv) * 32 + r32] = o1[i] * inv; }
    }
    __syncthreads();
    if (map == 0) {
        float ss = 0.f;
#pragma unroll
        for (int i = 0; i < 16; ++i) { const int dv = (i & 3) + 8 * (i >> 2) + 4 * hh;
            o0[i] = o0[i] * inv - lam * OX[(wq * 64 + dv) * 32 + r32]; o1[i] = o1[i] * inv - lam * OX[(wq * 64 + 32 + dv) * 32 + r32];
            ss += o0[i] * o0[i] + o1[i] * o1[i]; }
        ss += __shfl_xor(ss, 32);
        const float r = oscale / sqrtf(ss * (1.f / 64.f) + EPS);
        bf16* orow = MIX + (size_t)(b * SEQ + q0 + r32) * D + 256 + 64 * h;
#pragma unroll
        for (int g4 = 0; g4 < 4; ++g4) { const int dv = 8 * g4 + 4 * hh;
            const f32x4 ga = *(const f32x4*)(normg + dv), gb = *(const f32x4*)(normg + 32 + dv);
            v2u wa, wb; wa.x = pk2(o0[4 * g4] * r * ga.x, o0[4 * g4 + 1] * r * ga.y); wa.y = pk2(o0[4 * g4 + 2] * r * ga.z, o0[4 * g4 + 3] * r * ga.w);
            wb.x = pk2(o1[4 * g4] * r * gb.x, o1[4 * g4 + 1] * r * gb.y); wb.y = pk2(o1[4 * g4 + 2] * r * gb.z, o1[4 * g4 + 3] * r * gb.w);
            *(v2u*)(orow + dv) = wa; *(v2u*)(orow + 32 + dv) = wb; }
    }
}
__device__ __forceinline__ void mixer_phase(Frame& F, int l) {
    const bf16* P = (const bf16*)(F.ws + WS_P); const float* SM = (const float*)(F.ws + WS_SM); bf16* MIX = (bf16*)(F.ws + WS_XN);
    const int bid = blockIdx.x;
    constexpr int NSEQ = 16;
    if (bid < 4) { const int idx = bid * 8 + F.wave; gdn_seq_wave(F, P, SM, MIX, l, idx >> 2, idx & 3, (float*)(F.lds + F.wave * 16384)); }
    else if (bid < 12) { ssd_seq_block(F, P, SM, MIX, l, bid - 4, F.lds); }
    else if (bid < 16) { const int idx = (bid - 12) * 8 + F.wave; mlstm_seq_wave(F, P, SM, MIX, l, idx >> 2, idx & 3, (float*)(F.lds + F.wave * 16384)); }
    else {
        const float lambda_init = 0.8f - 0.6f * expf(-0.3f * (float)l);
        float d1 = 0.f, d2 = 0.f;
        if (F.lane < 32) { d1 = F.in[I_LQ1][l * 32 + F.lane] * F.in[I_LK1][l * 32 + F.lane]; d2 = F.in[I_LQ2][l * 32 + F.lane] * F.in[I_LK2][l * 32 + F.lane]; }
        const float lam = expf(wave_sum(d1)) - expf(wave_sum(d2)) + lambda_init;
        const float* normg = F.in[I_DNORM] + l * 64;
        const int nw = F.G - NSEQ, wk = bid - NSEQ;
        for (int i = wk; i < BATCH * 4 * 32; i += nw) { const int qb = 31 - (i >> 5), bh = i & 31; attn_unit(F, P, MIX, bh >> 2, bh & 3, qb, lam, normg, 1.0f - lambda_init, F.lds); }
    }
}
struct Args { const float* in[N_IN]; float* out; unsigned char* ws; int ph_lo, ph_hi, pad0, pad1; };
constexpr int N_SLOTS = 1 + NLAYER * 3 * 5;
__host__ __device__ constexpr bool slot_used(int p) { return p == 0 || ((((p - 1) / 5) % 3) == 1) || (((p - 1) % 5) != 1 && ((p - 1) % 5) != 2); }

__global__ void __launch_bounds__(NWAVES * 64, 2) mk_fwd(Args args) {
    extern __shared__ __attribute__((aligned(16))) unsigned char lds[];
    Frame F;
    F.lds = lds;
    F.MISC = (volatile LAS unsigned*)((LAS unsigned char*)lds + MISC_OFF);
    F.tid = threadIdx.x; F.lane = F.tid & 63; F.wave = __builtin_amdgcn_readfirstlane(F.tid >> 6);
    F.G = gridDim.x; { const int bx = blockIdx.x; F.vcu = (F.G % 8 == 0) ? (bx % 8) * (F.G / 8) + bx / 8 : bx; }
    F.in = args.in; F.out = args.out; F.ws = args.ws;
    F.ctl = (gu32*)(args.ws + WS_CTL);
    for (int u = F.tid; u < (LDS_BYTES - LDSCTL_OFF) / 4; u += NWAVES * 64) ((LAS unsigned*)((LAS unsigned char*)lds + LDSCTL_OFF))[u] = 0u;
    __syncthreads();
    XcdBarrier bar; bar.bar = (unsigned*)(F.ctl + CW_BAR); bar.x = 0; bar.st = nullptr;
    if (N_LAUNCHES == 1) bar = xcd_barrier_post((unsigned*)(F.ctl + CW_BAR), F.MISC + 8);
    const int lo = args.ph_lo, hi = args.ph_hi;
#define IN(k) (lo <= (k) && (k) < hi)
#define SEAM(k) do { if ((k) + 1 < hi) { if (N_LAUNCHES == 1) xcd_barrier(bar); } } while (0)
    bf16* XN = (bf16*)(F.ws + WS_XN); bf16* Y = (bf16*)(F.ws + WS_Y); bf16* P = (bf16*)(F.ws + WS_P); float* SM = (float*)(F.ws + WS_SM);
    PG8_LAS unsigned char* ring = (PG8_LAS unsigned char*)lds + RING_OFF;

    if (IN(0)) {
        p0_prologue(F);
        post_rows(F, F.in[I_X], nullptr, 0.f, nullptr, nullptr, F.in[I_F1PRE], XN, false, false, true);
        SEAM(0);
    }
#define SUBBLOCK(l, sb) do { \
        unsigned char* wl = F.ws + WS_W + (size_t)(l) * W_LAYER; \
        constexpr int base = 1 + ((l) * 3 + (sb)) * 5; \
        if (IN(base)) { \
            if ((sb) != 1) { \
                pg8::Gemm g{XN, (const bf16*)(wl + ((sb) == 0 ? WL_GU1 : WL_GU2)), M, 2 * FF, D}; pg8::StaticOrder S; S.init(M, 2 * FF, F.G, (int)blockIdx.x); \
                pg8::EpiSwiglu E{P, FF}; \
                pg8::gemm_phase<pg8::EpiSwiglu, pg8::StaticOrder, PG8_ALIGN, PG8_SP2>(ring, g, S, E); \
            } else { \
                pg8::Gemm g{XN, (const bf16*)(wl + WL_IN), M, 4096, D}; pg8::StaticOrder S; S.init(M, 4096, F.G, (int)blockIdx.x); \
                pg8::EpiProj E{P, SM}; \
                pg8::gemm_phase<pg8::EpiProj, pg8::StaticOrder, PG8_ALIGN, PG8_SP2>(ring, g, S, E); \
            } \
            SEAM(base); \
        } \
        if ((sb) == 1 && IN(base + 1)) { rope_phase(F, P); SEAM(base + 1); } \
        if ((sb) == 1 && IN(base + 2)) { mixer_phase(F, (l)); SEAM(base + 2); } \
        if (IN(base + 3)) { \
            const bf16* A = (sb) == 1 ? XN : P; const int K = (sb) == 1 ? D : FF; \
            const bf16* Bt = (const bf16*)(wl + ((sb) == 0 ? WL_D1 : (sb) == 1 ? WL_OUT : WL_D2)); \
            pg8::Gemm g{A, Bt, M, D, K}; pg8::StaticOrder S; S.init(M, D, F.G, (int)blockIdx.x); \
            pg8::EpiBf16<0> E{Y, D, nullptr, 0, 0, 1.f}; \
            pg8::gemm_phase<pg8::EpiBf16<0>, pg8::StaticOrder, PG8_ALIGN, PG8_SP2>(ring, g, S, E); \
            SEAM(base + 3); \
        } \
        if (IN(base + 4)) { \
            const float* xsrc = ((l) == 0 && (sb) == 0) ? F.in[I_X] : F.out; \
            const float* gpost = F.in[(sb) == 0 ? I_F1POST : (sb) == 1 ? I_MIXPOST : I_F2POST] + (l) * D; \
            constexpr bool last = ((l) == NLAYER - 1 && (sb) == 2); \
            const float* gpre = (sb) == 0 ? F.in[I_MIXPRE] + (l) * D : (sb) == 1 ? F.in[I_F2PRE] + (l) * D : F.in[I_F1PRE] + (last ? 0 : ((l) + 1) * D); \
            post_rows(F, xsrc, Y, (sb) == 1 ? 1.0f : 0.5f, gpost, F.out, gpre, XN, true, true, !last); \
            SEAM(base + 4); \
        } } while (0)
    SUBBLOCK(0, 0); SUBBLOCK(0, 1); SUBBLOCK(0, 2); SUBBLOCK(1, 0); SUBBLOCK(1, 1); SUBBLOCK(1, 2);
#undef SUBBLOCK
#undef IN
#undef SEAM
}

extern "C" void kernel_launch(void* const* d_in, const int* in_sizes, int n_in, void* d_out, int out_size, void* d_ws, size_t ws_size, hipStream_t stream) {
    static int grid = 0;
    if (grid == 0) {
        if (n_in != N_IN || in_sizes[0] != M * D || out_size != M * D || ws_size < WS_END) { fprintf(stderr, "kernel_launch: unexpected shapes (n_in %d, in0 %d, out %d, ws %zu); nothing launched\n", n_in, n_in > 0 ? in_sizes[0] : -1, out_size, ws_size); grid = -1; return; }
        int dev = 0, cus = 0, per_cu = 0;
        if (hipGetDevice(&dev) != hipSuccess || hipDeviceGetAttribute(&cus, hipDeviceAttributeMultiprocessorCount, dev) != hipSuccess) { grid = -1; return; }
        if (hipFuncSetAttribute((const void*)mk_fwd, hipFuncAttributeMaxDynamicSharedMemorySize, LDS_BYTES) != hipSuccess) { fprintf(stderr, "kernel_launch: hipFuncSetAttribute failed\n"); grid = -1; return; }
        if (hipOccupancyMaxActiveBlocksPerMultiprocessor(&per_cu, (const void*)mk_fwd, NWAVES * 64, LDS_BYTES) != hipSuccess || per_cu < 1) fprintf(stderr, "kernel_launch: occupancy query reports %d\n", per_cu);
        (void)hipGetLastError();
        grid = cus;
    }
    if (grid < 0) return;
    if (hipMemsetAsync((char*)d_ws + WS_CTL, 0, CTL_ZERO_BYTES, stream) != hipSuccess) return;
    Args a{};
    for (int i = 0; i < N_IN; ++i) a.in[i] = (const float*)d_in[i];
    a.out = (float*)d_out; a.ws = (unsigned char*)d_ws;
    if (N_LAUNCHES == 1) {
        a.ph_lo = 0; a.ph_hi = N_SLOTS;
        hipLaunchKernelGGL(mk_fwd, dim3(grid), dim3(NWAVES * 64), LDS_BYTES, stream, a);
    } else {
        for (int p = 0; p < N_SLOTS; ++p) { if (!slot_used(p)) continue; a.ph_lo = p; a.ph_hi = p + 1;
            hipLaunchKernelGGL(mk_fwd, dim3(grid), dim3(NWAVES * 64), LDS_BYTES, stream, a); }
    }
}
```

```cpp
#include <hip/hip_runtime.h>
#include <cstdio>
#include <cstdint>
#ifndef MK_N_LAUNCHES
#define MK_N_LAUNCHES 1
#endif
namespace pg8 {
#define PG8_LAS __attribute__((address_space(3)))
typedef unsigned short bf16_t;
typedef short bf16x8 __attribute__((ext_vector_type(8)));
typedef float f32x4 __attribute__((ext_vector_type(4)));
typedef unsigned u32x4 __attribute__((ext_vector_type(4)));
constexpr int BM = 256, BK = 64, HALF = 128, HTB = HALF * BK * 2  , STAGE_BYTES = 8 * HTB, NXCD = 8, WGM = 8;

__host__ __device__ __forceinline__ int lds_byte(int r, int c) { const int st = (r >> 4) * 2 + (c >> 5), rr = r & 15, cc = c & 31, ob = rr * 64 + cc * 2; return st * 1024 + (ob ^ (((ob >> 9) & 1) << 5)); }
__host__ __device__ __forceinline__ void stage_rc(int b, int& R, int& C) { const int st = b / 1024, sb = b % 1024, swz = sb ^ (((sb >> 9) & 1) << 5); R = (st >> 1) * 16 + swz / 64; C = (st & 1) * 32 + (swz % 64) / 2; }
__host__ __device__ __forceinline__ int perm32(int rho) { const int n = rho >> 4, i = rho & 15; return 8 * (i >> 2) + 4 * n + (i & 3); }

struct Unit { int pm, pn; };
struct Gemm { const bf16_t* A; const bf16_t* Bt; int M, N, K; };

struct StaticOrder {
    int nM, nN, nwg, G, c;
    __host__ __device__ void init(int M, int N, int G_, int c_) { nM = M / BM; nN = N / BM; nwg = nM * nN; G = G_; c = c_; }
    __host__ __device__ bool next(int i, Unit& u) const {
        const long L = (long)i * G + c; if (L >= nwg) return false;
        int wgid = (int)L; { const int q = nwg / NXCD, r = nwg % NXCD, xcd = wgid % NXCD, off = wgid / NXCD; wgid = (xcd < r ? xcd * (q + 1) : r * (q + 1) + (xcd - r) * q) + off; }
        const int nig = WGM * nN, gid = wgid / nig, fm = gid * WGM, gsz = (nM - fm) < WGM ? (nM - fm) : WGM;
        u.pm = fm + ((wgid % nig) % gsz); u.pn = (wgid % nig) / gsz; return true;
    }
    __device__ __forceinline__ void a_ready(const Unit&) const {}
    __device__ __forceinline__ void done(const Unit&) const {}
};

__device__ __forceinline__ unsigned cvt_pk_bf16(float lo, float hi) { unsigned r; asm volatile("v_cvt_pk_bf16_f32 %0, %1, %2" : "=v"(r) : "v"(lo), "v"(hi)); return r; }
typedef float f32x2 __attribute__((ext_vector_type(2)));
__device__ __forceinline__ f32x2 gelu_pk(f32x2 v) {
    const f32x2 av = __builtin_elementwise_abs(v), d = av * 0.2316418882f + 1.0f;
    f32x2 t; t.x = __builtin_amdgcn_rcpf(d.x); t.y = __builtin_amdgcn_rcpf(d.y);
    f32x2 q = t * 0.5307027145f + (-0.7265760135f); q = q * t + 0.7107068705f; q = q * t + (-0.142248368f); q = q * t + 0.127414796f; q = q * t;
    const f32x2 s = (v * v) * (-0.72134752044f);
    f32x2 e; e.x = __builtin_amdgcn_exp2f(s.x); e.y = __builtin_amdgcn_exp2f(s.y);
    const f32x2 m = v * (q * e), r = v - m;
    f32x2 o; o.x = v.x < 0.f ? m.x : r.x; o.y = v.y < 0.f ? m.y : r.y; return o;
}

template <int ACT  > struct EpiBf16 {
    static constexpr bool PERM = true, AFTER_DRAIN = false; static_assert(ACT == 0 || ACT == 1, "EpiBf16: ACT is 0 (none) or 1 (gelu_pk)");
    bf16_t* O; int ldc; const float* bias; int split_cols; size_t split_stride; float scale0;
    __device__ __forceinline__ void operator()(const f32x4 (&acc)[2][2][4][2], const Unit& u, int wr, int wc, int fr, int fq) const {
        const int row0 = u.pm * BM + wr * 64 + fr; int colt = u.pn * BM; bf16_t* base = O;
        float sc = 1.f; if (split_cols) { const int t = colt / split_cols; base += (size_t)t * split_stride; colt -= t * split_cols; if (t == 0) sc = scale0; }
        const int col0 = colt + wc * 32 + 8 * fq, bcol0 = u.pn * BM + wc * 32 + 8 * fq;
        f32x4 bv[2][2];
#pragma unroll
        for (int bj = 0; bj < 2; ++bj)
#pragma unroll
            for (int n = 0; n < 2; ++n) bv[bj][n] = bias ? *(const f32x4*)(bias + bcol0 + bj * HALF + 4 * n) : (f32x4){0.f, 0.f, 0.f, 0.f};
#pragma unroll
        for (int ai = 0; ai < 2; ++ai)
#pragma unroll
            for (int m = 0; m < 4; ++m) { bf16_t* rowp = base + (size_t)(row0 + ai * HALF + m * 16) * ldc + col0;
#pragma unroll
                for (int bj = 0; bj < 2; ++bj) { f32x4 v0 = acc[ai][bj][m][0] + bv[bj][0], v1 = acc[ai][bj][m][1] + bv[bj][1];
                    if (ACT == 1) { f32x2 a = gelu_pk((f32x2){v0[0], v0[1]}), b = gelu_pk((f32x2){v0[2], v0[3]}), c = gelu_pk((f32x2){v1[0], v1[1]}), d = gelu_pk((f32x2){v1[2], v1[3]});
                        v0 = (f32x4){a.x, a.y, b.x, b.y}; v1 = (f32x4){c.x, c.y, d.x, d.y}; }
                    v0 = v0 * sc; v1 = v1 * sc; u32x4 w; w.x = cvt_pk_bf16(v0[0], v0[1]); w.y = cvt_pk_bf16(v0[2], v0[3]); w.z = cvt_pk_bf16(v1[0], v1[1]); w.w = cvt_pk_bf16(v1[2], v1[3]);
                    *(u32x4*)(rowp + bj * HALF) = w; } }
    }
};

struct EpiSwiglu {
    static constexpr bool PERM = true, AFTER_DRAIN = false;
    bf16_t* O; int ldc;
    __device__ __forceinline__ void operator()(const f32x4 (&acc)[2][2][4][2], const Unit& u, int wr, int wc, int fr, int fq) const {
        const int row0 = u.pm * BM + wr * 64 + fr; const int col0 = u.pn * 128 + wc * 32 + 8 * fq;
#pragma unroll
        for (int ai = 0; ai < 2; ++ai)
#pragma unroll
            for (int m = 0; m < 4; ++m) { bf16_t* rowp = O + (size_t)(row0 + ai * HALF + m * 16) * ldc + col0;
                float h[8];
#pragma unroll
                for (int n = 0; n < 2; ++n)
#pragma unroll
                    for (int i = 0; i < 4; ++i) { const float g = acc[ai][0][m][n][i], up = acc[ai][1][m][n][i];
                        h[n * 4 + i] = g * __builtin_amdgcn_rcpf(1.0f + __expf(-g)) * up; }
                u32x4 w; w.x = cvt_pk_bf16(h[0], h[1]); w.y = cvt_pk_bf16(h[2], h[3]); w.z = cvt_pk_bf16(h[4], h[5]); w.w = cvt_pk_bf16(h[6], h[7]);
                *(u32x4*)rowp = w; }
    }
};
struct EpiProj {
    static constexpr bool PERM = true, AFTER_DRAIN = false;
    bf16_t* P; float* SM;
    __device__ __forceinline__ void operator()(const f32x4 (&acc)[2][2][4][2], const Unit& u, int wr, int wc, int fr, int fq) const {
        const int row0 = u.pm * BM + wr * 64 + fr;
        if (u.pn < 15) {
            const int col0 = u.pn * BM + wc * 32 + 8 * fq;
#pragma unroll
            for (int ai = 0; ai < 2; ++ai)
#pragma unroll
                for (int m = 0; m < 4; ++m) { bf16_t* rowp = P + (size_t)(row0 + ai * HALF + m * 16) * 3840 + col0;
#pragma unroll
                    for (int bj = 0; bj < 2; ++bj) { const f32x4 v0 = acc[ai][bj][m][0], v1 = acc[ai][bj][m][1];
                        u32x4 w; w.x = cvt_pk_bf16(v0[0], v0[1]); w.y = cvt_pk_bf16(v0[2], v0[3]); w.z = cvt_pk_bf16(v1[0], v1[1]); w.w = cvt_pk_bf16(v1[2], v1[3]);
                        *(u32x4*)(rowp + bj * HALF) = w; } }
        } else if (wc == 0) {
#pragma unroll
            for (int ai = 0; ai < 2; ++ai)
#pragma unroll
                for (int m = 0; m < 4; ++m) { float* rowp = SM + (size_t)(row0 + ai * HALF + m * 16) * 32 + 8 * fq;
                    *(f32x4*)rowp = acc[ai][0][m][0]; *(f32x4*)(rowp + 4) = acc[ai][0][m][1]; }
        }
    }
};
template <class Epi, class Sched, bool ALIGN_EPI = false, bool SP2 = false>
__device__ __forceinline__ void gemm_phase(PG8_LAS unsigned char* lds, const Gemm g, const Sched& S, const Epi& E) {
    const int tid = threadIdx.x, wid = __builtin_amdgcn_readfirstlane(tid >> 6), lane = tid & 63, wr = wid >> 2, wc = wid & 3, fr = lane & 15, fq = lane >> 4;
    const int K = g.K, nt = K / BK;
    unsigned voffA[2], voffB[2];
#pragma unroll
    for (int i = 0; i < 2; ++i) { int R, C; stage_rc(tid * 16 + i * 8192, R, C); const int Rb = Epi::PERM ? ((R & ~31) + perm32(R & 31)) : R;
        voffA[i] = (unsigned)(R * K + C) * 2u; voffB[i] = (unsigned)(Rb * K + C) * 2u; }
    const size_t kstep = (size_t)(BK * 2);
    const size_t hstep = (size_t)HALF * K * 2;
    const size_t tstep = 2 * hstep;
    const unsigned ldsw = (unsigned)wid * 1024u;
    const int aoff = lds_byte(wr * 64 + fr, fq * 8), boff = lds_byte(wc * 32 + fr, fq * 8);
#define PG8_SA(b, h) (((b) * 2 + (h)) * HTB)
#define PG8_SB(b, h) ((4 + (b) * 2 + (h)) * HTB)
#define PG8_STAGE(bufoff, gbase, voff) do { _Pragma("unroll") for (int _i = 0; _i < 2; ++_i) \
        __builtin_amdgcn_global_load_lds((const unsigned*)((const char*)(gbase) + (voff)[_i]), (PG8_LAS unsigned*)(lds + (bufoff) + ldsw + _i * 8192), 16, 0, 0); } while (0)
#define PG8_LDA(dst, b, h) do { _Pragma("unroll") for (int m = 0; m < 4; ++m) _Pragma("unroll") for (int k = 0; k < 2; ++k) dst[m][k] = *(const PG8_LAS bf16x8*)(lds + PG8_SA(b, h) + aoff + m * 2048 + k * 1024); } while (0)
#define PG8_LDB(dst, b, h) do { _Pragma("unroll") for (int n = 0; n < 2; ++n) _Pragma("unroll") for (int k = 0; k < 2; ++k) dst[n][k] = *(const PG8_LAS bf16x8*)(lds + PG8_SB(b, h) + boff + n * 2048 + k * 1024); } while (0)
#define PG8_MMA(ai, bj, At, Bt) do { __builtin_amdgcn_s_setprio(1); _Pragma("unroll") for (int m = 0; m < 4; ++m) _Pragma("unroll") for (int n = 0; n < 2; ++n) _Pragma("unroll") for (int k = 0; k < 2; ++k) \
        acc[ai][bj][m][n] = __builtin_amdgcn_mfma_f32_16x16x32_bf16(Bt[n][k], At[m][k], acc[ai][bj][m][n], 0, 0, 0); __builtin_amdgcn_s_setprio(0); } while (0)
#define PG8_WAIT_V(n) asm volatile("s_waitcnt vmcnt(" #n ")" ::: "memory")
#define PG8_WAIT_L(n) asm volatile("s_waitcnt lgkmcnt(" #n ")" ::: "memory")
#define PG8_BAR __builtin_amdgcn_s_barrier()
#define PG8_SCHED __builtin_amdgcn_sched_barrier(0)
    Unit cur, nxt; int ui = 0;
    if (!S.next(0, cur)) return;
    f32x4 acc[2][2][4][2];
#pragma unroll
    for (int a = 0; a < 2; ++a)
#pragma unroll
        for (int b = 0; b < 2; ++b)
#pragma unroll
            for (int m = 0; m < 4; ++m)
#pragma unroll
                for (int n = 0; n < 2; ++n) acc[a][b][m][n] = (f32x4){0.f, 0.f, 0.f, 0.f};
    bf16x8 At[4][2], B0[2][2], B1[2][2];
    const char* cA = (const char*)g.A + (size_t)cur.pm * tstep; const char* cB = (const char*)g.Bt + (size_t)cur.pn * tstep;
    S.a_ready(cur);
    if constexpr (SP2) {
        PG8_STAGE(PG8_SB(0, 0), cB, voffB); PG8_STAGE(PG8_SB(0, 1), cB + hstep, voffB); PG8_STAGE(PG8_SA(0, 0), cA, voffA); PG8_STAGE(PG8_SA(0, 1), cA + hstep, voffA);
        if (wr == 1) PG8_BAR;
        PG8_WAIT_V(2); PG8_BAR;
        PG8_STAGE(PG8_SB(1, 0), cB + kstep, voffB); PG8_STAGE(PG8_SA(1, 0), cA + kstep, voffA); PG8_STAGE(PG8_SB(1, 1), cB + hstep + kstep, voffB);
        PG8_WAIT_V(6); PG8_BAR;
    } else {
        PG8_STAGE(PG8_SB(0, 0), cB, voffB); PG8_STAGE(PG8_SA(0, 0), cA, voffA); PG8_STAGE(PG8_SB(0, 1), cB + hstep, voffB); PG8_STAGE(PG8_SA(0, 1), cA + hstep, voffA);
        if (wr == 1) PG8_BAR;
        PG8_WAIT_V(4); PG8_BAR;
        PG8_STAGE(PG8_SB(1, 0), cB + kstep, voffB); PG8_STAGE(PG8_SA(1, 0), cA + kstep, voffA); PG8_STAGE(PG8_SB(1, 1), cB + hstep + kstep, voffB);
        PG8_WAIT_V(6); PG8_BAR;
    }
    for (;;) {
        const bool has_next = S.next(ui + 1, nxt);
        const char* nA = has_next ? (const char*)g.A + (size_t)nxt.pm * tstep : cA; const char* nB = has_next ? (const char*)g.Bt + (size_t)nxt.pn * tstep : cB;
        for (int t = 0; t < nt; t += 2) {
            const bool last = (t == nt - 2);
            const char* a1 = cA + (size_t)(t + 1) * kstep;
            const char* a2 = last ? nA : cA + (size_t)(t + 2) * kstep; const char* b2 = last ? nB : cB + (size_t)(t + 2) * kstep;
            const char* a3 = a2 + kstep; const char* b3 = b2 + kstep;
            if (last && has_next) S.a_ready(nxt);
            if constexpr (SP2) {
            PG8_LDB(B0, 0, 0); PG8_LDB(B1, 0, 1); PG8_SCHED; PG8_LDA(At, 0, 0); PG8_STAGE(PG8_SA(1, 1), a1 + hstep, voffA);
            PG8_WAIT_V(8); PG8_WAIT_L(0); PG8_BAR; PG8_MMA(0, 0, At, B0); PG8_MMA(0, 1, At, B1); PG8_BAR; PG8_SCHED;
            PG8_LDA(At, 0, 1); PG8_STAGE(PG8_SB(0, 0), b2, voffB); PG8_STAGE(PG8_SB(0, 1), b2 + hstep, voffB); PG8_STAGE(PG8_SA(0, 0), a2, voffA);
            PG8_WAIT_V(8); PG8_WAIT_L(0); PG8_BAR; PG8_MMA(1, 0, At, B0); PG8_MMA(1, 1, At, B1); PG8_BAR; PG8_SCHED;
            PG8_LDB(B0, 1, 0); PG8_LDB(B1, 1, 1); PG8_SCHED; PG8_LDA(At, 1, 0); PG8_STAGE(PG8_SA(0, 1), a2 + hstep, voffA);
            PG8_WAIT_V(8); PG8_WAIT_L(0); PG8_BAR; PG8_MMA(0, 0, At, B0); PG8_MMA(0, 1, At, B1); PG8_BAR; PG8_SCHED;
            PG8_LDA(At, 1, 1); PG8_STAGE(PG8_SB(1, 0), b3, voffB); PG8_STAGE(PG8_SB(1, 1), b3 + hstep, voffB); PG8_STAGE(PG8_SA(1, 0), a3, voffA);
            PG8_WAIT_V(8); PG8_WAIT_L(0); PG8_BAR; PG8_MMA(1, 0, At, B0); PG8_MMA(1, 1, At, B1); PG8_BAR; PG8_SCHED;
            } else {
            PG8_LDB(B0, 0, 0); PG8_SCHED; PG8_LDA(At, 0, 0); PG8_STAGE(PG8_SA(1, 1), a1 + hstep, voffA);
            PG8_WAIT_L(8); PG8_BAR; PG8_WAIT_L(0); PG8_MMA(0, 0, At, B0); PG8_BAR; PG8_SCHED;
            PG8_LDB(B1, 0, 1); PG8_STAGE(PG8_SB(0, 0), b2, voffB);
            PG8_BAR; PG8_WAIT_L(0); PG8_MMA(0, 1, At, B1); PG8_BAR;
            PG8_LDA(At, 0, 1); PG8_STAGE(PG8_SA(0, 0), a2, voffA);
            PG8_BAR; PG8_WAIT_L(0); PG8_MMA(1, 0, At, B0); PG8_BAR; PG8_SCHED;
            PG8_STAGE(PG8_SB(0, 1), b2 + hstep, voffB);
            PG8_WAIT_V(6); PG8_BAR; PG8_MMA(1, 1, At, B1); PG8_BAR;
            PG8_LDB(B0, 1, 0); PG8_SCHED; PG8_LDA(At, 1, 0); PG8_STAGE(PG8_SA(0, 1), a2 + hstep, voffA);
            PG8_WAIT_L(8); PG8_BAR; PG8_WAIT_L(0); PG8_MMA(0, 0, At, B0); PG8_BAR; PG8_SCHED;
            PG8_LDB(B1, 1, 1); PG8_STAGE(PG8_SB(1, 0), b3, voffB);
            PG8_BAR; PG8_WAIT_L(0); PG8_MMA(0, 1, At, B1); PG8_BAR;
            PG8_LDA(At, 1, 1); PG8_STAGE(PG8_SA(1, 0), a3, voffA);
            PG8_BAR; PG8_WAIT_L(0); PG8_MMA(1, 0, At, B0); PG8_BAR; PG8_SCHED;
            PG8_STAGE(PG8_SB(1, 1), b3 + hstep, voffB);
            PG8_WAIT_V(6); PG8_BAR; PG8_MMA(1, 1, At, B1); PG8_BAR;
            }
        }
        if constexpr (ALIGN_EPI) { if (wr == 0) PG8_BAR; }
        if constexpr (!Epi::AFTER_DRAIN) { E(acc, cur, wr, wc, fr, fq); S.done(cur); }
        if (!has_next) break;
#pragma unroll
        for (int a = 0; a < 2; ++a)
#pragma unroll
            for (int b = 0; b < 2; ++b)
#pragma unroll
                for (int m = 0; m < 4; ++m)
#pragma unroll
                    for (int n = 0; n < 2; ++n) acc[a][b][m][n] = (f32x4){0.f, 0.f, 0.f, 0.f};
        cur = nxt; cA = nA; cB = nB; ++ui;
        if constexpr (ALIGN_EPI) { if (wr == 1) PG8_BAR; }
    }
    PG8_WAIT_V(0);
    if constexpr (!ALIGN_EPI) { if (wr == 0) PG8_BAR; }
    PG8_BAR;
    if constexpr (Epi::AFTER_DRAIN) { E.fused(acc, cur, wr, wc, fr, fq, lds, wid, lane); S.done(cur); }
#undef PG8_SA
#undef PG8_SB
#undef PG8_STAGE
#undef PG8_LDA
#undef PG8_LDB
#undef PG8_MMA
#undef PG8_WAIT_V
#undef PG8_WAIT_L
#undef PG8_BAR
#undef PG8_SCHED
}
}
#ifndef PG8_SP2
#define PG8_SP2 true
#endif
#ifndef PG8_ALIGN
#define PG8_ALIGN true
#endif
constexpr int N_LAUNCHES = MK_N_LAUNCHES;
constexpr int NWAVES = 8;
constexpr int BATCH = 8, SEQ = 4096, D = 1024, FF = 2816, NLAYER = 2;
constexpr int M = BATCH * SEQ;
constexpr int INC = 3860;
constexpr int PP = 3840;
constexpr int A_Q = 0, A_K = 256, A_V = 512, A_G = 768, B_Q = 1024, B_K = 1280, B_V = 1536, C_Z = 1792, C_XBC = 2048, D_Q = 2816, D_K = 3072, D_V = 3328, D_O = 3584;
constexpr int SM_BETA = 0, SM_A = 4, SM_DT = 8, SM_I = 12, SM_F = 16;
constexpr float EPS = 1e-6f;
enum { I_X = 0, I_F1PRE, I_F1G, I_F1U, I_F1D, I_F1POST, I_MIXPRE, I_WIN, I_GCONV, I_GALOG, I_GDTB, I_GNORM, I_LQ1, I_LK1, I_LQ2, I_LK2, I_DNORM,
       I_SCONVW, I_SCONVB, I_SALOG, I_SDTB, I_SD, I_SNORM, I_MIB, I_MFB, I_MNORM, I_WOUT, I_MIXPOST, I_F2PRE, I_F2G, I_F2U, I_F2D, I_F2POST, N_IN };
constexpr size_t MiB = 1u << 20;
constexpr size_t WS_CTL = 0, CTL_ZERO_BYTES = 1 * MiB;
constexpr size_t WS_ROPE = 1 * MiB;
constexpr size_t WS_W = 2 * MiB;
constexpr size_t W_GU = (size_t)2 * FF * D * 2, W_DN = (size_t)D * FF * 2, W_IN = (size_t)4096 * D * 2, W_OUT = (size_t)D * D * 2;
constexpr size_t WL_GU1 = 0, WL_D1 = WL_GU1 + W_GU, WL_IN = WL_D1 + W_DN, WL_OUT = WL_IN + W_IN, WL_GU2 = WL_OUT + W_OUT, WL_D2 = WL_GU2 + W_GU, W_LAYER = WL_D2 + W_DN;
static_assert(W_LAYER == 43 * MiB, "weights per layer");
constexpr size_t WS_XN = 88 * MiB;
constexpr size_t WS_Y = 152 * MiB;
constexpr size_t WS_P = 216 * MiB;
constexpr size_t WS_SM = 456 * MiB;
constexpr size_t WS_END = 511 * MiB;
static_assert(WS_W + 2 * W_LAYER <= WS_XN && WS_P + (size_t)M * PP * 2 <= WS_SM, "d_ws map");
constexpr int CW_TMO = 0, CW_CODE = 1, CW_BAR = 4096;
constexpr int RING_OFF = 0, RING_BYTES = 131072;
constexpr int LDSCTL_OFF = RING_BYTES, MISC_OFF = LDSCTL_OFF + 320;
constexpr int LDS_BYTES = 147456;
#define GAS __attribute__((address_space(1)))
#define LAS __attribute__((address_space(3)))
typedef unsigned short bf16;
typedef unsigned v4u __attribute__((ext_vector_type(4)));
typedef unsigned v2u __attribute__((ext_vector_type(2)));
typedef float f32x4 __attribute__((ext_vector_type(4)));
typedef float f32x16 __attribute__((ext_vector_type(16)));
typedef short bf16x8 __attribute__((ext_vector_type(8)));
typedef short s16x4 __attribute__((ext_vector_type(4)));
typedef GAS unsigned gu32;
#define RLX_AGENT __ATOMIC_RELAXED, __HIP_MEMORY_SCOPE_AGENT
#define LDS_WAIT() asm volatile("s_waitcnt lgkmcnt(0)" ::: "memory")
#define VM_WAIT() asm volatile("s_waitcnt vmcnt(0)" ::: "memory")
__device__ __forceinline__ unsigned f2bf(float f) { unsigned u = __builtin_bit_cast(unsigned, f); return (u + 0x7fffu + ((u >> 16) & 1u)) >> 16; }
__device__ __forceinline__ unsigned pk2(float lo, float hi) { return f2bf(lo) | (f2bf(hi) << 16); }
__device__ __forceinline__ float bf2f(unsigned v) { return __builtin_bit_cast(float, v << 16); }
__device__ __forceinline__ float silu_f(float x) { return x / (1.0f + __expf(-x)); }
__device__ __forceinline__ float sigmoid_f(float x) { return 1.0f / (1.0f + __expf(-x)); }
__device__ __forceinline__ float softplus_f(float x) { return x > 20.f ? x : log1pf(__expf(x)); }
__device__ __forceinline__ float wave_sum(float v) {
#pragma unroll
    for (int o = 1; o < 64; o <<= 1) v += __shfl_xor(v, o);
    return v;
}
#define XB_TMO      128
#define XB_XCNT(j)  (256  + 64 * (j))
#define XB_XSUB(j)  (1280 + 64 * (j))
#define XB_XGEN(j)  (2304 + 64 * (j))
#define XB_TOP      3328
#define XB_TOPGEN   3392
#define XCD_BAR_WORDS 3456
#define XB_SPIN_CAP (1u << 18)

__device__ __forceinline__ unsigned xb_ld(unsigned* p)              { return __hip_atomic_load(p, __ATOMIC_RELAXED, __HIP_MEMORY_SCOPE_AGENT); }
__device__ __forceinline__ unsigned xb_add(unsigned* p, unsigned v) { return __hip_atomic_fetch_add(p, v, __ATOMIC_RELAXED, __HIP_MEMORY_SCOPE_AGENT); }
__device__ __forceinline__ unsigned xb_xcc_id() { return (unsigned)__builtin_amdgcn_s_getreg((3 << 11) | 20) & 0xFu; }
#define XB_SPIN(cond, bar) do { unsigned _sp = 0; while (cond) { __builtin_amdgcn_s_sleep(1); \
    if ((++_sp & 255u) == 0u) { if (xb_ld(&(bar)[XB_TMO])) break; if (_sp > XB_SPIN_CAP) { atomicAdd(&(bar)[XB_TMO], 1u); break; } } } } while (0)

struct XcdBarrier {
    unsigned* bar; unsigned x;
    volatile LAS unsigned* st;
};

__device__ __forceinline__ XcdBarrier xcd_barrier_post(unsigned* bar, volatile LAS unsigned* st) {
    XcdBarrier b; b.bar = bar; b.x = xb_xcc_id(); b.st = st;
    if (threadIdx.x == 0) (void)xb_add(&bar[XB_XCNT(b.x)], 1u);
    return b;
}
__device__ __forceinline__ void xcd_barrier_complete(unsigned* bar, unsigned x, unsigned& nloc, unsigned& nx) {
    const unsigned G = gridDim.x * gridDim.y * gridDim.z;
    unsigned sum, cnt, mine, sp = 0u;
    for (;;) {
        sum = 0u; cnt = 0u; mine = 0u;
#pragma unroll
        for (unsigned j = 0; j < 16; ++j) { const unsigned c = xb_ld(&bar[XB_XCNT(j)]); sum += c; cnt += (c > 0u) ? 1u : 0u; mine = (j == x) ? c : mine; }
        if (sum == G) break;
        __builtin_amdgcn_s_sleep(1);
        if ((++sp & 255u) == 0u) { if (xb_ld(&bar[XB_TMO])) break; if (sp > XB_SPIN_CAP) { atomicAdd(&bar[XB_TMO], 1u); break; } }
    }
    nloc = mine > 0u ? mine : 1u; nx = cnt > 0u ? cnt : 1u;
}

__device__ __forceinline__ void xcd_barrier(const XcdBarrier& b) {
    asm volatile("s_waitcnt vmcnt(0)" ::: "memory");
    __syncthreads();
    if (threadIdx.x == 0) {
        unsigned* bar = b.bar;
        __builtin_amdgcn_s_waitcnt(0);
        unsigned nloc = b.st[0], nx = b.st[1];
        if (nloc == 0u) { xcd_barrier_complete(bar, b.x, nloc, nx); b.st[0] = nloc; b.st[1] = nx; }
        const unsigned old = xb_add(&bar[XB_XSUB(b.x)], 1u);
        const unsigned gen = old / nloc;
        if (old + 1u == (gen + 1u) * nloc) {
            __builtin_amdgcn_fence(__ATOMIC_RELEASE, "agent");
            asm volatile("s_waitcnt vmcnt(0)" ::: "memory");
            const unsigned og = xb_add(&bar[XB_TOP], 1u);
            const unsigned tg = og / nx;
            if (og + 1u == (tg + 1u) * nx) xb_add(&bar[XB_TOPGEN], 1u);
            else XB_SPIN(xb_ld(&bar[XB_TOPGEN]) == tg, bar);
            __builtin_amdgcn_fence(__ATOMIC_ACQUIRE, "agent");
            xb_add(&bar[XB_XGEN(b.x)], 1u);
            asm volatile("s_waitcnt vmcnt(0)" ::: "memory");
        } else {
            XB_SPIN(xb_ld(&bar[XB_XGEN(b.x)]) == gen, bar);
            __builtin_amdgcn_fence(__ATOMIC_ACQUIRE, "agent");
            asm volatile("s_waitcnt vmcnt(0)" ::: "memory");
        }
    }
    __syncthreads();
}
struct Frame {
    unsigned char* lds;
    volatile LAS unsigned* MISC;
    gu32* ctl;
    int tid, lane, wave;
    int vcu, G;
    const float* const* in;
    float* out; unsigned char* ws;
};
__device__ const double ROPE_INVF[16] = {1.0, 0.5623413251903491, 0.31622776601683794, 0.1778279410038923, 0.1, 0.05623413251903491, 0.03162277660168379, 0.01778279410038923,
    0.01, 0.005623413251903491, 0.0031622776601683794, 0.0017782794100389228, 0.001, 0.0005623413251903491, 0.00031622776601683794, 0.00017782794100389227};

template <int MODE> __device__ __forceinline__ int rowmap(int n) {
    if (MODE == 0) return n;
    if (MODE == 1) return (n >> 7) * 256 + (n & 127);
    if (MODE == 2) return (n >> 7) * 256 + 128 + (n & 127);
    if (n < 1024) return n;
    if (n < 1032) return 3840 + (n - 1024);
    if (n < 2824) return n - 8;
    if (n < 2828) return 3848 + (n - 2824);
    if (n < 3852) return n - 12;
    return n;
}
template <int MODE> __device__ __forceinline__ void p0_transpose_item(const float* W, int K, int N, bf16* WT, float* scr, int item, int lane) {
    const int nblk = (N + 31) / 32, kb = item / nblk, nb = item % nblk, k0 = 64 * kb, n0 = 32 * nb;
    const int nn = n0 + (lane & 31);
#pragma unroll 8
    for (int i = 0; i < 32; ++i) { const int kk = 2 * i + (lane >> 5); scr[kk * 33 + (lane & 31)] = nn < N ? W[(size_t)(k0 + kk) * N + nn] : 0.f; }
    LDS_WAIT(); asm volatile("" ::: "memory");
    const int c = lane & 7;
#pragma unroll
    for (int j = 0; j < 4; ++j) { const int n = (lane >> 3) + 8 * j; const float* s = scr + (8 * c) * 33 + n;
        v4u o; o.x = pk2(s[0 * 33], s[1 * 33]); o.y = pk2(s[2 * 33], s[3 * 33]); o.z = pk2(s[4 * 33], s[5 * 33]); o.w = pk2(s[6 * 33], s[7 * 33]);
        if (n0 + n < N) *(v4u*)(WT + (size_t)rowmap<MODE>(n0 + n) * K + k0 + 8 * c) = o; }
    LDS_WAIT(); asm volatile("" ::: "memory");
}
__device__ __forceinline__ void p0_prologue(Frame& F) {
    float* scr = (float*)(F.lds + RING_OFF + F.wave * 16384);
    const int gw = F.vcu * NWAVES + F.wave, NGW = F.G * NWAVES;
    constexpr int I_GATE = (D / 64) * (FF / 32), I_DOWN = (FF / 64) * (D / 32), I_IN = (D / 64) * ((INC + 31) / 32), I_OUT = (D / 64) * (D / 32);
    constexpr int PER_LAYER = 4 * I_GATE + 2 * I_DOWN + I_IN + I_OUT;
    for (int it = gw; it < NLAYER * PER_LAYER; it += NGW) {
        const int l = it / PER_LAYER; int r = it % PER_LAYER;
        unsigned char* wl = F.ws + WS_W + (size_t)l * W_LAYER;
        if (r < I_GATE) { p0_transpose_item<1>(F.in[I_F1G] + (size_t)l * D * FF, D, FF, (bf16*)(wl + WL_GU1), scr, r, F.lane); continue; } r -= I_GATE;
        if (r < I_GATE) { p0_transpose_item<2>(F.in[I_F1U] + (size_t)l * D * FF, D, FF, (bf16*)(wl + WL_GU1), scr, r, F.lane); continue; } r -= I_GATE;
        if (r < I_DOWN) { p0_transpose_item<0>(F.in[I_F1D] + (size_t)l * D * FF, FF, D, (bf16*)(wl + WL_D1), scr, r, F.lane); continue; } r -= I_DOWN;
        if (r < I_IN)   { p0_transpose_item<3>(F.in[I_WIN] + (size_t)l * D * INC, D, INC, (bf16*)(wl + WL_IN), scr, r, F.lane); continue; } r -= I_IN;
        if (r < I_OUT)  { p0_transpose_item<0>(F.in[I_WOUT] + (size_t)l * D * D, D, D, (bf16*)(wl + WL_OUT), scr, r, F.lane); continue; } r -= I_OUT;
        if (r < I_GATE) { p0_transpose_item<1>(F.in[I_F2G] + (size_t)l * D * FF, D, FF, (bf16*)(wl + WL_GU2), scr, r, F.lane); continue; } r -= I_GATE;
        if (r < I_GATE) { p0_transpose_item<2>(F.in[I_F2U] + (size_t)l * D * FF, D, FF, (bf16*)(wl + WL_GU2), scr, r, F.lane); continue; } r -= I_GATE;
        p0_transpose_item<0>(F.in[I_F2D] + (size_t)l * D * FF, FF, D, (bf16*)(wl + WL_D2), scr, r, F.lane);
    }
    const int gt = F.vcu * NWAVES * 64 + F.tid, NGT = F.G * NWAVES * 64;
    for (int i = gt; i < NLAYER * 236 * 128; i += NGT) { const int l = i / (236 * 128), r = i % (236 * 128);
        *(v4u*)(F.ws + WS_W + (size_t)l * W_LAYER + WL_IN + (size_t)INC * D * 2 + (size_t)r * 16) = (v4u){0u, 0u, 0u, 0u}; }
    float* ct = (float*)(F.ws + WS_ROPE); float* st = ct + SEQ * 16;
    for (int i = gt; i < SEQ * 16; i += NGT) { const int pos = i >> 4, f = i & 15;
        const double rev = (double)pos * ROPE_INVF[f] * 0.15915494309189535; const float fr = (float)(rev - __builtin_floor(rev));
        ct[i] = __builtin_amdgcn_cosf(fr); st[i] = __builtin_amdgcn_sinf(fr); }
}
__device__ __forceinline__ void post_rows(Frame& F, const float* xsrc, const bf16* Y, float coef, const float* g_post, float* xdst, const float* g_pre, bf16* XN, bool has_y, bool write_x, bool write_xn) {
    const int gw = F.vcu * NWAVES + F.wave, NGW = F.G * NWAVES;
    f32x4 gp[4], gn[4];
#pragma unroll
    for (int j = 0; j < 4; ++j) { gp[j] = has_y ? *(const f32x4*)(g_post + 4 * F.lane + 256 * j) : (f32x4){0.f, 0.f, 0.f, 0.f}; gn[j] = write_xn ? *(const f32x4*)(g_pre + 4 * F.lane + 256 * j) : (f32x4){0.f, 0.f, 0.f, 0.f}; }
    for (int m = gw; m < M; m += NGW) {
        f32x4 v[4];
#pragma unroll
        for (int j = 0; j < 4; ++j) v[j] = *(const f32x4*)(xsrc + (size_t)m * D + 4 * F.lane + 256 * j);
        if (has_y) {
            f32x4 y[4]; float s = 0.f;
#pragma unroll
            for (int j = 0; j < 4; ++j) { const v2u w = *(const v2u*)(Y + (size_t)m * D + 4 * F.lane + 256 * j);
                y[j] = (f32x4){bf2f(w.x & 0xffffu), bf2f(w.x >> 16), bf2f(w.y & 0xffffu), bf2f(w.y >> 16)};
                s += (y[j].x * y[j].x + y[j].y * y[j].y) + (y[j].z * y[j].z + y[j].w * y[j].w); }
            const float r = coef / sqrtf(wave_sum(s) * (1.f / D) + EPS);
#pragma unroll
            for (int j = 0; j < 4; ++j) v[j] = v[j] + y[j] * gp[j] * r;
        }
        if (write_x) {
#pragma unroll
            for (int j = 0; j < 4; ++j) *(f32x4*)(xdst + (size_t)m * D + 4 * F.lane + 256 * j) = v[j];
        }
        if (write_xn) {
            float s2 = 0.f;
#pragma unroll
            for (int j = 0; j < 4; ++j) s2 += (v[j].x * v[j].x + v[j].y * v[j].y) + (v[j].z * v[j].z + v[j].w * v[j].w);
            const float r2 = 1.f / sqrtf(wave_sum(s2) * (1.f / D) + EPS);
#pragma unroll
            for (int j = 0; j < 4; ++j) { const f32x4 o = v[j] * gn[j] * r2; v2u w; w.x = pk2(o.x, o.y); w.y = pk2(o.z, o.w);
                *(v2u*)(XN + (size_t)m * D + 4 * F.lane + 256 * j) = w; }
        }
    }
}
__device__ __forceinline__ void rope_phase(Frame& F, bf16* P) {
    const float* ct = (const float*)(F.ws + WS_ROPE); const float* st = ct + SEQ * 16;
    const int gt = F.vcu * NWAVES * 64 + F.tid, NGT = F.G * NWAVES * 64;
    for (int it = gt; it < M * 16; it += NGT) {
        const int row = it >> 4, hd = it & 15, pos = row & (SEQ - 1);
        bf16* p = P + (size_t)row * PP + B_Q + 32 * hd;
        const float sc = hd < 8 ? 0.17677669529663687f * 1.4426950408889634f : 1.0f;
        v4u a0 = *(v4u*)p, a1 = *(v4u*)(p + 8), b0 = *(v4u*)(p + 16), b1 = *(v4u*)(p + 24);
        unsigned t1[8] = {a0.x, a0.y, a0.z, a0.w, a1.x, a1.y, a1.z, a1.w}, t2[8] = {b0.x, b0.y, b0.z, b0.w, b1.x, b1.y, b1.z, b1.w};
        unsigned o1[8], o2[8];
#pragma unroll
        for (int i = 0; i < 8; ++i) {
            const float c0 = ct[pos * 16 + 2 * i], c1 = ct[pos * 16 + 2 * i + 1], s0 = st[pos * 16 + 2 * i], s1 = st[pos * 16 + 2 * i + 1];
            const float x0 = bf2f(t1[i] & 0xffffu), x1 = bf2f(t1[i] >> 16), y0 = bf2f(t2[i] & 0xffffu), y1 = bf2f(t2[i] >> 16);
            o1[i] = pk2((x0 * c0 - y0 * s0) * sc, (x1 * c1 - y1 * s1) * sc);
            o2[i] = pk2((y0 * c0 + x0 * s0) * sc, (y1 * c1 + x1 * s1) * sc);
        }
        *(v4u*)p = (v4u){o1[0], o1[1], o1[2], o1[3]}; *(v4u*)(p + 8) = (v4u){o1[4], o1[5], o1[6], o1[7]};
        *(v4u*)(p + 16) = (v4u){o2[0], o2[1], o2[2], o2[3]}; *(v4u*)(p + 24) = (v4u){o2[4], o2[5], o2[6], o2[7]};
    }
}
template <int NT, int KS> __device__ __forceinline__ void mma_nt(f32x4 (&acc)[NT], const unsigned char* X, int ldx, int x0, const unsigned char* Y, int ldy, int y0, int lane) {
    const int fr = lane & 15, fq = lane >> 4;
#pragma unroll
    for (int ks = 0; ks < KS; ++ks) {
        const bf16x8 a = *(const bf16x8*)(X + (x0 + fr) * ldx + (ks * 32 + 8 * fq) * 2);
#pragma unroll
        for (int t = 0; t < NT; ++t) { const bf16x8 b = *(const bf16x8*)(Y + (y0 + 16 * t + fr) * ldy + (ks * 32 + 8 * fq) * 2);
            acc[t] = __builtin_amdgcn_mfma_f32_16x16x32_bf16(a, b, acc[t], 0, 0, 0); }
    }
}
__device__ __forceinline__ v2u pk4(float a, float b, float c, float d) { v2u w; w.x = pk2(a, b); w.y = pk2(c, d); return w; }
__device__ __forceinline__ v4u pk8(const float (&v)[8]) { v4u w; w.x = pk2(v[0], v[1]); w.y = pk2(v[2], v[3]); w.z = pk2(v[4], v[5]); w.w = pk2(v[6], v[7]); return w; }
__device__ __forceinline__ void unpk8(const v4u w, float (&v)[8]) { v[0] = bf2f(w.x & 0xffffu); v[1] = bf2f(w.x >> 16); v[2] = bf2f(w.y & 0xffffu); v[3] = bf2f(w.y >> 16); v[4] = bf2f(w.z & 0xffffu); v[5] = bf2f(w.z >> 16); v[6] = bf2f(w.w & 0xffffu); v[7] = bf2f(w.w >> 16); }
__device__ __forceinline__ float wave_scan_add(float v, int lane) {
#pragma unroll
    for (int o = 1; o < 64; o <<= 1) { const float t = __shfl_up(v, o); if (lane >= o) v += t; }
    return v;
}
__device__ __forceinline__ float wave_scan_max(float v, int lane) {
#pragma unroll
    for (int o = 1; o < 64; o <<= 1) { const float t = __shfl_up(v, o); if (lane >= o) v = fmaxf(v, t); }
    return v;
}
__device__ __forceinline__ float wave_max(float v) {
#pragma unroll
    for (int o = 1; o < 64; o <<= 1) v = fmaxf(v, __shfl_xor(v, o));
    return v;
}
__device__ __forceinline__ void conv8(const bf16* src, int row, int pos, const float* w, int wstride, float (&out)[8]) {
#pragma unroll
    for (int i = 0; i < 8; ++i) out[i] = 0.f;
#pragma unroll
    for (int j = 0; j < 4; ++j) {
        const int dp = j - 3;
        if (pos + dp >= 0) {
            float r[8]; unpk8(*(const v4u*)(src + (size_t)(row + dp) * PP), r);
            const f32x4 w0 = *(const f32x4*)(w + j * wstride), w1 = *(const f32x4*)(w + j * wstride + 4);
            out[0] += w0.x * r[0]; out[1] += w0.y * r[1]; out[2] += w0.z * r[2]; out[3] += w0.w * r[3];
            out[4] += w1.x * r[4]; out[5] += w1.y * r[5]; out[6] += w1.z * r[6]; out[7] += w1.w * r[7];
        }
    }
}
constexpr size_t WS_GT = WS_Y;
constexpr size_t WS_SST = 460 * MiB;
constexpr size_t WS_MKC = 492 * MiB;
constexpr size_t WS_SCAL = 508 * MiB;
constexpr size_t SC_GL = 0, SC_ACS = 8192, SC_BB = SC_ACS + 524288, SC_DM = SC_BB + 524288, SC_DEN = SC_DM + 524288, SC_NC = SC_DEN + 524288, SC_MU = SC_NC + 524288, SC_END = SC_MU + 16384;
static_assert(WS_SCAL + SC_END <= 511 * MiB, "scalars");
constexpr int T72 = 144;
__device__ __forceinline__ void gdn_local_unit(Frame& F, int l, int u, unsigned char* lds) {
    const int tid = F.tid, lane = F.lane, w = F.wave;
    const int b = u >> 8, h = (u >> 6) & 3, n = u & 63, row0 = b * SEQ + n * 64;
    const bf16* P = (const bf16*)(F.ws + WS_P); const float* SM = (const float*)(F.ws + WS_SM); bf16* MIX = (bf16*)(F.ws + WS_XN);
    bf16* GT = (bf16*)(F.ws + WS_GT) + (size_t)u * 4 * 4096;
    unsigned char* KN = lds; unsigned char* QN = lds + 9216; float* RHS = (float*)(lds + 18432); float* Lm = (float*)(lds + 51200); unsigned char* KDT = lds + 67584;
    float* sbeta = (float*)(lds + 76800); float* sgc = (float*)(lds + 77056);
    if (w == 0) {
        const float* sm = SM + (size_t)(row0 + lane) * 32;
        const float Aneg = -expf(F.in[I_GALOG][l * 4 + h]), dtb = F.in[I_GDTB][l * 4 + h];
        const float g = Aneg * softplus_f(sm[SM_A + h] + dtb);
        const float gc = wave_scan_add(g, lane);
        sbeta[lane] = sigmoid_f(sm[SM_BETA + h]); sgc[lane] = gc;
        if (lane == 63) ((float*)(F.ws + WS_SCAL + SC_GL))[u] = expf(gc);
    }
    const int t = tid >> 3, cg = tid & 7, pos = n * 64 + t;
    const float* cw = F.in[I_GCONV] + (size_t)l * 4 * 768 + 64 * h + 8 * cg;
    float q8[8], k8[8], v8[8];
    conv8(P + A_Q + 64 * h + 8 * cg, row0 + t, pos, cw, 768, q8);
    conv8(P + A_K + 64 * h + 8 * cg, row0 + t, pos, cw + 256, 768, k8);
    conv8(P + A_V + 64 * h + 8 * cg, row0 + t, pos, cw + 512, 768, v8);
    float sq = 0.f, sk = 0.f;
#pragma unroll
    for (int i = 0; i < 8; ++i) { q8[i] = silu_f(q8[i]); k8[i] = silu_f(k8[i]); v8[i] = silu_f(v8[i]); sq += q8[i] * q8[i]; sk += k8[i] * k8[i]; }
    sq += __shfl_xor(sq, 1); sq += __shfl_xor(sq, 2); sq += __shfl_xor(sq, 4);
    sk += __shfl_xor(sk, 1); sk += __shfl_xor(sk, 2); sk += __shfl_xor(sk, 4);
    const float rq = 0.125f / sqrtf(sq + EPS), rk = 1.0f / sqrtf(sk + EPS);
#pragma unroll
    for (int i = 0; i < 8; ++i) { q8[i] *= rq; k8[i] *= rk; }
    __syncthreads();
    {
        const float be = sbeta[t], gct = sgc[t], eg = expf(gct), egl = expf(sgc[63] - gct);
        *(v4u*)(KN + t * T72 + cg * 16) = pk8(k8); *(v4u*)(QN + t * T72 + cg * 16) = pk8(q8);
        float tmp[8];
#pragma unroll
        for (int i = 0; i < 8; ++i) tmp[i] = q8[i] * eg;
        *(v4u*)(GT + 2 * 4096 + t * 64 + cg * 8) = pk8(tmp);
#pragma unroll
        for (int i = 0; i < 8; ++i) { RHS[t * 128 + 8 * cg + i] = v8[i] * be; RHS[t * 128 + 64 + 8 * cg + i] = k8[i] * be * eg;
            *(unsigned short*)(KDT + (8 * cg + i) * T72 + t * 2) = (unsigned short)f2bf(k8[i] * egl); }
    }
    __syncthreads();
    {
        const int fr = lane & 15, fq = lane >> 4, m0 = 16 * (w & 3) + 4 * fq;
        f32x4 acc[4];
#pragma unroll
        for (int tt = 0; tt < 4; ++tt) acc[tt] = (f32x4){0.f, 0.f, 0.f, 0.f};
        mma_nt<4, 2>(acc, KN, T72, 16 * (w & 3), (w < 4) ? KN : QN, T72, 0, lane);
        const float gm0 = sgc[m0], gm1 = sgc[m0 + 1], gm2 = sgc[m0 + 2], gm3 = sgc[m0 + 3];
#pragma unroll
        for (int tt = 0; tt < 4; ++tt) { const int c = 16 * tt + fr; const float gcc = sgc[c];
            if (w < 4) { const float be = sbeta[c];
                f32x4 o; o.x = (m0 < c) ? be * acc[tt].x * expf(gcc - gm0) : 0.f; o.y = (m0 + 1 < c) ? be * acc[tt].y * expf(gcc - gm1) : 0.f;
                o.z = (m0 + 2 < c) ? be * acc[tt].z * expf(gcc - gm2) : 0.f; o.w = (m0 + 3 < c) ? be * acc[tt].w * expf(gcc - gm3) : 0.f;
                *(f32x4*)(Lm + c * 64 + m0) = o;
            } else {
                const float a0 = (m0 <= c) ? acc[tt].x * expf(gcc - gm0) : 0.f, a1 = (m0 + 1 <= c) ? acc[tt].y * expf(gcc - gm1) : 0.f;
                const float a2 = (m0 + 2 <= c) ? acc[tt].z * expf(gcc - gm2) : 0.f, a3 = (m0 + 3 <= c) ? acc[tt].w * expf(gcc - gm3) : 0.f;
                *(v2u*)(GT + 1 * 4096 + c * 64 + m0) = pk4(a0, a1, a2, a3);
            } }
    }
    __syncthreads();
    if (w < 2) {
        const int col = tid;
        float x[64];
#pragma unroll
        for (int r = 0; r < 64; ++r) x[r] = RHS[r * 128 + col];
#pragma unroll
        for (int r = 1; r < 64; ++r) {
            float s0 = 0.f, s1 = 0.f;
#pragma unroll
            for (int m4 = 0; m4 < (r + 3) / 4; ++m4) { const f32x4 lv = *(const f32x4*)(Lm + r * 64 + 4 * m4);
                s0 += lv.x * x[4 * m4] + lv.z * x[4 * m4 + 2]; s1 += lv.y * x[4 * m4 + 1] + lv.w * x[4 * m4 + 3]; }
            x[r] -= s0 + s1;
            asm volatile("" : "+v"(x[r]) :: "memory");
        }
        if (col < 64) {
#pragma unroll
            for (int r = 0; r < 64; ++r) MIX[(size_t)(row0 + r) * D + 64 * h + col] = (bf16)f2bf(x[r]);
        } else {
#pragma unroll
            for (int r = 0; r < 64; ++r) GT[r * 64 + (col - 64)] = (bf16)f2bf(-x[r]);
        }
    } else {
        for (int i = tid - 128; i < 512; i += 384) { const int d = i >> 3, pc = i & 7; *(v4u*)(GT + 3 * 4096 + d * 64 + pc * 8) = *(const v4u*)(KDT + d * T72 + pc * 16); }
    }
    __syncthreads();
}
__device__ __forceinline__ void gdn_chain(Frame& F, int l, int b, int h, unsigned char* lds) {
    const int tid = F.tid, lane = F.lane, w = F.wave, fr = lane & 15, fq = lane >> 4, wm = w >> 1, wn = w & 1;
    const bf16* P = (const bf16*)(F.ws + WS_P); bf16* MIX = (bf16*)(F.ws + WS_XN);
    const float* GL = (const float*)(F.ws + WS_SCAL + SC_GL);
    unsigned char* WN = lds; unsigned char* AT = lds + 9216; unsigned char* QD = lds + 18432; unsigned char* KDT = lds + 27648; unsigned char* UU = lds + 36864;
    unsigned char* ST[2] = {lds + 46080, lds + 55296}; unsigned char* VNT = lds + 64512; float* O = (float*)(lds + 73728);
    const int r = tid >> 3, pc = tid & 7;
    for (int i = tid; i < 9216 / 4; i += 512) ((unsigned*)ST[0])[i] = 0u;
    f32x4 S[2] = {(f32x4){0.f, 0.f, 0.f, 0.f}, (f32x4){0.f, 0.f, 0.f, 0.f}};
    float ng[8];
#pragma unroll
    for (int i = 0; i < 8; ++i) ng[i] = F.in[I_GNORM][l * 64 + 8 * pc + i];
    const int u0 = (b * 4 + h) * 64;
    const bf16* gt = (const bf16*)(F.ws + WS_GT) + (size_t)u0 * 4 * 4096 + r * 64 + pc * 8;
    v4u pw = *(const v4u*)(gt), pa = *(const v4u*)(gt + 4096), pq = *(const v4u*)(gt + 2 * 4096), pk = *(const v4u*)(gt + 3 * 4096);
    v4u pu = *(const v4u*)(MIX + (size_t)(b * SEQ + r) * D + 64 * h + 8 * pc);
    float gl = GL[u0];
    for (int n = 0; n < 64; ++n) {
        const int row0 = b * SEQ + n * 64, cur = n & 1;
        *(v4u*)(WN + r * T72 + pc * 16) = pw; *(v4u*)(AT + r * T72 + pc * 16) = pa; *(v4u*)(QD + r * T72 + pc * 16) = pq; *(v4u*)(KDT + r * T72 + pc * 16) = pk; *(v4u*)(UU + r * T72 + pc * 16) = pu;
        const float glc = gl;
        const v4u gate = *(const v4u*)(P + (size_t)(row0 + r) * PP + A_G + 64 * h + 8 * pc);
        if (n + 1 < 64) { const bf16* g2 = gt + (size_t)(n + 1) * 4 * 4096;
            pw = *(const v4u*)(g2); pa = *(const v4u*)(g2 + 4096); pq = *(const v4u*)(g2 + 2 * 4096); pk = *(const v4u*)(g2 + 3 * 4096);
            pu = *(const v4u*)(MIX + (size_t)(row0 + 64 + r) * D + 64 * h + 8 * pc); gl = GL[u0 + n + 1]; }
        __syncthreads();
        {
            f32x4 a1[2];
#pragma unroll
            for (int t = 0; t < 2; ++t) { const int e = 32 * wn + 16 * t + fr;
#pragma unroll
                for (int j = 0; j < 4; ++j) a1[t][j] = bf2f(*(const unsigned short*)(UU + (16 * wm + 4 * fq + j) * T72 + e * 2)); }
            mma_nt<2, 2>(a1, WN, T72, 16 * wm, ST[cur], T72, 32 * wn, lane);
#pragma unroll
            for (int t = 0; t < 2; ++t) *(v2u*)(VNT + (32 * wn + 16 * t + fr) * T72 + (16 * wm + 4 * fq) * 2) = pk4(a1[t].x, a1[t].y, a1[t].z, a1[t].w);
        }
        __syncthreads();
        {
            f32x4 o[2] = {(f32x4){0.f, 0.f, 0.f, 0.f}, (f32x4){0.f, 0.f, 0.f, 0.f}};
            mma_nt<2, 2>(o, QD, T72, 16 * wm, ST[cur], T72, 32 * wn, lane);
            mma_nt<2, 2>(o, AT, T72, 16 * wm, VNT, T72, 32 * wn, lane);
#pragma unroll
            for (int t = 0; t < 2; ++t)
#pragma unroll
                for (int j = 0; j < 4; ++j) O[(16 * wm + 4 * fq + j) * 65 + 32 * wn + 16 * t + fr] = o[t][j];
            S[0] = S[0] * glc; S[1] = S[1] * glc;
            mma_nt<2, 2>(S, KDT, T72, 16 * wm, VNT, T72, 32 * wn, lane);
#pragma unroll
            for (int t = 0; t < 2; ++t) *(v2u*)(ST[cur ^ 1] + (32 * wn + 16 * t + fr) * T72 + (16 * wm + 4 * fq) * 2) = pk4(S[t].x, S[t].y, S[t].z, S[t].w);
        }
        __syncthreads();
        {
            float ov[8], gv[8]; float ss = 0.f;
#pragma unroll
            for (int i = 0; i < 8; ++i) { ov[i] = O[r * 65 + 8 * pc + i]; ss += ov[i] * ov[i]; }
            ss += __shfl_xor(ss, 1); ss += __shfl_xor(ss, 2); ss += __shfl_xor(ss, 4);
            const float rr = 1.0f / sqrtf(ss * (1.f / 64.f) + EPS);
            unpk8(gate, gv);
#pragma unroll
            for (int i = 0; i < 8; ++i) ov[i] = ov[i] * rr * ng[i] * silu_f(gv[i]);
            *(v4u*)(MIX + (size_t)(row0 + r) * D + 64 * h + 8 * pc) = pk8(ov);
        }
    }
    __syncthreads();
}
constexpr int T136 = 272;
__device__ __forceinline__ void ssd_local_unit(Frame& F, int l, int u, unsigned char* lds) {
    const int tid = F.tid, lane = F.lane, w = F.wave, fr = lane & 15, fq = lane >> 4;
    const int b = u >> 7, g = (u >> 6) & 1, n = u & 63, row0 = b * SEQ + n * 64;
    const bf16* P = (const bf16*)(F.ws + WS_P); const float* SM = (const float*)(F.ws + WS_SM); bf16* MIX = (bf16*)(F.ws + WS_XN);
    unsigned char* CM = lds; unsigned char* BM = lds + 17408; unsigned char* BMT = lds + 34816; unsigned char* XDT = lds + 53248; unsigned char* XST = lds + 71680; unsigned char* LD = lds + 90112;
    float* sacs = (float*)(lds + 108544); float* sdt = (float*)(lds + 109056);
    if (w < 2) {
        const int h = 2 * g + w;
        const float dt = softplus_f(SM[(size_t)(row0 + lane) * 32 + SM_DT + h] + F.in[I_SDTB][l * 4 + h]);
        const float acs = wave_scan_add(dt * (-expf(F.in[I_SALOG][l * 4 + h])), lane);
        sdt[w * 64 + lane] = dt; sacs[w * 64 + lane] = acs;
        ((float*)(F.ws + WS_SCAL + SC_ACS))[(size_t)(b * 4 + h) * SEQ + n * 64 + lane] = acs;
    }
    const int t = tid >> 3, cg = tid & 7, pos = n * 64 + t;
    const float* cw = F.in[I_SCONVW] + (size_t)l * 4 * 768; const float* cb = F.in[I_SCONVB] + (size_t)l * 768;
    float val[6][8];
#pragma unroll
    for (int k = 0; k < 6; ++k) {
        const int chg = cg + 8 * k, ch = (k < 2) ? (128 * g + 8 * chg) : (k < 4) ? (256 + 128 * g + 8 * (chg - 16)) : (512 + 128 * g + 8 * (chg - 32));
        conv8(P + C_XBC + ch, row0 + t, pos, cw + ch, 768, val[k]);
#pragma unroll
        for (int i = 0; i < 8; ++i) val[k][i] = silu_f(val[k][i] + cb[ch + i]);
    }
    __syncthreads();
#pragma unroll
    for (int k = 0; k < 6; ++k) {
        const int chg = cg + 8 * k;
        if (k < 2) { const int hh = k, p0 = 8 * cg; const float dt = sdt[hh * 64 + t], ds = expf(sacs[hh * 64 + 63] - sacs[hh * 64 + t]);
#pragma unroll
            for (int i = 0; i < 8; ++i) { const float xd = val[k][i] * dt;
                *(unsigned short*)(XDT + hh * 9216 + (p0 + i) * T72 + t * 2) = (unsigned short)f2bf(xd);
                *(unsigned short*)(XST + hh * 9216 + (p0 + i) * T72 + t * 2) = (unsigned short)f2bf(xd * ds); }
        } else if (k < 4) { const int n0 = 8 * (chg - 16);
            *(v4u*)(BM + t * T136 + n0 * 2) = pk8(val[k]);
#pragma unroll
            for (int i = 0; i < 8; ++i) *(unsigned short*)(BMT + (n0 + i) * T72 + t * 2) = (unsigned short)f2bf(val[k][i]);
        } else { const int n0 = 8 * (chg - 32); *(v4u*)(CM + t * T136 + n0 * 2) = pk8(val[k]); }
    }
    __syncthreads();
    {
        f32x4 acc[2] = {(f32x4){0.f, 0.f, 0.f, 0.f}, (f32x4){0.f, 0.f, 0.f, 0.f}};
        mma_nt<2, 4>(acc, BM, T136, 16 * (w & 3), CM, T136, 32 * (w >> 2), lane);
        const int m0 = 16 * (w & 3) + 4 * fq;
#pragma unroll
        for (int hh = 0; hh < 2; ++hh) { const float Dh = F.in[I_SD][l * 4 + 2 * g + hh];
#pragma unroll
            for (int tt = 0; tt < 2; ++tt) { const int lr = 32 * (w >> 2) + 16 * tt + fr; const float al = sacs[hh * 64 + lr];
                float o[4];
#pragma unroll
                for (int j = 0; j < 4; ++j) { const int m = m0 + j; o[j] = (m <= lr) ? acc[tt][j] * expf(al - sacs[hh * 64 + m]) : 0.f; if (m == lr) o[j] += Dh / sdt[hh * 64 + lr]; }
                *(v2u*)(LD + hh * 9216 + lr * T72 + m0 * 2) = pk4(o[0], o[1], o[2], o[3]); } }
    }
    __syncthreads();
    {
        const int hh = w >> 2, h = 2 * g + hh;
        f32x4 ya[4];
#pragma unroll
        for (int tt = 0; tt < 4; ++tt) ya[tt] = (f32x4){0.f, 0.f, 0.f, 0.f};
        mma_nt<4, 2>(ya, XDT + hh * 9216, T72, 16 * (w & 3), LD + hh * 9216, T72, 0, lane);
#pragma unroll
        for (int tt = 0; tt < 4; ++tt) *(v2u*)(MIX + (size_t)(row0 + 16 * tt + fr) * D + 512 + 64 * h + 16 * (w & 3) + 4 * fq) = pk4(ya[tt].x, ya[tt].y, ya[tt].z, ya[tt].w);
        bf16* STT = (bf16*)(F.ws + WS_SST) + ((size_t)(b * 4 + h) * 64 + n) * 8192;
#pragma unroll
        for (int k2 = 0; k2 < 2; ++k2) { const int rb = (w & 3) + 4 * k2;
            f32x4 sa[4];
#pragma unroll
            for (int tt = 0; tt < 4; ++tt) sa[tt] = (f32x4){0.f, 0.f, 0.f, 0.f};
            mma_nt<4, 2>(sa, BMT, T72, 16 * rb, XST + hh * 9216, T72, 0, lane);
#pragma unroll
            for (int tt = 0; tt < 4; ++tt) *(v2u*)(STT + (16 * tt + fr) * 128 + 16 * rb + 4 * fq) = pk4(sa[tt].x, sa[tt].y, sa[tt].z, sa[tt].w); }
    }
    __syncthreads();
}
__device__ __forceinline__ void ssd_chain(Frame& F, int l, int b, int g, unsigned char* lds) {
    const int tid = F.tid, lane = F.lane, w = F.wave, fr = lane & 15, fq = lane >> 4;
    const bf16* P = (const bf16*)(F.ws + WS_P); bf16* MIX = (bf16*)(F.ws + WS_XN);
    const float* ACS = (const float*)(F.ws + WS_SCAL + SC_ACS);
    unsigned char* CM = lds; unsigned char* PV = lds + 17408; float* YZ = (float*)(lds + 52224); float* seacs = (float*)(lds + 85248); float* sdal = (float*)(lds + 85760);
    const float* cw = F.in[I_SCONVW] + (size_t)l * 4 * 768; const float* cb = F.in[I_SCONVB] + (size_t)l * 768;
    float prev[2][2][8];
#pragma unroll
    for (int hh = 0; hh < 2; ++hh)
#pragma unroll
        for (int i = 0; i < 2; ++i)
#pragma unroll
            for (int e = 0; e < 8; ++e) prev[hh][i][e] = 0.f;
    const bf16* stt = (const bf16*)(F.ws + WS_SST) + (size_t)(b * 4 + 2 * g) * 64 * 8192;
    v4u pst[2][2];
#pragma unroll
    for (int hh = 0; hh < 2; ++hh)
#pragma unroll
        for (int i = 0; i < 2; ++i) pst[hh][i] = *(const v4u*)(stt + (size_t)hh * 64 * 8192 + (size_t)(tid + 512 * i) * 8);
    const int t = tid >> 3, cg = tid & 7;
    float ngv[16];
#pragma unroll
    for (int i = 0; i < 16; ++i) ngv[i] = F.in[I_SNORM][l * 256 + 128 * g + 16 * cg + i];
    for (int n = 0; n < 64; ++n) {
        const int row0 = b * SEQ + n * 64, pos = n * 64 + t;
#pragma unroll
        for (int k = 0; k < 2; ++k) { const int chg = cg + 8 * k, ch = 512 + 128 * g + 8 * chg; float v[8];
            conv8(P + C_XBC + ch, row0 + t, pos, cw + ch, 768, v);
#pragma unroll
            for (int i = 0; i < 8; ++i) v[i] = silu_f(v[i] + cb[ch + i]);
            *(v4u*)(CM + t * T136 + chg * 16) = pk8(v); }
#pragma unroll
        for (int hh = 0; hh < 2; ++hh)
#pragma unroll
            for (int i = 0; i < 2; ++i) { const int q = tid + 512 * i; *(v4u*)(PV + hh * 17408 + (q >> 4) * T136 + (q & 15) * 16) = pk8(prev[hh][i]); }
        if (tid < 128) { const int hh = tid >> 6, lr = tid & 63; const float a = ACS[(size_t)(b * 4 + 2 * g + hh) * SEQ + n * 64 + lr]; seacs[hh * 64 + lr] = expf(a); if (lr == 63) sdal[hh] = expf(a); }
        __syncthreads();
        {
            const int hh = w >> 2, h = 2 * g + hh, p0 = 16 * (w & 3) + 4 * fq;
            f32x4 ya[4];
#pragma unroll
            for (int tt = 0; tt < 4; ++tt) ya[tt] = (f32x4){0.f, 0.f, 0.f, 0.f};
            mma_nt<4, 4>(ya, PV + hh * 17408, T136, 16 * (w & 3), CM, T136, 0, lane);
#pragma unroll
            for (int tt = 0; tt < 4; ++tt) { const int lr = 16 * tt + fr;
                const v2u pp = *(const v2u*)(MIX + (size_t)(row0 + lr) * D + 512 + 64 * h + p0), zz = *(const v2u*)(P + (size_t)(row0 + lr) * PP + C_Z + 64 * h + p0);
                const float ea = seacs[hh * 64 + lr];
                const float y0 = ea * ya[tt].x + bf2f(pp.x & 0xffffu), y1 = ea * ya[tt].y + bf2f(pp.x >> 16), y2 = ea * ya[tt].z + bf2f(pp.y & 0xffffu), y3 = ea * ya[tt].w + bf2f(pp.y >> 16);
                float* yz = YZ + lr * 129 + 64 * hh + p0;
                yz[0] = y0 * silu_f(bf2f(zz.x & 0xffffu)); yz[1] = y1 * silu_f(bf2f(zz.x >> 16)); yz[2] = y2 * silu_f(bf2f(zz.y & 0xffffu)); yz[3] = y3 * silu_f(bf2f(zz.y >> 16)); }
        }
#pragma unroll
        for (int hh = 0; hh < 2; ++hh) { const float da = sdal[hh];
#pragma unroll
            for (int i = 0; i < 2; ++i) { float s8[8]; unpk8(pst[hh][i], s8);
#pragma unroll
                for (int e = 0; e < 8; ++e) prev[hh][i][e] = prev[hh][i][e] * da + s8[e]; } }
        if (n + 1 < 64) {
#pragma unroll
            for (int hh = 0; hh < 2; ++hh)
#pragma unroll
                for (int i = 0; i < 2; ++i) pst[hh][i] = *(const v4u*)(stt + ((size_t)hh * 64 + n + 1) * 8192 + (size_t)(tid + 512 * i) * 8);
        }
        __syncthreads();
        {
            float v[16]; float ss = 0.f;
#pragma unroll
            for (int i = 0; i < 16; ++i) { v[i] = YZ[t * 129 + 16 * cg + i]; ss += v[i] * v[i]; }
            ss += __shfl_xor(ss, 1); ss += __shfl_xor(ss, 2); ss += __shfl_xor(ss, 4);
            const float rr = 1.0f / sqrtf(ss * (1.f / 128.f) + EPS);
            float o0[8], o1[8];
#pragma unroll
            for (int i = 0; i < 8; ++i) { o0[i] = v[i] * rr * ngv[i]; o1[i] = v[8 + i] * rr * ngv[8 + i]; }
            bf16* op = MIX + (size_t)(row0 + t) * D + 512 + 128 * g + 16 * cg;
            *(v4u*)op = pk8(o0); *(v4u*)(op + 8) = pk8(o1);
        }
    }
    __syncthreads();
}
__device__ __forceinline__ void mlstm_local_unit(Frame& F, int l, int u, unsigned char* lds) {
    const int tid = F.tid, lane = F.lane, w = F.wave, fr = lane & 15, fq = lane >> 4;
    const int b = u >> 8, h = (u >> 6) & 3, n = u & 63, row0 = b * SEQ + n * 64;
    const bf16* P = (const bf16*)(F.ws + WS_P); const float* SM = (const float*)(F.ws + WS_SM); bf16* MIX = (bf16*)(F.ws + WS_XN);
    float* SC = (float*)(F.ws + WS_SCAL);
    unsigned char* QS = lds; unsigned char* KS = lds + 9216; unsigned char* VT = lds + 18432; unsigned char* KWT = lds + 27648; unsigned char* SS = lds + 36864; unsigned char* ONES = lds + 46080;
    float* sbb = (float*)(lds + 48384); float* sli = (float*)(lds + 48640); float* sdm = (float*)(lds + 48896); float* skw = (float*)(lds + 49152);
    const size_t tok = (size_t)(b * 4 + h) * SEQ + n * 64;
    if (w == 0) {
        const float* sm = SM + (size_t)(row0 + lane) * 32;
        const float li = sm[SM_I + h] + F.in[I_MIB][l * 4 + h], lf = -softplus_f(-(sm[SM_F + h] + F.in[I_MFB][l * 4 + h]));
        const float bb = wave_scan_add(lf, lane);
        const float dm = bb + wave_scan_max(li - bb, lane);
        const float bl = __shfl(bb, 63), ge = bl - bb + li, mloc = wave_max(ge);
        sbb[lane] = bb; sli[lane] = li; sdm[lane] = dm; skw[lane] = expf(ge - mloc);
        SC[SC_BB / 4 + tok + lane] = bb; SC[SC_DM / 4 + tok + lane] = dm;
        if (lane == 0) { SC[SC_MU / 4 + 2 * u] = mloc; SC[SC_MU / 4 + 2 * u + 1] = bl; }
    }
    if (tid < 16 * 9) ((v4u*)ONES)[tid] = (v4u){0x3f803f80u, 0x3f803f80u, 0x3f803f80u, 0x3f803f80u};
    const int t = tid >> 3, cg = tid & 7;
    const bf16* prow = P + (size_t)(row0 + t) * PP + 64 * h + 8 * cg;
    const v4u qv = *(const v4u*)(prow + D_Q), kv = *(const v4u*)(prow + D_K), vv = *(const v4u*)(prow + D_V);
    float k8[8], v8[8]; unpk8(kv, k8); unpk8(vv, v8);
    *(v4u*)(QS + t * T72 + cg * 16) = qv;
#pragma unroll
    for (int i = 0; i < 8; ++i) k8[i] *= 0.125f;
    *(v4u*)(KS + t * T72 + cg * 16) = pk8(k8);
#pragma unroll
    for (int i = 0; i < 8; ++i) *(unsigned short*)(VT + (8 * cg + i) * T72 + t * 2) = (unsigned short)f2bf(v8[i]);
    __syncthreads();
    { const float kw = skw[t];
#pragma unroll
      for (int i = 0; i < 8; ++i) *(unsigned short*)(KWT + (8 * cg + i) * T72 + t * 2) = (unsigned short)f2bf(k8[i] * kw); }
    {
        f32x4 acc[2] = {(f32x4){0.f, 0.f, 0.f, 0.f}, (f32x4){0.f, 0.f, 0.f, 0.f}};
        mma_nt<2, 2>(acc, KS, T72, 16 * (w & 3), QS, T72, 32 * (w >> 2), lane);
        const int m0 = 16 * (w & 3) + 4 * fq;
#pragma unroll
        for (int tt = 0; tt < 2; ++tt) { const int c = 32 * (w >> 2) + 16 * tt + fr; const float base = sbb[c] - sdm[c];
            float o[4];
#pragma unroll
            for (int j = 0; j < 4; ++j) { const int m = m0 + j; o[j] = (m <= c) ? acc[tt][j] * expf(base - sbb[m] + sli[m]) : 0.f; }
            *(v2u*)(SS + c * T72 + m0 * 2) = pk4(o[0], o[1], o[2], o[3]); }
    }
    __syncthreads();
    {
        const int e0 = 16 * (w & 3) + 4 * fq;
        f32x4 na[2] = {(f32x4){0.f, 0.f, 0.f, 0.f}, (f32x4){0.f, 0.f, 0.f, 0.f}};
        mma_nt<2, 2>(na, VT, T72, 16 * (w & 3), SS, T72, 32 * (w >> 2), lane);
#pragma unroll
        for (int tt = 0; tt < 2; ++tt) *(v2u*)(MIX + (size_t)(row0 + 32 * (w >> 2) + 16 * tt + fr) * D + 768 + 64 * h + e0) = pk4(na[tt].x, na[tt].y, na[tt].z, na[tt].w);
        f32x4 ka[2] = {(f32x4){0.f, 0.f, 0.f, 0.f}, (f32x4){0.f, 0.f, 0.f, 0.f}};
        mma_nt<2, 2>(ka, KWT, T72, 16 * (w & 3), VT, T72, 32 * (w >> 2), lane);
        bf16* KCT = (bf16*)(F.ws + WS_MKC) + (size_t)u * 4096;
#pragma unroll
        for (int tt = 0; tt < 2; ++tt) *(v2u*)(KCT + (32 * (w >> 2) + 16 * tt + fr) * 64 + e0) = pk4(ka[tt].x, ka[tt].y, ka[tt].z, ka[tt].w);
        if (w < 4) {
            f32x4 da[1] = {(f32x4){0.f, 0.f, 0.f, 0.f}}, nn[1] = {(f32x4){0.f, 0.f, 0.f, 0.f}};
            mma_nt<1, 2>(da, ONES, T72, 0, SS, T72, 16 * w, lane);
            mma_nt<1, 2>(nn, KWT, T72, 16 * w, ONES, T72, 0, lane);
            if (fq == 0) SC[SC_DEN / 4 + tok + 16 * w + fr] = da[0].x;
            if (fr == 0) *(f32x4*)(SC + SC_NC / 4 + (size_t)u * 64 + 16 * w + 4 * fq) = nn[0];
        }
    }
    __syncthreads();
}
__device__ __forceinline__ void mlstm_chain(Frame& F, int l, int b, int h, unsigned char* lds) {
    const int tid = F.tid, lane = F.lane, w = F.wave, fr = lane & 15, fq = lane >> 4;
    const bf16* P = (const bf16*)(F.ws + WS_P); bf16* MIX = (bf16*)(F.ws + WS_XN);
    const float* SC = (const float*)(F.ws + WS_SCAL);
    unsigned char* QS = lds; unsigned char* CT[2] = {lds + 9216, lds + 18432}; unsigned char* NB[2] = {lds + 27648, lds + 29952};
    float* swst = (float*)(lds + 32256); float* ssloc = (float*)(lds + 32512); float* semt = (float*)(lds + 32768); float* sden = (float*)(lds + 33024);
    const int u0 = (b * 4 + h) * 64; const size_t tok0 = (size_t)(b * 4 + h) * SEQ;
    for (int i = tid; i < (9216 + 2304) / 4; i += 512) { if (i < 2304) ((unsigned*)CT[0])[i] = 0u; else ((unsigned*)NB[0])[i - 2304] = 0u; }
    const int se = (tid - 256) >> 2, sd0 = 16 * ((tid - 256) & 3);
    float Cm[16], nm[16];
#pragma unroll
    for (int i = 0; i < 16; ++i) { Cm[i] = 0.f; nm[i] = 0.f; }
    float m_st = 0.f;
    const int t = tid >> 3, cg = tid & 7;
    float ngv[4][4];
#pragma unroll
    for (int rb = 0; rb < 4; ++rb)
#pragma unroll
        for (int j = 0; j < 4; ++j) ngv[rb][j] = F.in[I_MNORM][l * 256 + 64 * h + 16 * rb + 4 * fq + j];
    for (int n = 0; n < 64; ++n) {
        const int row0 = b * SEQ + n * 64, cur = n & 1;
        const float mloc = SC[SC_MU / 4 + 2 * (u0 + n)], bl = SC[SC_MU / 4 + 2 * (u0 + n) + 1];
        *(v4u*)(QS + t * T72 + cg * 16) = *(const v4u*)(P + (size_t)(row0 + t) * PP + D_Q + 64 * h + 8 * cg);
        if (tid < 64) { const float bb = SC[SC_BB / 4 + tok0 + n * 64 + tid], dm = SC[SC_DM / 4 + tok0 + n * 64 + tid];
            const float mt = fmaxf(bb + m_st, dm); swst[tid] = expf(bb + m_st - mt); ssloc[tid] = expf(dm - mt); semt[tid] = expf(-mt); sden[tid] = SC[SC_DEN / 4 + tok0 + n * 64 + tid]; }
        const float m_new = fmaxf(bl + m_st, mloc), fa = expf(bl + m_st - m_new), fb = expf(mloc - m_new);
        m_st = m_new;
        __syncthreads();
        if (w < 4) {
            f32x4 na[4][1], dd[1] = {(f32x4){0.f, 0.f, 0.f, 0.f}};
#pragma unroll
            for (int rb = 0; rb < 4; ++rb) { na[rb][0] = (f32x4){0.f, 0.f, 0.f, 0.f}; mma_nt<1, 2>(na[rb], CT[cur], T72, 16 * rb, QS, T72, 16 * w, lane); }
            mma_nt<1, 2>(dd, NB[cur], T72, 0, QS, T72, 16 * w, lane);
            const int c = 16 * w + fr; const float ws_ = swst[c], sl = ssloc[c];
            const float den = ws_ * dd[0].x + sl * sden[c], inv = 1.0f / fmaxf(fabsf(den), semt[c]);
            float hv[4][4]; float ss = 0.f;
#pragma unroll
            for (int rb = 0; rb < 4; ++rb) { const int e0 = 16 * rb + 4 * fq;
                const v2u nl = *(const v2u*)(MIX + (size_t)(row0 + c) * D + 768 + 64 * h + e0), og = *(const v2u*)(P + (size_t)(row0 + c) * PP + D_O + 64 * h + e0);
                const float nlv[4] = {bf2f(nl.x & 0xffffu), bf2f(nl.x >> 16), bf2f(nl.y & 0xffffu), bf2f(nl.y >> 16)}, ogv[4] = {bf2f(og.x & 0xffffu), bf2f(og.x >> 16), bf2f(og.y & 0xffffu), bf2f(og.y >> 16)};
#pragma unroll
                for (int j = 0; j < 4; ++j) { hv[rb][j] = (ws_ * na[rb][0][j] + sl * nlv[j]) * inv * sigmoid_f(ogv[j]); ss += hv[rb][j] * hv[rb][j]; } }
            ss += __shfl_xor(ss, 16); ss += __shfl_xor(ss, 32);
            const float rr = 1.0f / sqrtf(ss * (1.f / 64.f) + EPS);
#pragma unroll
            for (int rb = 0; rb < 4; ++rb) *(v2u*)(MIX + (size_t)(row0 + c) * D + 768 + 64 * h + 16 * rb + 4 * fq) = pk4(hv[rb][0] * rr * ngv[rb][0], hv[rb][1] * rr * ngv[rb][1], hv[rb][2] * rr * ngv[rb][2], hv[rb][3] * rr * ngv[rb][3]);
        } else {
            const bf16* kct = (const bf16*)(F.ws + WS_MKC) + (size_t)(u0 + n) * 4096 + se * 64 + sd0;
            float k0[8], k1[8]; unpk8(*(const v4u*)kct, k0); unpk8(*(const v4u*)(kct + 8), k1);
            const float* ncp = SC + SC_NC / 4 + (size_t)(u0 + n) * 64 + sd0;
            float o0[8], o1[8];
#pragma unroll
            for (int i = 0; i < 8; ++i) { Cm[i] = Cm[i] * fa + k0[i] * fb; Cm[8 + i] = Cm[8 + i] * fa + k1[i] * fb; nm[i] = nm[i] * fa + ncp[i] * fb; nm[8 + i] = nm[8 + i] * fa + ncp[8 + i] * fb; o0[i] = Cm[i]; o1[i] = Cm[8 + i]; }
            *(v4u*)(CT[cur ^ 1] + se * T72 + sd0 * 2) = pk8(o0); *(v4u*)(CT[cur ^ 1] + se * T72 + sd0 * 2 + 16) = pk8(o1);
            if (se < 16) {
#pragma unroll
                for (int i = 0; i < 8; ++i) { o0[i] = nm[i]; o1[i] = nm[8 + i]; }
                *(v4u*)(NB[cur ^ 1] + se * T72 + sd0 * 2) = pk8(o0); *(v4u*)(NB[cur ^ 1] + se * T72 + sd0 * 2 + 16) = pk8(o1); }
        }
        __syncthreads();
    }
}
constexpr int AT_KS = 0, AT_KROW = 80, AT_VT = 2 * 64 * AT_KROW, AT_VROW = 136, AT_OX = 20480;
__device__ __forceinline__ void attn_unit(Frame& F, const bf16* P, bf16* MIX, int b, int h, int qb, float lam, const float* normg, float oscale, unsigned char* lds) {
    const int tid = F.tid, lane = F.lane, w = F.wave, map = w >> 2, wq = w & 3, r32 = lane & 31, hh = lane >> 5;
    const int q0 = qb * 128 + wq * 32;
    const int my_last = 2 * qb + (wq >> 1), nt = 2 * qb + 2;
    const bf16* qrow = P + (size_t)(b * SEQ + q0 + r32) * PP + B_Q + 32 * (2 * h + map) + 8 * hh;
    const bf16x8 Qf0 = *(const bf16x8*)qrow, Qf1 = *(const bf16x8*)(qrow + 16);
    f32x16 o0, o1;
#pragma unroll
    for (int i = 0; i < 16; ++i) { o0[i] = 0.f; o1[i] = 0.f; }
    float m_run = -1e30f, l_run = 0.f;
    const int kmap = tid >> 8, kkey = (tid >> 2) & 63, kpc = tid & 3, vkey = tid >> 3, vg = tid & 7;
    const bf16* ksrc = P + (size_t)(b * SEQ + kkey) * PP + B_K + 32 * (2 * h + kmap) + 8 * kpc;
    const bf16* vsrc = P + (size_t)(b * SEQ + vkey) * PP + B_V + 64 * h + 8 * vg;
    v4u kreg = *(const v4u*)ksrc, vreg = *(const v4u*)vsrc;
    unsigned char* kdst = lds + AT_KS + kmap * (64 * AT_KROW) + kkey * AT_KROW + kpc * 16;
    unsigned char* vdst = lds + AT_VT + (8 * vg) * AT_VROW + vkey * 2;
    const unsigned char* kA = lds + AT_KS + map * (64 * AT_KROW) + r32 * AT_KROW + hh * 16;
    const unsigned char* vA = lds + AT_VT + r32 * AT_VROW + hh * 8;
    for (int j = 0; j < nt; ++j) {
        __syncthreads();
        *(v4u*)kdst = kreg;
        {
            const unsigned vv[4] = {vreg.x, vreg.y, vreg.z, vreg.w};
#pragma unroll
            for (int i = 0; i < 4; ++i) { *(unsigned short*)(vdst + (2 * i) * AT_VROW) = (unsigned short)(vv[i] & 0xffffu); *(unsigned short*)(vdst + (2 * i + 1) * AT_VROW) = (unsigned short)(vv[i] >> 16); }
        }
        __syncthreads();
        if (j + 1 < nt) { kreg = *(const v4u*)(ksrc + (size_t)(j + 1) * 64 * PP); vreg = *(const v4u*)(vsrc + (size_t)(j + 1) * 64 * PP); }
        if (j <= my_last) {
            f32x16 s0, s1;
#pragma unroll
            for (int i = 0; i < 16; ++i) { s0[i] = 0.f; s1[i] = 0.f; }
            s0 = __builtin_amdgcn_mfma_f32_32x32x16_bf16(*(const bf16x8*)(kA), Qf0, s0, 0, 0, 0);
            s0 = __builtin_amdgcn_mfma_f32_32x32x16_bf16(*(const bf16x8*)(kA + 32), Qf1, s0, 0, 0, 0);
            s1 = __builtin_amdgcn_mfma_f32_32x32x16_bf16(*(const bf16x8*)(kA + 32 * AT_KROW), Qf0, s1, 0, 0, 0);
            s1 = __builtin_amdgcn_mfma_f32_32x32x16_bf16(*(const bf16x8*)(kA + 32 * AT_KROW + 32), Qf1, s1, 0, 0, 0);
            float mx = s0[0];
#pragma unroll
            for (int i = 0; i < 16; ++i) { mx = fmaxf(mx, s0[i]); mx = fmaxf(mx, s1[i]); }
            mx = fmaxf(mx, __shfl_xor(mx, 32));
            const float mn = fmaxf(m_run, mx), alpha = exp2f(m_run - mn); m_run = mn;
            float rs = 0.f;
#pragma unroll
            for (int i = 0; i < 16; ++i) { s0[i] = exp2f(s0[i] - mn); s1[i] = exp2f(s1[i] - mn); rs += s0[i] + s1[i]; }
            l_run = l_run * alpha + rs;
#pragma unroll
            for (int i = 0; i < 16; ++i) { o0[i] *= alpha; o1[i] *= alpha; }
            bf16x8 pf[4];
#pragma unroll
            for (int st = 0; st < 2; ++st) {
                v4u a, c;
                a.x = pk2(s0[8 * st + 0], s0[8 * st + 1]); a.y = pk2(s0[8 * st + 2], s0[8 * st + 3]); a.z = pk2(s0[8 * st + 4], s0[8 * st + 5]); a.w = pk2(s0[8 * st + 6], s0[8 * st + 7]);
                c.x = pk2(s1[8 * st + 0], s1[8 * st + 1]); c.y = pk2(s1[8 * st + 2], s1[8 * st + 3]); c.z = pk2(s1[8 * st + 4], s1[8 * st + 5]); c.w = pk2(s1[8 * st + 6], s1[8 * st + 7]);
                pf[st] = __builtin_bit_cast(bf16x8, a); pf[2 + st] = __builtin_bit_cast(bf16x8, c);
            }
#pragma unroll
            for (int ks = 0; ks < 4; ++ks) {
                const unsigned char* va = vA + (16 * ks) * 2;
                const v2u lo0 = *(const v2u*)(va), hi0 = *(const v2u*)(va + 16);
                const v2u lo1 = *(const v2u*)(va + 32 * AT_VROW), hi1 = *(const v2u*)(va + 32 * AT_VROW + 16);
                const bf16x8 a0 = __builtin_bit_cast(bf16x8, (v4u){lo0.x, lo0.y, hi0.x, hi0.y}), a1 = __builtin_bit_cast(bf16x8, (v4u){lo1.x, lo1.y, hi1.x, hi1.y});
                o0 = __builtin_amdgcn_mfma_f32_32x32x16_bf16(a0, pf[ks], o0, 0, 0, 0);
                o1 = __builtin_amdgcn_mfma_f32_32x32x16_bf16(a1, pf[ks], o1, 0, 0, 0);
            }
        }
    }
    const float lt = l_run + __shfl_xor(l_run, 32), inv = 1.0f / lt;
    float* OX = (float*)(lds + AT_OX);
    if (map == 1) {
#pragma unroll
        for (int i = 0; i < 16; ++i) { const int dv = (i & 3) + 8 * (i >> 2) + 4 * hh;
            OX[(wq * 64 + dv) * 32 + r32] = o0[i] * inv; OX[(wq * 64 + 32 + dv) * 32 + r32] = o1[i] * inv; }
    }
    __syncthreads();
    if (map == 0) {
        float ss = 0.f;
#pragma unroll
        for (int i = 0; i < 16; ++i) { const int dv = (i & 3) + 8 * (i >> 2) + 4 * hh;
            o0[i] = o0[i] * inv - lam * OX[(wq * 64 + dv) * 32 + r32]; o1[i] = o1[i] * inv - lam * OX[(wq * 64 + 32 + dv) * 32 + r32];
            ss += o0[i] * o0[i] + o1[i] * o1[i]; }
        ss += __shfl_xor(ss, 32);
        const float r = oscale / sqrtf(ss * (1.f / 64.f) + EPS);
        bf16* orow = MIX + (size_t)(b * SEQ + q0 + r32) * D + 256 + 64 * h;
#pragma unroll
        for (int g4 = 0; g4 < 4; ++g4) { const int dv = 8 * g4 + 4 * hh;
            const f32x4 ga = *(const f32x4*)(normg + dv), gb = *(const f32x4*)(normg + 32 + dv);
            v2u wa, wb; wa.x = pk2(o0[4 * g4] * r * ga.x, o0[4 * g4 + 1] * r * ga.y); wa.y = pk2(o0[4 * g4 + 2] * r * ga.z, o0[4 * g4 + 3] * r * ga.w);
            wb.x = pk2(o1[4 * g4] * r * gb.x, o1[4 * g4 + 1] * r * gb.y); wb.y = pk2(o1[4 * g4 + 2] * r * gb.z, o1[4 * g4 + 3] * r * gb.w);
            *(v2u*)(orow + dv) = wa; *(v2u*)(orow + 32 + dv) = wb; }
    }
}
__device__ __forceinline__ void mixer_phaseA(Frame& F, int l) {
    rope_phase(F, (bf16*)(F.ws + WS_P));
    const int bid = blockIdx.x, G = F.G;
    for (int u = bid; u < BATCH * 4 * 64; u += G) gdn_local_unit(F, l, u, F.lds);
    for (int u = bid; u < BATCH * 2 * 64; u += G) ssd_local_unit(F, l, u, F.lds);
    for (int u = bid; u < BATCH * 4 * 64; u += G) mlstm_local_unit(F, l, u, F.lds);
}
__device__ __forceinline__ void mixer_phaseB(Frame& F, int l) {
    const int bid = blockIdx.x;
    constexpr int NCHAIN = 80;
    if (bid < 32) gdn_chain(F, l, bid >> 2, bid & 3, F.lds);
    else if (bid < 48) ssd_chain(F, l, (bid - 32) >> 1, (bid - 32) & 1, F.lds);
    else if (bid < 80) mlstm_chain(F, l, (bid - 48) >> 2, (bid - 48) & 3, F.lds);
    else {
        const bf16* P = (const bf16*)(F.ws + WS_P); bf16* MIX = (bf16*)(F.ws + WS_XN);
        const float lambda_init = 0.8f - 0.6f * expf(-0.3f * (float)l);
        float d1 = 0.f, d2 = 0.f;
        if (F.lane < 32) { d1 = F.in[I_LQ1][l * 32 + F.lane] * F.in[I_LK1][l * 32 + F.lane]; d2 = F.in[I_LQ2][l * 32 + F.lane] * F.in[I_LK2][l * 32 + F.lane]; }
        const float lam = expf(wave_sum(d1)) - expf(wave_sum(d2)) + lambda_init;
        const float* normg = F.in[I_DNORM] + l * 64;
        const int nw = F.G - NCHAIN, wk = bid - NCHAIN;
        for (int i = wk; i < BATCH * 4 * 32; i += nw) { const int qb = 31 - (i >> 5), bh = i & 31; attn_unit(F, P, MIX, bh >> 2, bh & 3, qb, lam, normg, 1.0f - lambda_init, F.lds); }
    }
}
struct Args { const float* in[N_IN]; float* out; unsigned char* ws; int ph_lo, ph_hi, pad0, pad1; };
constexpr int N_SLOTS = 1 + NLAYER * 3 * 5;
__host__ __device__ constexpr bool slot_used(int p) { return p == 0 || ((((p - 1) / 5) % 3) == 1) || (((p - 1) % 5) != 1 && ((p - 1) % 5) != 2); }

__global__ void __launch_bounds__(NWAVES * 64, 2) mk_fwd(Args args) {
    extern __shared__ __attribute__((aligned(16))) unsigned char lds[];
    Frame F;
    F.lds = lds;
    F.MISC = (volatile LAS unsigned*)((LAS unsigned char*)lds + MISC_OFF);
    F.tid = threadIdx.x; F.lane = F.tid & 63; F.wave = __builtin_amdgcn_readfirstlane(F.tid >> 6);
    F.G = gridDim.x; { const int bx = blockIdx.x; F.vcu = (F.G % 8 == 0) ? (bx % 8) * (F.G / 8) + bx / 8 : bx; }
    F.in = args.in; F.out = args.out; F.ws = args.ws;
    F.ctl = (gu32*)(args.ws + WS_CTL);
    for (int u = F.tid; u < (LDS_BYTES - LDSCTL_OFF) / 4; u += NWAVES * 64) ((LAS unsigned*)((LAS unsigned char*)lds + LDSCTL_OFF))[u] = 0u;
    __syncthreads();
    XcdBarrier bar; bar.bar = (unsigned*)(F.ctl + CW_BAR); bar.x = 0; bar.st = nullptr;
    if (N_LAUNCHES == 1) bar = xcd_barrier_post((unsigned*)(F.ctl + CW_BAR), F.MISC + 8);
    const int lo = args.ph_lo, hi = args.ph_hi;
#define IN(k) (lo <= (k) && (k) < hi)
#define SEAM(k) do { if ((k) + 1 < hi) { if (N_LAUNCHES == 1) xcd_barrier(bar); } } while (0)
    bf16* XN = (bf16*)(F.ws + WS_XN); bf16* Y = (bf16*)(F.ws + WS_Y); bf16* P = (bf16*)(F.ws + WS_P); float* SM = (float*)(F.ws + WS_SM);
    PG8_LAS unsigned char* ring = (PG8_LAS unsigned char*)lds + RING_OFF;

    if (IN(0)) {
        p0_prologue(F);
        post_rows(F, F.in[I_X], nullptr, 0.f, nullptr, nullptr, F.in[I_F1PRE], XN, false, false, true);
        SEAM(0);
    }
#define SUBBLOCK(l, sb) do { \
        unsigned char* wl = F.ws + WS_W + (size_t)(l) * W_LAYER; \
        constexpr int base = 1 + ((l) * 3 + (sb)) * 5; \
        if (IN(base)) { \
            if ((sb) != 1) { \
                pg8::Gemm g{XN, (const bf16*)(wl + ((sb) == 0 ? WL_GU1 : WL_GU2)), M, 2 * FF, D}; pg8::StaticOrder S; S.init(M, 2 * FF, F.G, (int)blockIdx.x); \
                pg8::EpiSwiglu E{P, FF}; \
                pg8::gemm_phase<pg8::EpiSwiglu, pg8::StaticOrder, PG8_ALIGN, PG8_SP2>(ring, g, S, E); \
            } else { \
                pg8::Gemm g{XN, (const bf16*)(wl + WL_IN), M, 4096, D}; pg8::StaticOrder S; S.init(M, 4096, F.G, (int)blockIdx.x); \
                pg8::EpiProj E{P, SM}; \
                pg8::gemm_phase<pg8::EpiProj, pg8::StaticOrder, PG8_ALIGN, PG8_SP2>(ring, g, S, E); \
            } \
            SEAM(base); \
        } \
        if ((sb) == 1 && IN(base + 1)) { mixer_phaseA(F, (l)); SEAM(base + 1); } \
        if ((sb) == 1 && IN(base + 2)) { mixer_phaseB(F, (l)); SEAM(base + 2); } \
        if (IN(base + 3)) { \
            const bf16* A = (sb) == 1 ? XN : P; const int K = (sb) == 1 ? D : FF; \
            const bf16* Bt = (const bf16*)(wl + ((sb) == 0 ? WL_D1 : (sb) == 1 ? WL_OUT : WL_D2)); \
            pg8::Gemm g{A, Bt, M, D, K}; pg8::StaticOrder S; S.init(M, D, F.G, (int)blockIdx.x); \
            pg8::EpiBf16<0> E{Y, D, nullptr, 0, 0, 1.f}; \
            pg8::gemm_phase<pg8::EpiBf16<0>, pg8::StaticOrder, PG8_ALIGN, PG8_SP2>(ring, g, S, E); \
            SEAM(base + 3); \
        } \
        if (IN(base + 4)) { \
            const float* xsrc = ((l) == 0 && (sb) == 0) ? F.in[I_X] : F.out; \
            const float* gpost = F.in[(sb) == 0 ? I_F1POST : (sb) == 1 ? I_MIXPOST : I_F2POST] + (l) * D; \
            constexpr bool last = ((l) == NLAYER - 1 && (sb) == 2); \
            const float* gpre = (sb) == 0 ? F.in[I_MIXPRE] + (l) * D : (sb) == 1 ? F.in[I_F2PRE] + (l) * D : F.in[I_F1PRE] + (last ? 0 : ((l) + 1) * D); \
            post_rows(F, xsrc, Y, (sb) == 1 ? 1.0f : 0.5f, gpost, F.out, gpre, XN, true, true, !last); \
            SEAM(base + 4); \
        } } while (0)
    SUBBLOCK(0, 0); SUBBLOCK(0, 1); SUBBLOCK(0, 2); SUBBLOCK(1, 0); SUBBLOCK(1, 1); SUBBLOCK(1, 2);
#undef SUBBLOCK
#undef IN
#undef SEAM
}

extern "C" void kernel_launch(void* const* d_in, const int* in_sizes, int n_in, void* d_out, int out_size, void* d_ws, size_t ws_size, hipStream_t stream) {
    static int grid = 0;
    if (grid == 0) {
        if (n_in != N_IN || in_sizes[0] != M * D || out_size != M * D || ws_size < WS_END) { fprintf(stderr, "kernel_launch: unexpected shapes (n_in %d, in0 %d, out %d, ws %zu); nothing launched\n", n_in, n_in > 0 ? in_sizes[0] : -1, out_size, ws_size); grid = -1; return; }
        int dev = 0, cus = 0, per_cu = 0;
        if (hipGetDevice(&dev) != hipSuccess || hipDeviceGetAttribute(&cus, hipDeviceAttributeMultiprocessorCount, dev) != hipSuccess) { grid = -1; return; }
        if (hipFuncSetAttribute((const void*)mk_fwd, hipFuncAttributeMaxDynamicSharedMemorySize, LDS_BYTES) != hipSuccess) { fprintf(stderr, "kernel_launch: hipFuncSetAttribute failed\n"); grid = -1; return; }
        if (hipOccupancyMaxActiveBlocksPerMultiprocessor(&per_cu, (const void*)mk_fwd, NWAVES * 64, LDS_BYTES) != hipSuccess || per_cu < 1) fprintf(stderr, "kernel_launch: occupancy query reports %d\n", per_cu);
        (void)hipGetLastError();
        grid = cus;
    }
    if (grid < 0) return;
    if (hipMemsetAsync((char*)d_ws + WS_CTL, 0, CTL_ZERO_BYTES, stream) != hipSuccess) return;
    Args a{};
    for (int i = 0; i < N_IN; ++i) a.in[i] = (const float*)d_in[i];
    a.out = (float*)d_out; a.ws = (unsigned char*)d_ws;
    if (N_LAUNCHES == 1) {
        a.ph_lo = 0; a.ph_hi = N_SLOTS;
        hipLaunchKernelGGL(mk_fwd, dim3(grid), dim3(NWAVES * 64), LDS_BYTES, stream, a);
    } else {
        for (int p = 0; p < N_SLOTS; ++p) { if (!slot_used(p)) continue; a.ph_lo = p; a.ph_hi = p + 1;
            hipLaunchKernelGGL(mk_fwd, dim3(grid), dim3(NWAVES * 64), LDS_BYTES, stream, a); }
    }
}
```

```cpp
#include <hip/hip_runtime.h>
#include <cstdio>
#include <cstdint>
#ifndef MK_N_LAUNCHES
#define MK_N_LAUNCHES 1
#endif
#ifndef PROBE_SEL
#define PROBE_SEL 0
#endif
#ifndef PROBE_MULT
#define PROBE_MULT 1
#endif
#ifndef PROBE_A
#define PROBE_A 0
#define PROBE_B 0
#define PROBE_WG 0
#endif
namespace pg8 {
#define PG8_LAS __attribute__((address_space(3)))
typedef unsigned short bf16_t;
typedef short bf16x8 __attribute__((ext_vector_type(8)));
typedef float f32x4 __attribute__((ext_vector_type(4)));
typedef unsigned u32x4 __attribute__((ext_vector_type(4)));
constexpr int BM = 256, BK = 64, HALF = 128, HTB = HALF * BK * 2  , STAGE_BYTES = 8 * HTB, NXCD = 8, WGM = 8;

__host__ __device__ __forceinline__ int lds_byte(int r, int c) { const int st = (r >> 4) * 2 + (c >> 5), rr = r & 15, cc = c & 31, ob = rr * 64 + cc * 2; return st * 1024 + (ob ^ (((ob >> 9) & 1) << 5)); }
__host__ __device__ __forceinline__ void stage_rc(int b, int& R, int& C) { const int st = b / 1024, sb = b % 1024, swz = sb ^ (((sb >> 9) & 1) << 5); R = (st >> 1) * 16 + swz / 64; C = (st & 1) * 32 + (swz % 64) / 2; }
__host__ __device__ __forceinline__ int perm32(int rho) { const int n = rho >> 4, i = rho & 15; return 8 * (i >> 2) + 4 * n + (i & 3); }

struct Unit { int pm, pn; };
struct Gemm { const bf16_t* A; const bf16_t* Bt; int M, N, K; };

struct StaticOrder {
    int nM, nN, nwg, G, c;
    __host__ __device__ void init(int M, int N, int G_, int c_) { nM = M / BM; nN = N / BM; nwg = nM * nN; G = G_; c = c_; }
    __host__ __device__ bool next(int i, Unit& u) const {
        const long L = (long)i * G + c; if (L >= nwg) return false;
        int wgid = (int)L; { const int q = nwg / NXCD, r = nwg % NXCD, xcd = wgid % NXCD, off = wgid / NXCD; wgid = (xcd < r ? xcd * (q + 1) : r * (q + 1) + (xcd - r) * q) + off; }
        const int nig = WGM * nN, gid = wgid / nig, fm = gid * WGM, gsz = (nM - fm) < WGM ? (nM - fm) : WGM;
        u.pm = fm + ((wgid % nig) % gsz); u.pn = (wgid % nig) / gsz; return true;
    }
    __device__ __forceinline__ void a_ready(const Unit&) const {}
    __device__ __forceinline__ void done(const Unit&) const {}
};

typedef float f32x2 __attribute__((ext_vector_type(2)));
typedef __bf16 nbf2p_t __attribute__((ext_vector_type(2)));
__device__ __forceinline__ unsigned cvt_pk_bf16(float lo, float hi) { const f32x2 f = {lo, hi}; const nbf2p_t b = __builtin_convertvector(f, nbf2p_t); return __builtin_bit_cast(unsigned, b); }
__device__ __forceinline__ f32x2 gelu_pk(f32x2 v) {
    const f32x2 av = __builtin_elementwise_abs(v), d = av * 0.2316418882f + 1.0f;
    f32x2 t; t.x = __builtin_amdgcn_rcpf(d.x); t.y = __builtin_amdgcn_rcpf(d.y);
    f32x2 q = t * 0.5307027145f + (-0.7265760135f); q = q * t + 0.7107068705f; q = q * t + (-0.142248368f); q = q * t + 0.127414796f; q = q * t;
    const f32x2 s = (v * v) * (-0.72134752044f);
    f32x2 e; e.x = __builtin_amdgcn_exp2f(s.x); e.y = __builtin_amdgcn_exp2f(s.y);
    const f32x2 m = v * (q * e), r = v - m;
    f32x2 o; o.x = v.x < 0.f ? m.x : r.x; o.y = v.y < 0.f ? m.y : r.y; return o;
}

template <int ACT  > struct EpiBf16 {
    static constexpr bool PERM = true, AFTER_DRAIN = false; static_assert(ACT == 0 || ACT == 1, "EpiBf16: ACT is 0 (none) or 1 (gelu_pk)");
    bf16_t* O; int ldc; const float* bias; int split_cols; size_t split_stride; float scale0;
    __device__ __forceinline__ void operator()(const f32x4 (&acc)[2][2][4][2], const Unit& u, int wr, int wc, int fr, int fq) const {
        const int row0 = u.pm * BM + wr * 64 + fr; int colt = u.pn * BM; bf16_t* base = O;
        float sc = 1.f; if (split_cols) { const int t = colt / split_cols; base += (size_t)t * split_stride; colt -= t * split_cols; if (t == 0) sc = scale0; }
        const int col0 = colt + wc * 32 + 8 * fq, bcol0 = u.pn * BM + wc * 32 + 8 * fq;
        f32x4 bv[2][2];
#pragma unroll
        for (int bj = 0; bj < 2; ++bj)
#pragma unroll
            for (int n = 0; n < 2; ++n) bv[bj][n] = bias ? *(const f32x4*)(bias + bcol0 + bj * HALF + 4 * n) : (f32x4){0.f, 0.f, 0.f, 0.f};
#pragma unroll
        for (int ai = 0; ai < 2; ++ai)
#pragma unroll
            for (int m = 0; m < 4; ++m) { bf16_t* rowp = base + (size_t)(row0 + ai * HALF + m * 16) * ldc + col0;
#pragma unroll
                for (int bj = 0; bj < 2; ++bj) { f32x4 v0 = acc[ai][bj][m][0] + bv[bj][0], v1 = acc[ai][bj][m][1] + bv[bj][1];
                    if (ACT == 1) { f32x2 a = gelu_pk((f32x2){v0[0], v0[1]}), b = gelu_pk((f32x2){v0[2], v0[3]}), c = gelu_pk((f32x2){v1[0], v1[1]}), d = gelu_pk((f32x2){v1[2], v1[3]});
                        v0 = (f32x4){a.x, a.y, b.x, b.y}; v1 = (f32x4){c.x, c.y, d.x, d.y}; }
                    v0 = v0 * sc; v1 = v1 * sc; u32x4 w; w.x = cvt_pk_bf16(v0[0], v0[1]); w.y = cvt_pk_bf16(v0[2], v0[3]); w.z = cvt_pk_bf16(v1[0], v1[1]); w.w = cvt_pk_bf16(v1[2], v1[3]);
                    *(u32x4*)(rowp + bj * HALF) = w; } }
    }
};

struct EpiSwiglu {
    static constexpr bool PERM = true, AFTER_DRAIN = false;
    bf16_t* O; int ldc;
    __device__ __forceinline__ void operator()(const f32x4 (&acc)[2][2][4][2], const Unit& u, int wr, int wc, int fr, int fq) const {
        const int row0 = u.pm * BM + wr * 64 + fr; const int col0 = u.pn * 128 + wc * 32 + 8 * fq;
#pragma unroll
        for (int ai = 0; ai < 2; ++ai)
#pragma unroll
            for (int m = 0; m < 4; ++m) { bf16_t* rowp = O + (size_t)(row0 + ai * HALF + m * 16) * ldc + col0;
                float h[8];
#pragma unroll
                for (int n = 0; n < 2; ++n)
#pragma unroll
                    for (int i = 0; i < 4; ++i) { const float g = acc[ai][0][m][n][i], up = acc[ai][1][m][n][i];
                        h[n * 4 + i] = g * __builtin_amdgcn_rcpf(1.0f + __expf(-g)) * up; }
                u32x4 w; w.x = cvt_pk_bf16(h[0], h[1]); w.y = cvt_pk_bf16(h[2], h[3]); w.z = cvt_pk_bf16(h[4], h[5]); w.w = cvt_pk_bf16(h[6], h[7]);
                *(u32x4*)rowp = w; }
    }
};
struct EpiProj {
    static constexpr bool PERM = true, AFTER_DRAIN = false;
    bf16_t* P; float* SM; const float* ct; const float* st;
    __device__ __forceinline__ void operator()(const f32x4 (&acc)[2][2][4][2], const Unit& u, int wr, int wc, int fr, int fq) const {
        const int row0 = u.pm * BM + wr * 64 + fr;
        if (u.pn == 4 || u.pn == 5) {
            const int col0 = u.pn * BM + wc * 32 + 8 * fq, fb = 8 * (fq & 1);
            const float sc = (u.pn == 4) ? 0.17677669529663687f * 1.4426950408889634f : 1.0f, sg = (fq < 2) ? -1.0f : 1.0f;
#pragma unroll
            for (int ai = 0; ai < 2; ++ai)
#pragma unroll
                for (int m = 0; m < 4; ++m) { const int row = row0 + ai * HALF + m * 16, pos = row & 4095;
                    bf16_t* rowp = P + (size_t)row * 3840 + col0;
                    const f32x4 c0 = *(const f32x4*)(ct + pos * 16 + fb), c1 = *(const f32x4*)(ct + pos * 16 + fb + 4), s0 = *(const f32x4*)(st + pos * 16 + fb) * sg, s1 = *(const f32x4*)(st + pos * 16 + fb + 4) * sg;
#pragma unroll
                    for (int bj = 0; bj < 2; ++bj) { const f32x4 v0 = acc[ai][bj][m][0], v1 = acc[ai][bj][m][1];
                        f32x4 p0, p1;
#pragma unroll
                        for (int i = 0; i < 4; ++i) { p0[i] = __shfl_xor(v0[i], 32); p1[i] = __shfl_xor(v1[i], 32); }
                        const f32x4 o0 = (v0 * c0 + p0 * s0) * sc, o1 = (v1 * c1 + p1 * s1) * sc;
                        u32x4 w; w.x = cvt_pk_bf16(o0[0], o0[1]); w.y = cvt_pk_bf16(o0[2], o0[3]); w.z = cvt_pk_bf16(o1[0], o1[1]); w.w = cvt_pk_bf16(o1[2], o1[3]);
                        *(u32x4*)(rowp + bj * HALF) = w; } }
        } else if (u.pn < 15) {
            const int col0 = u.pn * BM + wc * 32 + 8 * fq;
#pragma unroll
            for (int ai = 0; ai < 2; ++ai)
#pragma unroll
                for (int m = 0; m < 4; ++m) { bf16_t* rowp = P + (size_t)(row0 + ai * HALF + m * 16) * 3840 + col0;
#pragma unroll
                    for (int bj = 0; bj < 2; ++bj) { const f32x4 v0 = acc[ai][bj][m][0], v1 = acc[ai][bj][m][1];
                        u32x4 w; w.x = cvt_pk_bf16(v0[0], v0[1]); w.y = cvt_pk_bf16(v0[2], v0[3]); w.z = cvt_pk_bf16(v1[0], v1[1]); w.w = cvt_pk_bf16(v1[2], v1[3]);
                        *(u32x4*)(rowp + bj * HALF) = w; } }
        } else if (wc == 0) {
#pragma unroll
            for (int ai = 0; ai < 2; ++ai)
#pragma unroll
                for (int m = 0; m < 4; ++m) { float* rowp = SM + (size_t)(row0 + ai * HALF + m * 16) * 32 + 8 * fq;
                    *(f32x4*)rowp = acc[ai][0][m][0]; *(f32x4*)(rowp + 4) = acc[ai][0][m][1]; }
        }
    }
};
template <class Epi, class Sched, bool ALIGN_EPI = false, bool SP2 = false>
__device__ __forceinline__ void gemm_phase(PG8_LAS unsigned char* lds, const Gemm g, const Sched& S, const Epi& E) {
    const int tid = threadIdx.x, wid = __builtin_amdgcn_readfirstlane(tid >> 6), lane = tid & 63, wr = wid >> 2, wc = wid & 3, fr = lane & 15, fq = lane >> 4;
    const int K = g.K, nt = K / BK;
    unsigned voffA[2], voffB[2];
#pragma unroll
    for (int i = 0; i < 2; ++i) { int R, C; stage_rc(tid * 16 + i * 8192, R, C); const int Rb = Epi::PERM ? ((R & ~31) + perm32(R & 31)) : R;
        voffA[i] = (unsigned)(R * K + C) * 2u; voffB[i] = (unsigned)(Rb * K + C) * 2u; }
    const size_t kstep = (size_t)(BK * 2);
    const size_t hstep = (size_t)HALF * K * 2;
    const size_t tstep = 2 * hstep;
    const unsigned ldsw = (unsigned)wid * 1024u;
    const int aoff = lds_byte(wr * 64 + fr, fq * 8), boff = lds_byte(wc * 32 + fr, fq * 8);
#define PG8_SA(b, h) (((b) * 2 + (h)) * HTB)
#define PG8_SB(b, h) ((4 + (b) * 2 + (h)) * HTB)
#define PG8_STAGE(bufoff, gbase, voff) do { _Pragma("unroll") for (int _i = 0; _i < 2; ++_i) \
        __builtin_amdgcn_global_load_lds((const unsigned*)((const char*)(gbase) + (voff)[_i]), (PG8_LAS unsigned*)(lds + (bufoff) + ldsw + _i * 8192), 16, 0, 0); } while (0)
#define PG8_LDA(dst, b, h) do { _Pragma("unroll") for (int m = 0; m < 4; ++m) _Pragma("unroll") for (int k = 0; k < 2; ++k) dst[m][k] = *(const PG8_LAS bf16x8*)(lds + PG8_SA(b, h) + aoff + m * 2048 + k * 1024); } while (0)
#define PG8_LDB(dst, b, h) do { _Pragma("unroll") for (int n = 0; n < 2; ++n) _Pragma("unroll") for (int k = 0; k < 2; ++k) dst[n][k] = *(const PG8_LAS bf16x8*)(lds + PG8_SB(b, h) + boff + n * 2048 + k * 1024); } while (0)
#define PG8_MMA(ai, bj, At, Bt) do { __builtin_amdgcn_s_setprio(1); _Pragma("unroll") for (int m = 0; m < 4; ++m) _Pragma("unroll") for (int n = 0; n < 2; ++n) _Pragma("unroll") for (int k = 0; k < 2; ++k) \
        acc[ai][bj][m][n] = __builtin_amdgcn_mfma_f32_16x16x32_bf16(Bt[n][k], At[m][k], acc[ai][bj][m][n], 0, 0, 0); __builtin_amdgcn_s_setprio(0); } while (0)
#define PG8_WAIT_V(n) asm volatile("s_waitcnt vmcnt(" #n ")" ::: "memory")
#define PG8_WAIT_L(n) asm volatile("s_waitcnt lgkmcnt(" #n ")" ::: "memory")
#define PG8_BAR __builtin_amdgcn_s_barrier()
#define PG8_SCHED __builtin_amdgcn_sched_barrier(0)
    Unit cur, nxt; int ui = 0;
    if (!S.next(0, cur)) return;
    f32x4 acc[2][2][4][2];
#pragma unroll
    for (int a = 0; a < 2; ++a)
#pragma unroll
        for (int b = 0; b < 2; ++b)
#pragma unroll
            for (int m = 0; m < 4; ++m)
#pragma unroll
                for (int n = 0; n < 2; ++n) acc[a][b][m][n] = (f32x4){0.f, 0.f, 0.f, 0.f};
    bf16x8 At[4][2], B0[2][2], B1[2][2];
    const char* cA = (const char*)g.A + (size_t)cur.pm * tstep; const char* cB = (const char*)g.Bt + (size_t)cur.pn * tstep;
    S.a_ready(cur);
    if constexpr (SP2) {
        PG8_STAGE(PG8_SB(0, 0), cB, voffB); PG8_STAGE(PG8_SB(0, 1), cB + hstep, voffB); PG8_STAGE(PG8_SA(0, 0), cA, voffA); PG8_STAGE(PG8_SA(0, 1), cA + hstep, voffA);
        if (wr == 1) PG8_BAR;
        PG8_WAIT_V(2); PG8_BAR;
        PG8_STAGE(PG8_SB(1, 0), cB + kstep, voffB); PG8_STAGE(PG8_SA(1, 0), cA + kstep, voffA); PG8_STAGE(PG8_SB(1, 1), cB + hstep + kstep, voffB);
        PG8_WAIT_V(6); PG8_BAR;
    } else {
        PG8_STAGE(PG8_SB(0, 0), cB, voffB); PG8_STAGE(PG8_SA(0, 0), cA, voffA); PG8_STAGE(PG8_SB(0, 1), cB + hstep, voffB); PG8_STAGE(PG8_SA(0, 1), cA + hstep, voffA);
        if (wr == 1) PG8_BAR;
        PG8_WAIT_V(4); PG8_BAR;
        PG8_STAGE(PG8_SB(1, 0), cB + kstep, voffB); PG8_STAGE(PG8_SA(1, 0), cA + kstep, voffA); PG8_STAGE(PG8_SB(1, 1), cB + hstep + kstep, voffB);
        PG8_WAIT_V(6); PG8_BAR;
    }
    for (;;) {
        const bool has_next = S.next(ui + 1, nxt);
        const char* nA = has_next ? (const char*)g.A + (size_t)nxt.pm * tstep : cA; const char* nB = has_next ? (const char*)g.Bt + (size_t)nxt.pn * tstep : cB;
        for (int t = 0; t < nt; t += 2) {
            const bool last = (t == nt - 2);
            const char* a1 = cA + (size_t)(t + 1) * kstep;
            const char* a2 = last ? nA : cA + (size_t)(t + 2) * kstep; const char* b2 = last ? nB : cB + (size_t)(t + 2) * kstep;
            const char* a3 = a2 + kstep; const char* b3 = b2 + kstep;
            if (last && has_next) S.a_ready(nxt);
            if constexpr (SP2) {
            PG8_LDB(B0, 0, 0); PG8_LDB(B1, 0, 1); PG8_SCHED; PG8_LDA(At, 0, 0); PG8_STAGE(PG8_SA(1, 1), a1 + hstep, voffA);
            PG8_WAIT_V(8); PG8_WAIT_L(0); PG8_BAR; PG8_MMA(0, 0, At, B0); PG8_MMA(0, 1, At, B1); PG8_BAR; PG8_SCHED;
            PG8_LDA(At, 0, 1); PG8_STAGE(PG8_SB(0, 0), b2, voffB); PG8_STAGE(PG8_SB(0, 1), b2 + hstep, voffB); PG8_STAGE(PG8_SA(0, 0), a2, voffA);
            PG8_WAIT_V(8); PG8_WAIT_L(0); PG8_BAR; PG8_MMA(1, 0, At, B0); PG8_MMA(1, 1, At, B1); PG8_BAR; PG8_SCHED;
            PG8_LDB(B0, 1, 0); PG8_LDB(B1, 1, 1); PG8_SCHED; PG8_LDA(At, 1, 0); PG8_STAGE(PG8_SA(0, 1), a2 + hstep, voffA);
            PG8_WAIT_V(8); PG8_WAIT_L(0); PG8_BAR; PG8_MMA(0, 0, At, B0); PG8_MMA(0, 1, At, B1); PG8_BAR; PG8_SCHED;
            PG8_LDA(At, 1, 1); PG8_STAGE(PG8_SB(1, 0), b3, voffB); PG8_STAGE(PG8_SB(1, 1), b3 + hstep, voffB); PG8_STAGE(PG8_SA(1, 0), a3, voffA);
            PG8_WAIT_V(8); PG8_WAIT_L(0); PG8_BAR; PG8_MMA(1, 0, At, B0); PG8_MMA(1, 1, At, B1); PG8_BAR; PG8_SCHED;
            } else {
            PG8_LDB(B0, 0, 0); PG8_SCHED; PG8_LDA(At, 0, 0); PG8_STAGE(PG8_SA(1, 1), a1 + hstep, voffA);
            PG8_WAIT_L(8); PG8_BAR; PG8_WAIT_L(0); PG8_MMA(0, 0, At, B0); PG8_BAR; PG8_SCHED;
            PG8_LDB(B1, 0, 1); PG8_STAGE(PG8_SB(0, 0), b2, voffB);
            PG8_BAR; PG8_WAIT_L(0); PG8_MMA(0, 1, At, B1); PG8_BAR;
            PG8_LDA(At, 0, 1); PG8_STAGE(PG8_SA(0, 0), a2, voffA);
            PG8_BAR; PG8_WAIT_L(0); PG8_MMA(1, 0, At, B0); PG8_BAR; PG8_SCHED;
            PG8_STAGE(PG8_SB(0, 1), b2 + hstep, voffB);
            PG8_WAIT_V(6); PG8_BAR; PG8_MMA(1, 1, At, B1); PG8_BAR;
            PG8_LDB(B0, 1, 0); PG8_SCHED; PG8_LDA(At, 1, 0); PG8_STAGE(PG8_SA(0, 1), a2 + hstep, voffA);
            PG8_WAIT_L(8); PG8_BAR; PG8_WAIT_L(0); PG8_MMA(0, 0, At, B0); PG8_BAR; PG8_SCHED;
            PG8_LDB(B1, 1, 1); PG8_STAGE(PG8_SB(1, 0), b3, voffB);
            PG8_BAR; PG8_WAIT_L(0); PG8_MMA(0, 1, At, B1); PG8_BAR;
            PG8_LDA(At, 1, 1); PG8_STAGE(PG8_SA(1, 0), a3, voffA);
            PG8_BAR; PG8_WAIT_L(0); PG8_MMA(1, 0, At, B0); PG8_BAR; PG8_SCHED;
            PG8_STAGE(PG8_SB(1, 1), b3 + hstep, voffB);
            PG8_WAIT_V(6); PG8_BAR; PG8_MMA(1, 1, At, B1); PG8_BAR;
            }
        }
        if constexpr (ALIGN_EPI) { if (wr == 0) PG8_BAR; }
        if constexpr (!Epi::AFTER_DRAIN) { E(acc, cur, wr, wc, fr, fq); S.done(cur); }
        if (!has_next) break;
#pragma unroll
        for (int a = 0; a < 2; ++a)
#pragma unroll
            for (int b = 0; b < 2; ++b)
#pragma unroll
                for (int m = 0; m < 4; ++m)
#pragma unroll
                    for (int n = 0; n < 2; ++n) acc[a][b][m][n] = (f32x4){0.f, 0.f, 0.f, 0.f};
        cur = nxt; cA = nA; cB = nB; ++ui;
        if constexpr (ALIGN_EPI) { if (wr == 1) PG8_BAR; }
    }
    PG8_WAIT_V(0);
    if constexpr (!ALIGN_EPI) { if (wr == 0) PG8_BAR; }
    PG8_BAR;
    if constexpr (Epi::AFTER_DRAIN) { E.fused(acc, cur, wr, wc, fr, fq, lds, wid, lane); S.done(cur); }
#undef PG8_SA
#undef PG8_SB
#undef PG8_STAGE
#undef PG8_LDA
#undef PG8_LDB
#undef PG8_MMA
#undef PG8_WAIT_V
#undef PG8_WAIT_L
#undef PG8_BAR
#undef PG8_SCHED
}
}
#ifndef PG8_SP2
#define PG8_SP2 true
#endif
#ifndef PG8_ALIGN
#define PG8_ALIGN true
#endif
constexpr int N_LAUNCHES = MK_N_LAUNCHES;
constexpr int NWAVES = 8;
constexpr int BATCH = 8, SEQ = 4096, D = 1024, FF = 2816, NLAYER = 2;
constexpr int M = BATCH * SEQ;
constexpr int INC = 3860;
constexpr int PP = 3840;
constexpr int A_Q = 0, A_K = 256, A_V = 512, A_G = 768, B_Q = 1024, B_K = 1280, B_V = 1536, C_Z = 1792, C_XBC = 2048, D_Q = 2816, D_K = 3072, D_V = 3328, D_O = 3584;
constexpr int SM_BETA = 0, SM_A = 4, SM_DT = 8, SM_I = 12, SM_F = 16;
constexpr float EPS = 1e-6f;
enum { I_X = 0, I_F1PRE, I_F1G, I_F1U, I_F1D, I_F1POST, I_MIXPRE, I_WIN, I_GCONV, I_GALOG, I_GDTB, I_GNORM, I_LQ1, I_LK1, I_LQ2, I_LK2, I_DNORM,
       I_SCONVW, I_SCONVB, I_SALOG, I_SDTB, I_SD, I_SNORM, I_MIB, I_MFB, I_MNORM, I_WOUT, I_MIXPOST, I_F2PRE, I_F2G, I_F2U, I_F2D, I_F2POST, N_IN };
constexpr size_t MiB = 1u << 20;
constexpr size_t WS_CTL = 0, CTL_ZERO_BYTES = 1 * MiB;
constexpr size_t WS_ROPE = 1 * MiB;
constexpr size_t WS_W = 2 * MiB;
constexpr size_t W_GU = (size_t)2 * FF * D * 2, W_DN = (size_t)D * FF * 2, W_IN = (size_t)4096 * D * 2, W_OUT = (size_t)D * D * 2;
constexpr size_t WL_GU1 = 0, WL_D1 = WL_GU1 + W_GU, WL_IN = WL_D1 + W_DN, WL_OUT = WL_IN + W_IN, WL_GU2 = WL_OUT + W_OUT, WL_D2 = WL_GU2 + W_GU, W_LAYER = WL_D2 + W_DN;
static_assert(W_LAYER == 43 * MiB, "weights per layer");
constexpr size_t WS_XN = 88 * MiB;
constexpr size_t WS_Y = 152 * MiB;
constexpr size_t WS_P = 216 * MiB;
constexpr size_t WS_SM = 456 * MiB;
constexpr size_t WS_END = 512 * MiB;
static_assert(WS_W + 2 * W_LAYER <= WS_XN && WS_P + (size_t)M * PP * 2 <= WS_SM, "d_ws map");
constexpr int CW_TMO = 0, CW_CODE = 1, CW_BAR = 4096;
constexpr int RING_OFF = 0, RING_BYTES = 131072;
constexpr int LDSCTL_OFF = 158720, MISC_OFF = LDSCTL_OFF + 320;
constexpr int LDS_BYTES = 163840;
#define GAS __attribute__((address_space(1)))
#define LAS __attribute__((address_space(3)))
typedef unsigned short bf16;
typedef unsigned v4u __attribute__((ext_vector_type(4)));
typedef unsigned v2u __attribute__((ext_vector_type(2)));
typedef float f32x4 __attribute__((ext_vector_type(4)));
typedef float f32x16 __attribute__((ext_vector_type(16)));
typedef short bf16x8 __attribute__((ext_vector_type(8)));
typedef short s16x4 __attribute__((ext_vector_type(4)));
typedef GAS unsigned gu32;
#define RLX_AGENT __ATOMIC_RELAXED, __HIP_MEMORY_SCOPE_AGENT
#define LDS_WAIT() asm volatile("s_waitcnt lgkmcnt(0)" ::: "memory")
#define VM_WAIT() asm volatile("s_waitcnt vmcnt(0)" ::: "memory")
typedef __bf16 nbf2_t __attribute__((ext_vector_type(2)));
typedef float nf2_t __attribute__((ext_vector_type(2)));
__device__ __forceinline__ unsigned pk2(float lo, float hi) { const nf2_t f = {lo, hi}; const nbf2_t b = __builtin_convertvector(f, nbf2_t); return __builtin_bit_cast(unsigned, b); }
__device__ __forceinline__ unsigned f2bf(float f) { return (unsigned)__builtin_bit_cast(unsigned short, (__bf16)f); }
__device__ __forceinline__ float bf2f(unsigned v) { return __builtin_bit_cast(float, v << 16); }
__device__ __forceinline__ float silu_f(float x) { return x * __builtin_amdgcn_rcpf(1.0f + __expf(-x)); }
__device__ __forceinline__ float sigmoid_f(float x) { return __builtin_amdgcn_rcpf(1.0f + __expf(-x)); }
__device__ __forceinline__ float rsqrt_f(float x) { return __builtin_amdgcn_rsqf(x); }
__device__ __forceinline__ float softplus_f(float x) { return x > 20.f ? x : log1pf(__expf(x)); }
__device__ __forceinline__ float wave_sum(float v) {
#pragma unroll
    for (int o = 1; o < 64; o <<= 1) v += __shfl_xor(v, o);
    return v;
}
#define XB_TMO      128
#define XB_XCNT(j)  (256  + 64 * (j))
#define XB_XSUB(j)  (1280 + 64 * (j))
#define XB_XGEN(j)  (2304 + 64 * (j))
#define XB_TOP      3328
#define XB_TOPGEN   3392
#define XCD_BAR_WORDS 3456
#define XB_SPIN_CAP (1u << 18)

__device__ __forceinline__ unsigned xb_ld(unsigned* p)              { return __hip_atomic_load(p, __ATOMIC_RELAXED, __HIP_MEMORY_SCOPE_AGENT); }
__device__ __forceinline__ unsigned xb_add(unsigned* p, unsigned v) { return __hip_atomic_fetch_add(p, v, __ATOMIC_RELAXED, __HIP_MEMORY_SCOPE_AGENT); }
__device__ __forceinline__ unsigned xb_xcc_id() { return (unsigned)__builtin_amdgcn_s_getreg((3 << 11) | 20) & 0xFu; }
#define XB_SPIN(cond, bar) do { unsigned _sp = 0; while (cond) { __builtin_amdgcn_s_sleep(1); \
    if ((++_sp & 255u) == 0u) { if (xb_ld(&(bar)[XB_TMO])) break; if (_sp > XB_SPIN_CAP) { atomicAdd(&(bar)[XB_TMO], 1u); break; } } } } while (0)

struct XcdBarrier {
    unsigned* bar; unsigned x;
    volatile LAS unsigned* st;
};

__device__ __forceinline__ XcdBarrier xcd_barrier_post(unsigned* bar, volatile LAS unsigned* st) {
    XcdBarrier b; b.bar = bar; b.x = xb_xcc_id(); b.st = st;
    if (threadIdx.x == 0) (void)xb_add(&bar[XB_XCNT(b.x)], 1u);
    return b;
}
__device__ __forceinline__ void xcd_barrier_complete(unsigned* bar, unsigned x, unsigned& nloc, unsigned& nx) {
    const unsigned G = gridDim.x * gridDim.y * gridDim.z;
    unsigned sum, cnt, mine, sp = 0u;
    for (;;) {
        sum = 0u; cnt = 0u; mine = 0u;
#pragma unroll
        for (unsigned j = 0; j < 16; ++j) { const unsigned c = xb_ld(&bar[XB_XCNT(j)]); sum += c; cnt += (c > 0u) ? 1u : 0u; mine = (j == x) ? c : mine; }
        if (sum == G) break;
        __builtin_amdgcn_s_sleep(1);
        if ((++sp & 255u) == 0u) { if (xb_ld(&bar[XB_TMO])) break; if (sp > XB_SPIN_CAP) { atomicAdd(&bar[XB_TMO], 1u); break; } }
    }
    nloc = mine > 0u ? mine : 1u; nx = cnt > 0u ? cnt : 1u;
}

__device__ __forceinline__ void xcd_barrier(const XcdBarrier& b) {
    asm volatile("s_waitcnt vmcnt(0)" ::: "memory");
    __syncthreads();
    if (threadIdx.x == 0) {
        unsigned* bar = b.bar;
        __builtin_amdgcn_s_waitcnt(0);
        unsigned nloc = b.st[0], nx = b.st[1];
        if (nloc == 0u) { xcd_barrier_complete(bar, b.x, nloc, nx); b.st[0] = nloc; b.st[1] = nx; }
        const unsigned old = xb_add(&bar[XB_XSUB(b.x)], 1u);
        const unsigned gen = old / nloc;
        if (old + 1u == (gen + 1u) * nloc) {
            __builtin_amdgcn_fence(__ATOMIC_RELEASE, "agent");
            asm volatile("s_waitcnt vmcnt(0)" ::: "memory");
            const unsigned og = xb_add(&bar[XB_TOP], 1u);
            const unsigned tg = og / nx;
            if (og + 1u == (tg + 1u) * nx) xb_add(&bar[XB_TOPGEN], 1u);
            else XB_SPIN(xb_ld(&bar[XB_TOPGEN]) == tg, bar);
            __builtin_amdgcn_fence(__ATOMIC_ACQUIRE, "agent");
            xb_add(&bar[XB_XGEN(b.x)], 1u);
            asm volatile("s_waitcnt vmcnt(0)" ::: "memory");
        } else {
            XB_SPIN(xb_ld(&bar[XB_XGEN(b.x)]) == gen, bar);
            __builtin_amdgcn_fence(__ATOMIC_ACQUIRE, "agent");
            asm volatile("s_waitcnt vmcnt(0)" ::: "memory");
        }
    }
    __syncthreads();
}
struct Frame {
    unsigned char* lds;
    volatile LAS unsigned* MISC;
    gu32* ctl;
    int tid, lane, wave;
    int vcu, G;
    const float* const* in;
    float* out; unsigned char* ws;
};
__device__ const double ROPE_INVF[16] = {1.0, 0.5623413251903491, 0.31622776601683794, 0.1778279410038923, 0.1, 0.05623413251903491, 0.03162277660168379, 0.01778279410038923,
    0.01, 0.005623413251903491, 0.0031622776601683794, 0.0017782794100389228, 0.001, 0.0005623413251903491, 0.00031622776601683794, 0.00017782794100389227};

template <int MODE> __device__ __forceinline__ int rowmap(int n) {
    if (MODE == 0) return n;
    if (MODE == 1) return (n >> 7) * 256 + (n & 127);
    if (MODE == 2) return (n >> 7) * 256 + 128 + (n & 127);
    if (n < 1024) return n;
    if (n < 1032) return 3840 + (n - 1024);
    if (n < 2824) return n - 8;
    if (n < 2828) return 3848 + (n - 2824);
    if (n < 3852) return n - 12;
    return n;
}
template <int MODE> __device__ __forceinline__ void p0_transpose_item(const float* W, int K, int N, bf16* WT, float* scr, int item, int lane) {
    const int nblk = (N + 31) / 32, kb = item / nblk, nb = item % nblk, k0 = 64 * kb, n0 = 32 * nb;
    const int nn = n0 + (lane & 31);
#pragma unroll 8
    for (int i = 0; i < 32; ++i) { const int kk = 2 * i + (lane >> 5); scr[kk * 33 + (lane & 31)] = nn < N ? W[(size_t)(k0 + kk) * N + nn] : 0.f; }
    LDS_WAIT(); asm volatile("" ::: "memory");
    const int c = lane & 7;
#pragma unroll
    for (int j = 0; j < 4; ++j) { const int n = (lane >> 3) + 8 * j; const float* s = scr + (8 * c) * 33 + n;
        v4u o; o.x = pk2(s[0 * 33], s[1 * 33]); o.y = pk2(s[2 * 33], s[3 * 33]); o.z = pk2(s[4 * 33], s[5 * 33]); o.w = pk2(s[6 * 33], s[7 * 33]);
        if (n0 + n < N) *(v4u*)(WT + (size_t)rowmap<MODE>(n0 + n) * K + k0 + 8 * c) = o; }
    LDS_WAIT(); asm volatile("" ::: "memory");
}
__device__ __forceinline__ void p0_prologue(Frame& F) {
    float* scr = (float*)(F.lds + RING_OFF + F.wave * 16384);
    const int gw = F.vcu * NWAVES + F.wave, NGW = F.G * NWAVES;
    constexpr int I_GATE = (D / 64) * (FF / 32), I_DOWN = (FF / 64) * (D / 32), I_IN = (D / 64) * ((INC + 31) / 32), I_OUT = (D / 64) * (D / 32);
    constexpr int PER_LAYER = 4 * I_GATE + 2 * I_DOWN + I_IN + I_OUT;
    for (int it = gw; it < NLAYER * PER_LAYER; it += NGW) {
        const int l = it / PER_LAYER; int r = it % PER_LAYER;
        unsigned char* wl = F.ws + WS_W + (size_t)l * W_LAYER;
        if (r < I_GATE) { p0_transpose_item<1>(F.in[I_F1G] + (size_t)l * D * FF, D, FF, (bf16*)(wl + WL_GU1), scr, r, F.lane); continue; } r -= I_GATE;
        if (r < I_GATE) { p0_transpose_item<2>(F.in[I_F1U] + (size_t)l * D * FF, D, FF, (bf16*)(wl + WL_GU1), scr, r, F.lane); continue; } r -= I_GATE;
        if (r < I_DOWN) { p0_transpose_item<0>(F.in[I_F1D] + (size_t)l * D * FF, FF, D, (bf16*)(wl + WL_D1), scr, r, F.lane); continue; } r -= I_DOWN;
        if (r < I_IN)   { p0_transpose_item<3>(F.in[I_WIN] + (size_t)l * D * INC, D, INC, (bf16*)(wl + WL_IN), scr, r, F.lane); continue; } r -= I_IN;
        if (r < I_OUT)  { p0_transpose_item<0>(F.in[I_WOUT] + (size_t)l * D * D, D, D, (bf16*)(wl + WL_OUT), scr, r, F.lane); continue; } r -= I_OUT;
        if (r < I_GATE) { p0_transpose_item<1>(F.in[I_F2G] + (size_t)l * D * FF, D, FF, (bf16*)(wl + WL_GU2), scr, r, F.lane); continue; } r -= I_GATE;
        if (r < I_GATE) { p0_transpose_item<2>(F.in[I_F2U] + (size_t)l * D * FF, D, FF, (bf16*)(wl + WL_GU2), scr, r, F.lane); continue; } r -= I_GATE;
        p0_transpose_item<0>(F.in[I_F2D] + (size_t)l * D * FF, FF, D, (bf16*)(wl + WL_D2), scr, r, F.lane);
    }
    const int gt = F.vcu * NWAVES * 64 + F.tid, NGT = F.G * NWAVES * 64;
    for (int i = gt; i < NLAYER * 236 * 128; i += NGT) { const int l = i / (236 * 128), r = i % (236 * 128);
        *(v4u*)(F.ws + WS_W + (size_t)l * W_LAYER + WL_IN + (size_t)INC * D * 2 + (size_t)r * 16) = (v4u){0u, 0u, 0u, 0u}; }
    float* ct = (float*)(F.ws + WS_ROPE); float* st = ct + SEQ * 16;
    for (int i = gt; i < SEQ * 16; i += NGT) { const int pos = i >> 4, f = i & 15;
        const double rev = (double)pos * ROPE_INVF[f] * 0.15915494309189535; const float fr = (float)(rev - __builtin_floor(rev));
        ct[i] = __builtin_amdgcn_cosf(fr); st[i] = __builtin_amdgcn_sinf(fr); }
}
__device__ __forceinline__ void post_rows(Frame& F, const float* xsrc, const bf16* Y, float coef, const float* g_post, float* xdst, const float* g_pre, bf16* XN, bool has_y, bool write_x, bool write_xn) {
    const int gw = F.vcu * NWAVES + F.wave, NGW = F.G * NWAVES;
    f32x4 gp[4], gn[4];
#pragma unroll
    for (int j = 0; j < 4; ++j) { gp[j] = has_y ? *(const f32x4*)(g_post + 4 * F.lane + 256 * j) : (f32x4){0.f, 0.f, 0.f, 0.f}; gn[j] = write_xn ? *(const f32x4*)(g_pre + 4 * F.lane + 256 * j) : (f32x4){0.f, 0.f, 0.f, 0.f}; }
    for (int m = gw; m < M; m += NGW) {
        f32x4 v[4];
#pragma unroll
        for (int j = 0; j < 4; ++j) v[j] = *(const f32x4*)(xsrc + (size_t)m * D + 4 * F.lane + 256 * j);
        if (has_y) {
            f32x4 y[4]; float s = 0.f;
#pragma unroll
            for (int j = 0; j < 4; ++j) { const v2u w = *(const v2u*)(Y + (size_t)m * D + 4 * F.lane + 256 * j);
                y[j] = (f32x4){bf2f(w.x & 0xffffu), bf2f(w.x >> 16), bf2f(w.y & 0xffffu), bf2f(w.y >> 16)};
                s += (y[j].x * y[j].x + y[j].y * y[j].y) + (y[j].z * y[j].z + y[j].w * y[j].w); }
            const float r = coef / sqrtf(wave_sum(s) * (1.f / D) + EPS);
#pragma unroll
            for (int j = 0; j < 4; ++j) v[j] = v[j] + y[j] * gp[j] * r;
        }
        if (write_x) {
#pragma unroll
            for (int j = 0; j < 4; ++j) *(f32x4*)(xdst + (size_t)m * D + 4 * F.lane + 256 * j) = v[j];
        }
        if (write_xn) {
            float s2 = 0.f;
#pragma unroll
            for (int j = 0; j < 4; ++j) s2 += (v[j].x * v[j].x + v[j].y * v[j].y) + (v[j].z * v[j].z + v[j].w * v[j].w);
            const float r2 = 1.f / sqrtf(wave_sum(s2) * (1.f / D) + EPS);
#pragma unroll
            for (int j = 0; j < 4; ++j) { const f32x4 o = v[j] * gn[j] * r2; v2u w; w.x = pk2(o.x, o.y); w.y = pk2(o.z, o.w);
                *(v2u*)(XN + (size_t)m * D + 4 * F.lane + 256 * j) = w; }
        }
    }
}
__device__ __forceinline__ void rope_phase(Frame& F, bf16* P) {
    const float* ct = (const float*)(F.ws + WS_ROPE); const float* st = ct + SEQ * 16;
    const int gt = F.vcu * NWAVES * 64 + F.tid, NGT = F.G * NWAVES * 64;
    for (int it = gt; it < M * 16; it += NGT) {
        const int row = it >> 4, hd = it & 15, pos = row & (SEQ - 1);
        bf16* p = P + (size_t)row * PP + B_Q + 32 * hd;
        const float sc = hd < 8 ? 0.17677669529663687f * 1.4426950408889634f : 1.0f;
        v4u a0 = *(v4u*)p, a1 = *(v4u*)(p + 8), b0 = *(v4u*)(p + 16), b1 = *(v4u*)(p + 24);
        unsigned t1[8] = {a0.x, a0.y, a0.z, a0.w, a1.x, a1.y, a1.z, a1.w}, t2[8] = {b0.x, b0.y, b0.z, b0.w, b1.x, b1.y, b1.z, b1.w};
        unsigned o1[8], o2[8];
#pragma unroll
        for (int i = 0; i < 8; ++i) {
            const float c0 = ct[pos * 16 + 2 * i], c1 = ct[pos * 16 + 2 * i + 1], s0 = st[pos * 16 + 2 * i], s1 = st[pos * 16 + 2 * i + 1];
            const float x0 = bf2f(t1[i] & 0xffffu), x1 = bf2f(t1[i] >> 16), y0 = bf2f(t2[i] & 0xffffu), y1 = bf2f(t2[i] >> 16);
            o1[i] = pk2((x0 * c0 - y0 * s0) * sc, (x1 * c1 - y1 * s1) * sc);
            o2[i] = pk2((y0 * c0 + x0 * s0) * sc, (y1 * c1 + x1 * s1) * sc);
        }
        *(v4u*)p = (v4u){o1[0], o1[1], o1[2], o1[3]}; *(v4u*)(p + 8) = (v4u){o1[4], o1[5], o1[6], o1[7]};
        *(v4u*)(p + 16) = (v4u){o2[0], o2[1], o2[2], o2[3]}; *(v4u*)(p + 24) = (v4u){o2[4], o2[5], o2[6], o2[7]};
    }
}
template <int NT, int KS> __device__ __forceinline__ void mma_nt(f32x4 (&acc)[NT], const unsigned char* X, int ldx, int x0, const unsigned char* Y, int ldy, int y0, int lane) {
    const int fr = lane & 15, fq = lane >> 4;
#pragma unroll
    for (int ks = 0; ks < KS; ++ks) {
        const bf16x8 a = *(const bf16x8*)(X + (x0 + fr) * ldx + (ks * 32 + 8 * fq) * 2);
#pragma unroll
        for (int t = 0; t < NT; ++t) { const bf16x8 b = *(const bf16x8*)(Y + (y0 + 16 * t + fr) * ldy + (ks * 32 + 8 * fq) * 2);
            acc[t] = __builtin_amdgcn_mfma_f32_16x16x32_bf16(a, b, acc[t], 0, 0, 0); }
    }
}
__device__ __forceinline__ v2u pk4(float a, float b, float c, float d) { v2u w; w.x = pk2(a, b); w.y = pk2(c, d); return w; }
__device__ __forceinline__ v4u pk8(const float (&v)[8]) { v4u w; w.x = pk2(v[0], v[1]); w.y = pk2(v[2], v[3]); w.z = pk2(v[4], v[5]); w.w = pk2(v[6], v[7]); return w; }
__device__ __forceinline__ void unpk8(const v4u w, float (&v)[8]) { v[0] = bf2f(w.x & 0xffffu); v[1] = bf2f(w.x >> 16); v[2] = bf2f(w.y & 0xffffu); v[3] = bf2f(w.y >> 16); v[4] = bf2f(w.z & 0xffffu); v[5] = bf2f(w.z >> 16); v[6] = bf2f(w.w & 0xffffu); v[7] = bf2f(w.w >> 16); }
__device__ __forceinline__ float wave_scan_add(float v, int lane) {
#pragma unroll
    for (int o = 1; o < 64; o <<= 1) { const float t = __shfl_up(v, o); if (lane >= o) v += t; }
    return v;
}
__device__ __forceinline__ float wave_scan_max(float v, int lane) {
#pragma unroll
    for (int o = 1; o < 64; o <<= 1) { const float t = __shfl_up(v, o); if (lane >= o) v = fmaxf(v, t); }
    return v;
}
__device__ __forceinline__ float wave_max(float v) {
#pragma unroll
    for (int o = 1; o < 64; o <<= 1) v = fmaxf(v, __shfl_xor(v, o));
    return v;
}
__device__ __forceinline__ void conv8(const bf16* src, int row, int pos, const float* w, int wstride, float (&out)[8]) {
    v4u raw[4];
#pragma unroll
    for (int j = 0; j < 4; ++j) { const int rr = (pos + j - 3 >= 0) ? row + j - 3 : row; raw[j] = *(const v4u*)(src + (size_t)rr * PP); }
#pragma unroll
    for (int i = 0; i < 8; ++i) out[i] = 0.f;
#pragma unroll
    for (int j = 0; j < 4; ++j) {
        const float msk = (pos + j - 3 >= 0) ? 1.f : 0.f;
        float r[8]; unpk8(raw[j], r);
        const f32x4 w0 = *(const f32x4*)(w + j * wstride) * msk, w1 = *(const f32x4*)(w + j * wstride + 4) * msk;
        out[0] += w0.x * r[0]; out[1] += w0.y * r[1]; out[2] += w0.z * r[2]; out[3] += w0.w * r[3];
        out[4] += w1.x * r[4]; out[5] += w1.y * r[5]; out[6] += w1.z * r[6]; out[7] += w1.w * r[7];
    }
}
__device__ __forceinline__ void conv8_load(const bf16* src, int row, int pos, v4u (&raw)[4]) {
#pragma unroll
    for (int j = 0; j < 4; ++j) { const int rr = (pos + j - 3 >= 0) ? row + j - 3 : row; raw[j] = *(const v4u*)(src + (size_t)rr * PP); }
}
__device__ __forceinline__ void conv8_fin(const v4u (&raw)[4], int pos, const float* w, int wstride, float (&out)[8]) {
#pragma unroll
    for (int i = 0; i < 8; ++i) out[i] = 0.f;
#pragma unroll
    for (int j = 0; j < 4; ++j) {
        const float msk = (pos + j - 3 >= 0) ? 1.f : 0.f;
        float r[8]; unpk8(raw[j], r);
        const f32x4 w0 = *(const f32x4*)(w + j * wstride) * msk, w1 = *(const f32x4*)(w + j * wstride + 4) * msk;
        out[0] += w0.x * r[0]; out[1] += w0.y * r[1]; out[2] += w0.z * r[2]; out[3] += w0.w * r[3];
        out[4] += w1.x * r[4]; out[5] += w1.y * r[5]; out[6] += w1.z * r[6]; out[7] += w1.w * r[7];
    }
}
constexpr int CW_GDN = 131072, CW_SSD = 131072 + 12288;
constexpr size_t WS_GT = WS_Y;
constexpr size_t WS_SST = 460 * MiB;
constexpr size_t WS_MKC = 492 * MiB;
constexpr size_t WS_SCAL = 508 * MiB;
constexpr size_t SC_GL = 0, SC_ACS = 8192, SC_BB = SC_ACS + 524288, SC_DM = SC_BB + 524288, SC_DEN = SC_DM + 524288, SC_NC = SC_DEN + 524288, SC_MU = SC_NC + 524288, SC_END = SC_MU + 16384;
static_assert(WS_SCAL + SC_END <= 511 * MiB, "scalars");
constexpr size_t WS_CSIDE = 511 * MiB;
constexpr int T72 = 144;
__device__ __forceinline__ void gdn_local_unit(Frame& F, int l, int u, unsigned char* lds) {
    const int tid = F.tid, lane = F.lane, w = F.wave, fr = lane & 15, fq = lane >> 4;
    const int b = u >> 8, h = (u >> 6) & 3, n = u & 63, row0 = b * SEQ + n * 64;
    const bf16* P = (const bf16*)(F.ws + WS_P); const float* SM = (const float*)(F.ws + WS_SM); bf16* MIX = (bf16*)(F.ws + WS_XN);
    bf16* GT = (bf16*)(F.ws + WS_GT) + (size_t)u * 4 * 4096;
    unsigned char* KN = lds; unsigned char* QN = lds + 9216; float* RHS = (float*)(lds + 18432); float* Lm = (float*)(lds + 51200); unsigned char* KDT = lds + 67584;
    unsigned char* LN = lds + 76800; unsigned char* XT = lds + 86016; unsigned char* DINV = lds + 104448; unsigned char* RT = lds + 109568 + w * 1280;
    float* sbeta = (float*)(lds + 119808); float* sgc = (float*)(lds + 120064);
    const float* cwl = (const float*)(lds + CW_GDN);
    if (w == 0) {
        const float* sm = SM + (size_t)(row0 + lane) * 32;
        const float Aneg = -expf(F.in[I_GALOG][l * 4 + h]), dtb = F.in[I_GDTB][l * 4 + h];
        const float g = Aneg * softplus_f(sm[SM_A + h] + dtb);
        const float gc = wave_scan_add(g, lane);
        sbeta[lane] = sigmoid_f(sm[SM_BETA + h]); sgc[lane] = gc;
        if (lane == 63) ((float*)(F.ws + WS_SCAL + SC_GL))[u] = expf(gc);
    }
    const int t = tid >> 3, cg = tid & 7, pos = n * 64 + t;
    float q8[8], k8[8], v8[8];
    {
        v4u rq[4], rk[4], rv[4];
        conv8_load(P + A_Q + 64 * h + 8 * cg, row0 + t, pos, rq); conv8_load(P + A_K + 64 * h + 8 * cg, row0 + t, pos, rk); conv8_load(P + A_V + 64 * h + 8 * cg, row0 + t, pos, rv);
        for (int i = tid; i < 4608; i += 512) ((unsigned*)XT)[i] = 0u;
        conv8_fin(rq, pos, cwl + 64 * h + 8 * cg, 768, q8); conv8_fin(rk, pos, cwl + 256 + 64 * h + 8 * cg, 768, k8); conv8_fin(rv, pos, cwl + 512 + 64 * h + 8 * cg, 768, v8);
    }
    float sq = 0.f, sk = 0.f;
#pragma unroll
    for (int i = 0; i < 8; ++i) { q8[i] = silu_f(q8[i]); k8[i] = silu_f(k8[i]); v8[i] = silu_f(v8[i]); sq += q8[i] * q8[i]; sk += k8[i] * k8[i]; }
    sq += __shfl_xor(sq, 1); sq += __shfl_xor(sq, 2); sq += __shfl_xor(sq, 4);
    sk += __shfl_xor(sk, 1); sk += __shfl_xor(sk, 2); sk += __shfl_xor(sk, 4);
    const float rq_ = 0.125f * rsqrt_f(sq + EPS), rk_ = rsqrt_f(sk + EPS);
#pragma unroll
    for (int i = 0; i < 8; ++i) { q8[i] *= rq_; k8[i] *= rk_; }
    __syncthreads();
    {
        const float be = sbeta[t], gct = sgc[t], eg = __expf(gct), egl = __expf(sgc[63] - gct);
        *(v4u*)(KN + t * T72 + cg * 16) = pk8(k8); *(v4u*)(QN + t * T72 + cg * 16) = pk8(q8);
        float tmp[8];
#pragma unroll
        for (int i = 0; i < 8; ++i) tmp[i] = q8[i] * eg;
        *(v4u*)(GT + 2 * 4096 + t * 64 + cg * 8) = pk8(tmp);
#pragma unroll
        for (int i = 0; i < 8; ++i) { RHS[t * 128 + 8 * cg + i] = v8[i] * be; RHS[t * 128 + 64 + 8 * cg + i] = k8[i] * be * eg;
            *(unsigned short*)(KDT + (8 * cg + i) * T72 + t * 2) = (unsigned short)f2bf(k8[i] * egl); }
    }
    __syncthreads();
    {
        const int m0 = 16 * (w & 3) + 4 * fq;
        f32x4 acc[4];
#pragma unroll
        for (int tt = 0; tt < 4; ++tt) acc[tt] = (f32x4){0.f, 0.f, 0.f, 0.f};
        mma_nt<4, 2>(acc, KN, T72, 16 * (w & 3), (w < 4) ? KN : QN, T72, 0, lane);
        const float gm0 = sgc[m0], gm1 = sgc[m0 + 1], gm2 = sgc[m0 + 2], gm3 = sgc[m0 + 3];
#pragma unroll
        for (int tt = 0; tt < 4; ++tt) { const int c = 16 * tt + fr; const float gcc = sgc[c];
            if (w < 4) { const float be = sbeta[c];
                f32x4 o; o.x = (m0 < c) ? be * acc[tt].x * __expf(gcc - gm0) : 0.f; o.y = (m0 + 1 < c) ? be * acc[tt].y * __expf(gcc - gm1) : 0.f;
                o.z = (m0 + 2 < c) ? be * acc[tt].z * __expf(gcc - gm2) : 0.f; o.w = (m0 + 3 < c) ? be * acc[tt].w * __expf(gcc - gm3) : 0.f;
                *(f32x4*)(Lm + c * 64 + m0) = o; *(v2u*)(LN + c * T72 + m0 * 2) = pk4(-o.x, -o.y, -o.z, -o.w);
            } else {
                const float a0 = (m0 <= c) ? acc[tt].x * __expf(gcc - gm0) : 0.f, a1 = (m0 + 1 <= c) ? acc[tt].y * __expf(gcc - gm1) : 0.f;
                const float a2 = (m0 + 2 <= c) ? acc[tt].z * __expf(gcc - gm2) : 0.f, a3 = (m0 + 3 <= c) ? acc[tt].w * __expf(gcc - gm3) : 0.f;
                *(v2u*)(GT + 1 * 4096 + c * 64 + m0) = pk4(a0, a1, a2, a3);
            } }
    }
    __syncthreads();
    if (w < 4) {
        if (lane < 16) {
            float x[16];
#pragma unroll
            for (int r = 0; r < 16; ++r) { float s = (r == lane) ? 1.f : 0.f;
#pragma unroll
                for (int m = 0; m < r; ++m) s -= Lm[(16 * w + r) * 64 + 16 * w + m] * x[m];
                x[r] = s; }
#pragma unroll
            for (int r = 0; r < 16; ++r) *(unsigned short*)(DINV + w * 1280 + r * 80 + lane * 2) = (unsigned short)f2bf(x[r]);
        } else if (lane < 32) {
#pragma unroll
            for (int r = 0; r < 16; ++r) *(unsigned short*)(DINV + w * 1280 + r * 80 + lane * 2) = 0;
        }
    } else {
        for (int i = tid - 256; i < 512; i += 256) { const int d = i >> 3, pc = i & 7; *(v4u*)(GT + 3 * 4096 + d * 64 + pc * 8) = *(const v4u*)(KDT + d * T72 + pc * 16); }
    }
    if (lane >= 16 && lane < 32) {
#pragma unroll
        for (int r = 0; r < 16; ++r) *(unsigned short*)(RT + r * 80 + lane * 2) = 0;
    }
    __syncthreads();
    {
#pragma unroll
        for (int bi = 0; bi < 4; ++bi) {
            f32x4 a[1];
#pragma unroll
            for (int j = 0; j < 4; ++j) a[0][j] = RHS[(16 * bi + 4 * fq + j) * 128 + 16 * w + fr];
            if (bi > 0) mma_nt<1, 2>(a, LN, T72, 16 * bi, XT, T72, 16 * w, lane);
            *(v2u*)(RT + fr * 80 + (4 * fq) * 2) = pk4(a[0].x, a[0].y, a[0].z, a[0].w);
            f32x4 x[1] = {(f32x4){0.f, 0.f, 0.f, 0.f}};
            mma_nt<1, 1>(x, DINV + bi * 1280, 80, 0, RT, 80, 0, lane);
            *(v2u*)(XT + (16 * w + fr) * T72 + (16 * bi + 4 * fq) * 2) = pk4(x[0].x, x[0].y, x[0].z, x[0].w);
        }
    }
    __syncthreads();
    {
        float u8[8], w8[8];
#pragma unroll
        for (int i = 0; i < 8; ++i) { u8[i] = bf2f(*(const unsigned short*)(XT + (8 * cg + i) * T72 + t * 2)); w8[i] = -bf2f(*(const unsigned short*)(XT + (64 + 8 * cg + i) * T72 + t * 2)); }
        *(v4u*)(MIX + (size_t)(row0 + t) * D + 64 * h + 8 * cg) = pk8(u8);
        *(v4u*)(GT + t * 64 + 8 * cg) = pk8(w8);
    }
    {
        bf16* gp = (bf16*)P + (size_t)(row0 + t) * PP + A_G + 64 * h + 8 * cg; float gv[8]; unpk8(*(const v4u*)gp, gv);
#pragma unroll
        for (int i = 0; i < 8; ++i) gv[i] = silu_f(gv[i]);
        *(v4u*)gp = pk8(gv);
    }
    __syncthreads();
}
__device__ __forceinline__ void gdn_chain(Frame& F, int l, int b, int h, unsigned char* lds) {
    const int tid = F.tid, lane = F.lane, w = F.wave, fr = lane & 15, fq = lane >> 4, wm = w >> 1, wn = w & 1;
    const bf16* P = (const bf16*)(F.ws + WS_P); bf16* MIX = (bf16*)(F.ws + WS_XN);
    const float* GL = (const float*)(F.ws + WS_SCAL + SC_GL);
    unsigned char* WN = lds; unsigned char* AT = lds + 9216; unsigned char* QD = lds + 18432; unsigned char* KDT = lds + 27648; unsigned char* UU = lds + 36864;
    unsigned char* ST[2] = {lds + 46080, lds + 55296}; unsigned char* VNT = lds + 64512; float* O = (float*)(lds + 73728);
    const int r = tid >> 3, pc = tid & 7;
    for (int i = tid; i < 9216 / 4; i += 512) ((unsigned*)ST[0])[i] = 0u;
    f32x4 S[2] = {(f32x4){0.f, 0.f, 0.f, 0.f}, (f32x4){0.f, 0.f, 0.f, 0.f}};
    float ng[8];
#pragma unroll
    for (int i = 0; i < 8; ++i) ng[i] = F.in[I_GNORM][l * 64 + 8 * pc + i];
    const int u0 = (b * 4 + h) * 64;
    const bf16* gt = (const bf16*)(F.ws + WS_GT) + (size_t)u0 * 4 * 4096 + r * 64 + pc * 8;
    v4u pw = *(const v4u*)(gt), pa = *(const v4u*)(gt + 4096), pq = *(const v4u*)(gt + 2 * 4096), pk = *(const v4u*)(gt + 3 * 4096);
    v4u pu = *(const v4u*)(MIX + (size_t)(b * SEQ + r) * D + 64 * h + 8 * pc);
    float gl = GL[u0];
    for (int n = 0; n < 64; ++n) {
        const int row0 = b * SEQ + n * 64, cur = n & 1;
        *(v4u*)(WN + r * T72 + pc * 16) = pw; *(v4u*)(AT + r * T72 + pc * 16) = pa; *(v4u*)(QD + r * T72 + pc * 16) = pq; *(v4u*)(KDT + r * T72 + pc * 16) = pk; *(v4u*)(UU + r * T72 + pc * 16) = pu;
        const float glc = gl;
        const v4u gate = *(const v4u*)(P + (size_t)(row0 + r) * PP + A_G + 64 * h + 8 * pc);
        if (n + 1 < 64) { const bf16* g2 = gt + (size_t)(n + 1) * 4 * 4096;
            pw = *(const v4u*)(g2); pa = *(const v4u*)(g2 + 4096); pq = *(const v4u*)(g2 + 2 * 4096); pk = *(const v4u*)(g2 + 3 * 4096);
            pu = *(const v4u*)(MIX + (size_t)(row0 + 64 + r) * D + 64 * h + 8 * pc); gl = GL[u0 + n + 1]; }
        __syncthreads();
        {
            f32x4 a1[2];
#pragma unroll
            for (int t = 0; t < 2; ++t) { const int e = 32 * wn + 16 * t + fr;
#pragma unroll
                for (int j = 0; j < 4; ++j) a1[t][j] = bf2f(*(const unsigned short*)(UU + (16 * wm + 4 * fq + j) * T72 + e * 2)); }
            mma_nt<2, 2>(a1, WN, T72, 16 * wm, ST[cur], T72, 32 * wn, lane);
#pragma unroll
            for (int t = 0; t < 2; ++t) *(v2u*)(VNT + (32 * wn + 16 * t + fr) * T72 + (16 * wm + 4 * fq) * 2) = pk4(a1[t].x, a1[t].y, a1[t].z, a1[t].w);
        }
        __syncthreads();
        {
            f32x4 o[2] = {(f32x4){0.f, 0.f, 0.f, 0.f}, (f32x4){0.f, 0.f, 0.f, 0.f}};
            mma_nt<2, 2>(o, QD, T72, 16 * wm, ST[cur], T72, 32 * wn, lane);
            mma_nt<2, 2>(o, AT, T72, 16 * wm, VNT, T72, 32 * wn, lane);
#pragma unroll
            for (int t = 0; t < 2; ++t)
#pragma unroll
                for (int j = 0; j < 4; ++j) O[(16 * wm + 4 * fq + j) * 65 + 32 * wn + 16 * t + fr] = o[t][j];
            S[0] = S[0] * glc; S[1] = S[1] * glc;
            mma_nt<2, 2>(S, KDT, T72, 16 * wm, VNT, T72, 32 * wn, lane);
#pragma unroll
            for (int t = 0; t < 2; ++t) *(v2u*)(ST[cur ^ 1] + (32 * wn + 16 * t + fr) * T72 + (16 * wm + 4 * fq) * 2) = pk4(S[t].x, S[t].y, S[t].z, S[t].w);
        }
        __syncthreads();
        {
            float ov[8], gv[8]; float ss = 0.f;
#pragma unroll
            for (int i = 0; i < 8; ++i) { ov[i] = O[r * 65 + 8 * pc + i]; ss += ov[i] * ov[i]; }
            ss += __shfl_xor(ss, 1); ss += __shfl_xor(ss, 2); ss += __shfl_xor(ss, 4);
            const float rr = rsqrt_f(ss * (1.f / 64.f) + EPS);
            unpk8(gate, gv);
#pragma unroll
            for (int i = 0; i < 8; ++i) ov[i] = ov[i] * rr * ng[i] * gv[i];
            *(v4u*)(MIX + (size_t)(row0 + r) * D + 64 * h + 8 * pc) = pk8(ov);
        }
    }
    __syncthreads();
}
constexpr int T136 = 272;
__device__ __forceinline__ void ssd_local_unit(Frame& F, int l, int u, unsigned char* lds) {
    const int tid = F.tid, lane = F.lane, w = F.wave, fr = lane & 15, fq = lane >> 4;
    const int b = u >> 7, g = (u >> 6) & 1, n = u & 63, row0 = b * SEQ + n * 64;
    const bf16* P = (const bf16*)(F.ws + WS_P); const float* SM = (const float*)(F.ws + WS_SM); bf16* MIX = (bf16*)(F.ws + WS_XN);
    unsigned char* CM = lds; unsigned char* BM = lds + 17408; unsigned char* BMT = lds + 34816; unsigned char* XDT = lds + 53248; unsigned char* XST = lds + 71680; unsigned char* LD = lds + 90112;
    float* sacs = (float*)(lds + 108544); float* sdt = (float*)(lds + 109056);
    if (w < 2) {
        const int h = 2 * g + w;
        const float dt = softplus_f(SM[(size_t)(row0 + lane) * 32 + SM_DT + h] + F.in[I_SDTB][l * 4 + h]);
        const float acs = wave_scan_add(dt * (-expf(F.in[I_SALOG][l * 4 + h])), lane);
        sdt[w * 64 + lane] = dt; sacs[w * 64 + lane] = acs;
        ((float*)(F.ws + WS_SCAL + SC_ACS))[(size_t)(b * 4 + h) * SEQ + n * 64 + lane] = acs;
    }
    const int t = tid >> 3, cg = tid & 7, pos = n * 64 + t;
    const float* cwl = (const float*)(lds + CW_SSD);
    float val[6][8];
#pragma unroll
    for (int kb = 0; kb < 6; kb += 3) {
        v4u raw[3][4];
#pragma unroll
        for (int k2 = 0; k2 < 3; ++k2) { const int k = kb + k2, chg = cg + 8 * k, ch = (k < 2) ? (128 * g + 8 * chg) : (k < 4) ? (256 + 128 * g + 8 * (chg - 16)) : (512 + 128 * g + 8 * (chg - 32));
            conv8_load(P + C_XBC + ch, row0 + t, pos, raw[k2]); }
#pragma unroll
        for (int k2 = 0; k2 < 3; ++k2) { const int k = kb + k2, chg = cg + 8 * k, ch = (k < 2) ? (128 * g + 8 * chg) : (k < 4) ? (256 + 128 * g + 8 * (chg - 16)) : (512 + 128 * g + 8 * (chg - 32));
            conv8_fin(raw[k2], pos, cwl + ch, 768, val[k]);
            const f32x4 b0 = *(const f32x4*)(cwl + 3072 + ch), b1 = *(const f32x4*)(cwl + 3072 + ch + 4);
            val[k][0] = silu_f(val[k][0] + b0.x); val[k][1] = silu_f(val[k][1] + b0.y); val[k][2] = silu_f(val[k][2] + b0.z); val[k][3] = silu_f(val[k][3] + b0.w);
            val[k][4] = silu_f(val[k][4] + b1.x); val[k][5] = silu_f(val[k][5] + b1.y); val[k][6] = silu_f(val[k][6] + b1.z); val[k][7] = silu_f(val[k][7] + b1.w); }
        asm volatile("" ::: "memory");
    }
    __syncthreads();
#pragma unroll
    for (int k = 0; k < 6; ++k) {
        const int chg = cg + 8 * k;
        if (k < 2) { const int hh = k, p0 = 8 * cg; const float dt = sdt[hh * 64 + t], ds = expf(sacs[hh * 64 + 63] - sacs[hh * 64 + t]);
#pragma unroll
            for (int i = 0; i < 8; ++i) { const float xd = val[k][i] * dt;
                *(unsigned short*)(XDT + hh * 9216 + (p0 + i) * T72 + t * 2) = (unsigned short)f2bf(xd);
                *(unsigned short*)(XST + hh * 9216 + (p0 + i) * T72 + t * 2) = (unsigned short)f2bf(xd * ds); }
        } else if (k < 4) { const int n0 = 8 * (chg - 16);
            *(v4u*)(BM + t * T136 + n0 * 2) = pk8(val[k]);
#pragma unroll
            for (int i = 0; i < 8; ++i) *(unsigned short*)(BMT + (n0 + i) * T72 + t * 2) = (unsigned short)f2bf(val[k][i]);
        } else { const int n0 = 8 * (chg - 32); const v4u cv = pk8(val[k]); *(v4u*)(CM + t * T136 + n0 * 2) = cv;
            if (t <= 60) *(v4u*)((bf16*)P + (size_t)(row0 + t) * PP + C_XBC + 512 + 128 * g + n0) = cv;
            else *(v4u*)((bf16*)(F.ws + WS_CSIDE) + ((size_t)u * 3 + (t - 61)) * 128 + n0) = cv; }
    }
    {
        bf16* zp = (bf16*)P + (size_t)(row0 + t) * PP + C_Z + 128 * g + 16 * cg; float z0[8], z1[8]; unpk8(*(const v4u*)zp, z0); unpk8(*(const v4u*)(zp + 8), z1);
#pragma unroll
        for (int i = 0; i < 8; ++i) { z0[i] = silu_f(z0[i]); z1[i] = silu_f(z1[i]); }
        *(v4u*)zp = pk8(z0); *(v4u*)(zp + 8) = pk8(z1);
    }
    __syncthreads();
    {
        f32x4 acc[2] = {(f32x4){0.f, 0.f, 0.f, 0.f}, (f32x4){0.f, 0.f, 0.f, 0.f}};
        mma_nt<2, 4>(acc, BM, T136, 16 * (w & 3), CM, T136, 32 * (w >> 2), lane);
        const int m0 = 16 * (w & 3) + 4 * fq;
#pragma unroll
        for (int hh = 0; hh < 2; ++hh) { const float Dh = F.in[I_SD][l * 4 + 2 * g + hh];
#pragma unroll
            for (int tt = 0; tt < 2; ++tt) { const int lr = 32 * (w >> 2) + 16 * tt + fr; const float al = sacs[hh * 64 + lr];
                float o[4];
#pragma unroll
                for (int j = 0; j < 4; ++j) { const int m = m0 + j; o[j] = (m <= lr) ? acc[tt][j] * __expf(al - sacs[hh * 64 + m]) : 0.f; if (m == lr) o[j] += Dh / sdt[hh * 64 + lr]; }
                *(v2u*)(LD + hh * 9216 + lr * T72 + m0 * 2) = pk4(o[0], o[1], o[2], o[3]); } }
    }
    __syncthreads();
    {
        const int hh = w >> 2, h = 2 * g + hh;
        f32x4 ya[4];
#pragma unroll
        for (int tt = 0; tt < 4; ++tt) ya[tt] = (f32x4){0.f, 0.f, 0.f, 0.f};
        mma_nt<4, 2>(ya, XDT + hh * 9216, T72, 16 * (w & 3), LD + hh * 9216, T72, 0, lane);
#pragma unroll
        for (int tt = 0; tt < 4; ++tt) *(v2u*)(MIX + (size_t)(row0 + 16 * tt + fr) * D + 512 + 64 * h + 16 * (w & 3) + 4 * fq) = pk4(ya[tt].x, ya[tt].y, ya[tt].z, ya[tt].w);
        bf16* STT = (bf16*)(F.ws + WS_SST) + ((size_t)(b * 4 + h) * 64 + n) * 8192;
#pragma unroll
        for (int k2 = 0; k2 < 2; ++k2) { const int rb = (w & 3) + 4 * k2;
            f32x4 sa[4];
#pragma unroll
            for (int tt = 0; tt < 4; ++tt) sa[tt] = (f32x4){0.f, 0.f, 0.f, 0.f};
            mma_nt<4, 2>(sa, BMT, T72, 16 * rb, XST + hh * 9216, T72, 0, lane);
#pragma unroll
            for (int tt = 0; tt < 4; ++tt) *(v2u*)(STT + (16 * tt + fr) * 128 + 16 * rb + 4 * fq) = pk4(sa[tt].x, sa[tt].y, sa[tt].z, sa[tt].w); }
    }
    __syncthreads();
}
__device__ __forceinline__ void ssd_chain(Frame& F, int l, int b, int g, unsigned char* lds) {
    const int tid = F.tid, lane = F.lane, w = F.wave, fr = lane & 15, fq = lane >> 4;
    const bf16* P = (const bf16*)(F.ws + WS_P); bf16* MIX = (bf16*)(F.ws + WS_XN);
    const float* ACS = (const float*)(F.ws + WS_SCAL + SC_ACS);
    unsigned char* CM = lds; unsigned char* PV = lds + 17408; float* YZ = (float*)(lds + 52224); float* seacs = (float*)(lds + 85248); float* sdal = (float*)(lds + 85760);
    v2u* PZ = (v2u*)(lds + 86016) + tid;
    float prev[2][2][8];
#pragma unroll
    for (int hh = 0; hh < 2; ++hh)
#pragma unroll
        for (int i = 0; i < 2; ++i)
#pragma unroll
            for (int e = 0; e < 8; ++e) prev[hh][i][e] = 0.f;
    const bf16* stt = (const bf16*)(F.ws + WS_SST) + (size_t)(b * 4 + 2 * g) * 64 * 8192;
    const int t = tid >> 3, cg = tid & 7;
    const int hhw = w >> 2, hw = 2 * g + hhw, p0 = 16 * (w & 3) + 4 * fq;
    v4u pst[2][2], craw[2]; v2u ppv[4], zzv[4]; float acsv = 0.f;
    const bf16* cside = (const bf16*)(F.ws + WS_CSIDE) + (size_t)(b * 2 + g) * 64 * 3 * 128;
#pragma unroll
    for (int hh = 0; hh < 2; ++hh)
#pragma unroll
        for (int i = 0; i < 2; ++i) pst[hh][i] = (v4u){0u, 0u, 0u, 0u};
#pragma unroll
    for (int k = 0; k < 2; ++k) craw[k] = (t <= 60) ? *(const v4u*)(P + (size_t)(b * SEQ + t) * PP + C_XBC + 512 + 128 * g + 8 * (cg + 8 * k)) : *(const v4u*)(cside + (size_t)(t - 61) * 128 + 8 * (cg + 8 * k));
    if (tid < 128) acsv = ACS[(size_t)(b * 4 + 2 * g + (tid >> 6)) * SEQ + (tid & 63)];
#pragma unroll
    for (int tt = 0; tt < 4; ++tt) { const int lr = 16 * tt + fr;
        ppv[tt] = *(const v2u*)(MIX + (size_t)(b * SEQ + lr) * D + 512 + 64 * hw + p0); zzv[tt] = *(const v2u*)(P + (size_t)(b * SEQ + lr) * PP + C_Z + 64 * hw + p0); }
    float ngv[16];
#pragma unroll
    for (int i = 0; i < 16; ++i) ngv[i] = F.in[I_SNORM][l * 256 + 128 * g + 16 * cg + i];
    for (int n = 0; n < 64; ++n) {
        const int row0 = b * SEQ + n * 64, pos = n * 64 + t;
        {
#pragma unroll
            for (int hh = 0; hh < 2; ++hh) { const float da = (n > 0) ? sdal[2 * ((n - 1) & 1) + hh] : 0.f;
#pragma unroll
                for (int i = 0; i < 2; ++i) { float s8[8]; unpk8(pst[hh][i], s8);
#pragma unroll
                    for (int e = 0; e < 8; ++e) prev[hh][i][e] = prev[hh][i][e] * da + s8[e];
                    const int q = tid + 512 * i; *(v4u*)(PV + hh * 17408 + (q >> 4) * T136 + (q & 15) * 16) = pk8(prev[hh][i]); } }
        }
#pragma unroll
        for (int k = 0; k < 2; ++k) *(v4u*)(CM + t * T136 + (cg + 8 * k) * 16) = craw[k];
#pragma unroll
        for (int tt = 0; tt < 4; ++tt) { PZ[512 * (2 * tt)] = ppv[tt]; PZ[512 * (2 * tt + 1)] = zzv[tt]; }
        if (tid < 128) { const float ea = __expf(acsv); seacs[tid] = ea; if ((tid & 63) == 63) sdal[2 * (n & 1) + (tid >> 6)] = ea; }
#pragma unroll
        for (int hh = 0; hh < 2; ++hh)
#pragma unroll
            for (int i = 0; i < 2; ++i) pst[hh][i] = *(const v4u*)(stt + ((size_t)hh * 64 + n) * 8192 + (size_t)(tid + 512 * i) * 8);
        if (n + 1 < 64) {
#pragma unroll
            for (int k = 0; k < 2; ++k) craw[k] = (t <= 60) ? *(const v4u*)(P + (size_t)(row0 + 64 + t) * PP + C_XBC + 512 + 128 * g + 8 * (cg + 8 * k)) : *(const v4u*)(cside + ((size_t)(n + 1) * 3 + (t - 61)) * 128 + 8 * (cg + 8 * k));
            if (tid < 128) acsv = ACS[(size_t)(b * 4 + 2 * g + (tid >> 6)) * SEQ + (n + 1) * 64 + (tid & 63)];
#pragma unroll
            for (int tt = 0; tt < 4; ++tt) { const int lr = 16 * tt + fr;
                ppv[tt] = *(const v2u*)(MIX + (size_t)(row0 + 64 + lr) * D + 512 + 64 * hw + p0); zzv[tt] = *(const v2u*)(P + (size_t)(row0 + 64 + lr) * PP + C_Z + 64 * hw + p0); }
        }
        __syncthreads();
        {
            f32x4 ya[4];
#pragma unroll
            for (int tt = 0; tt < 4; ++tt) ya[tt] = (f32x4){0.f, 0.f, 0.f, 0.f};
            mma_nt<4, 4>(ya, PV + hhw * 17408, T136, 16 * (w & 3), CM, T136, 0, lane);
#pragma unroll
            for (int tt = 0; tt < 4; ++tt) { const int lr = 16 * tt + fr; const v2u pp = PZ[512 * (2 * tt)], zz = PZ[512 * (2 * tt + 1)];
                const float ea = seacs[hhw * 64 + lr];
                const float y0 = ea * ya[tt].x + bf2f(pp.x & 0xffffu), y1 = ea * ya[tt].y + bf2f(pp.x >> 16), y2 = ea * ya[tt].z + bf2f(pp.y & 0xffffu), y3 = ea * ya[tt].w + bf2f(pp.y >> 16);
                float* yz = YZ + lr * 129 + 64 * hhw + p0;
                yz[0] = y0 * bf2f(zz.x & 0xffffu); yz[1] = y1 * bf2f(zz.x >> 16); yz[2] = y2 * bf2f(zz.y & 0xffffu); yz[3] = y3 * bf2f(zz.y >> 16); }
        }
        __syncthreads();
        {
            float v[16]; float ss = 0.f;
#pragma unroll
            for (int i = 0; i < 16; ++i) { v[i] = YZ[t * 129 + 16 * cg + i]; ss += v[i] * v[i]; }
            ss += __shfl_xor(ss, 1); ss += __shfl_xor(ss, 2); ss += __shfl_xor(ss, 4);
            const float rr = rsqrt_f(ss * (1.f / 128.f) + EPS);
            float o0[8], o1[8];
#pragma unroll
            for (int i = 0; i < 8; ++i) { o0[i] = v[i] * rr * ngv[i]; o1[i] = v[8 + i] * rr * ngv[8 + i]; }
            bf16* op = MIX + (size_t)(row0 + t) * D + 512 + 128 * g + 16 * cg;
            *(v4u*)op = pk8(o0); *(v4u*)(op + 8) = pk8(o1);
        }
    }
    __syncthreads();
}
__device__ __forceinline__ void mlstm_local_unit(Frame& F, int l, int u, unsigned char* lds) {
    const int tid = F.tid, lane = F.lane, w = F.wave, fr = lane & 15, fq = lane >> 4;
    const int b = u >> 8, h = (u >> 6) & 3, n = u & 63, row0 = b * SEQ + n * 64;
    const bf16* P = (const bf16*)(F.ws + WS_P); const float* SM = (const float*)(F.ws + WS_SM); bf16* MIX = (bf16*)(F.ws + WS_XN);
    float* SC = (float*)(F.ws + WS_SCAL);
    unsigned char* QS = lds; unsigned char* KS = lds + 9216; unsigned char* VT = lds + 18432; unsigned char* KWT = lds + 27648; unsigned char* SS = lds + 36864; unsigned char* ONES = lds + 46080;
    float* sbb = (float*)(lds + 48384); float* sli = (float*)(lds + 48640); float* sdm = (float*)(lds + 48896); float* skw = (float*)(lds + 49152);
    const size_t tok = (size_t)(b * 4 + h) * SEQ + n * 64;
    if (w == 0) {
        const float* sm = SM + (size_t)(row0 + lane) * 32;
        const float li = sm[SM_I + h] + F.in[I_MIB][l * 4 + h], lf = -softplus_f(-(sm[SM_F + h] + F.in[I_MFB][l * 4 + h]));
        const float bb = wave_scan_add(lf, lane);
        const float dm = bb + wave_scan_max(li - bb, lane);
        const float bl = __shfl(bb, 63), ge = bl - bb + li, mloc = wave_max(ge);
        sbb[lane] = bb; sli[lane] = li; sdm[lane] = dm; skw[lane] = expf(ge - mloc);
        SC[SC_BB / 4 + tok + lane] = bb; SC[SC_DM / 4 + tok + lane] = dm;
        if (lane == 0) { SC[SC_MU / 4 + 2 * u] = mloc; SC[SC_MU / 4 + 2 * u + 1] = bl; }
    }
    if (tid < 16 * 9) ((v4u*)ONES)[tid] = (v4u){0x3f803f80u, 0x3f803f80u, 0x3f803f80u, 0x3f803f80u};
    const int t = tid >> 3, cg = tid & 7;
    const bf16* prow = P + (size_t)(row0 + t) * PP + 64 * h + 8 * cg;
    const v4u qv = *(const v4u*)(prow + D_Q), kv = *(const v4u*)(prow + D_K), vv = *(const v4u*)(prow + D_V);
    float k8[8], v8[8]; unpk8(kv, k8); unpk8(vv, v8);
    {
        float o8[8]; unpk8(*(const v4u*)(prow + D_O), o8);
#pragma unroll
        for (int i = 0; i < 8; ++i) o8[i] = sigmoid_f(o8[i]);
        *(v4u*)((bf16*)prow + D_O) = pk8(o8);
    }
    *(v4u*)(QS + t * T72 + cg * 16) = qv;
#pragma unroll
    for (int i = 0; i < 8; ++i) k8[i] *= 0.125f;
    *(v4u*)(KS + t * T72 + cg * 16) = pk8(k8);
#pragma unroll
    for (int i = 0; i < 8; ++i) *(unsigned short*)(VT + (8 * cg + i) * T72 + t * 2) = (unsigned short)f2bf(v8[i]);
    __syncthreads();
    { const float kw = skw[t];
#pragma unroll
      for (int i = 0; i < 8; ++i) *(unsigned short*)(KWT + (8 * cg + i) * T72 + t * 2) = (unsigned short)f2bf(k8[i] * kw); }
    {
        f32x4 acc[2] = {(f32x4){0.f, 0.f, 0.f, 0.f}, (f32x4){0.f, 0.f, 0.f, 0.f}};
        mma_nt<2, 2>(acc, KS, T72, 16 * (w & 3), QS, T72, 32 * (w >> 2), lane);
        const int m0 = 16 * (w & 3) + 4 * fq;
#pragma unroll
        for (int tt = 0; tt < 2; ++tt) { const int c = 32 * (w >> 2) + 16 * tt + fr; const float base = sbb[c] - sdm[c];
            float o[4];
#pragma unroll
            for (int j = 0; j < 4; ++j) { const int m = m0 + j; o[j] = (m <= c) ? acc[tt][j] * __expf(base - sbb[m] + sli[m]) : 0.f; }
            *(v2u*)(SS + c * T72 + m0 * 2) = pk4(o[0], o[1], o[2], o[3]); }
    }
    __syncthreads();
    {
        const int e0 = 16 * (w & 3) + 4 * fq;
        f32x4 na[2] = {(f32x4){0.f, 0.f, 0.f, 0.f}, (f32x4){0.f, 0.f, 0.f, 0.f}};
        mma_nt<2, 2>(na, VT, T72, 16 * (w & 3), SS, T72, 32 * (w >> 2), lane);
#pragma unroll
        for (int tt = 0; tt < 2; ++tt) *(v2u*)(MIX + (size_t)(row0 + 32 * (w >> 2) + 16 * tt + fr) * D + 768 + 64 * h + e0) = pk4(na[tt].x, na[tt].y, na[tt].z, na[tt].w);
        f32x4 ka[2] = {(f32x4){0.f, 0.f, 0.f, 0.f}, (f32x4){0.f, 0.f, 0.f, 0.f}};
        mma_nt<2, 2>(ka, KWT, T72, 16 * (w & 3), VT, T72, 32 * (w >> 2), lane);
        bf16* KCT = (bf16*)(F.ws + WS_MKC) + (size_t)u * 4096;
#pragma unroll
        for (int tt = 0; tt < 2; ++tt) *(v2u*)(KCT + (32 * (w >> 2) + 16 * tt + fr) * 64 + e0) = pk4(ka[tt].x, ka[tt].y, ka[tt].z, ka[tt].w);
        if (w < 4) {
            f32x4 da[1] = {(f32x4){0.f, 0.f, 0.f, 0.f}}, nn[1] = {(f32x4){0.f, 0.f, 0.f, 0.f}};
            mma_nt<1, 2>(da, ONES, T72, 0, SS, T72, 16 * w, lane);
            mma_nt<1, 2>(nn, KWT, T72, 16 * w, ONES, T72, 0, lane);
            if (fq == 0) SC[SC_DEN / 4 + tok + 16 * w + fr] = da[0].x;
            if (fr == 0) *(f32x4*)(SC + SC_NC / 4 + (size_t)u * 64 + 16 * w + 4 * fq) = nn[0];
        }
    }
    __syncthreads();
}
__device__ __forceinline__ void mlstm_chain(Frame& F, int l, int b, int h, unsigned char* lds) {
    const int tid = F.tid, lane = F.lane, w = F.wave, fr = lane & 15, fq = lane >> 4;
    const bf16* P = (const bf16*)(F.ws + WS_P); bf16* MIX = (bf16*)(F.ws + WS_XN);
    const float* SC = (const float*)(F.ws + WS_SCAL);
    unsigned char* QS = lds; unsigned char* CT[2] = {lds + 9216, lds + 18432}; unsigned char* NB[2] = {lds + 27648, lds + 29952};
    float* swst = (float*)(lds + 32256); float* ssloc = (float*)(lds + 32512); float* semt = (float*)(lds + 32768); float* sden = (float*)(lds + 33024);
    v2u* NO = (v2u*)(lds + 33280) + (tid & 255);
    const int u0 = (b * 4 + h) * 64; const size_t tok0 = (size_t)(b * 4 + h) * SEQ;
    for (int i = tid; i < (9216 + 2304) / 4; i += 512) { if (i < 2304) ((unsigned*)CT[0])[i] = 0u; else ((unsigned*)NB[0])[i - 2304] = 0u; }
    const int se = (tid - 256) >> 2, sd0 = 16 * ((tid - 256) & 3);
    float Cm[16], nm[16];
#pragma unroll
    for (int i = 0; i < 16; ++i) { Cm[i] = 0.f; nm[i] = 0.f; }
    float m_st = 0.f;
    const int t = tid >> 3, cg = tid & 7, cw_ = 16 * (w & 3) + fr;
    float ngv[4][4];
#pragma unroll
    for (int rb = 0; rb < 4; ++rb)
#pragma unroll
        for (int j = 0; j < 4; ++j) ngv[rb][j] = F.in[I_MNORM][l * 256 + 64 * h + 16 * rb + 4 * fq + j];
    v4u pq = *(const v4u*)(P + (size_t)(b * SEQ + t) * PP + D_Q + 64 * h + 8 * cg);
    float pbb = 0.f, pdm = 0.f, pden = 0.f;
    if (tid < 64) { pbb = SC[SC_BB / 4 + tok0 + tid]; pdm = SC[SC_DM / 4 + tok0 + tid]; pden = SC[SC_DEN / 4 + tok0 + tid]; }
    float pml = SC[SC_MU / 4 + 2 * u0], pbl = SC[SC_MU / 4 + 2 * u0 + 1];
    v4u pk0 = {0u, 0u, 0u, 0u}, pk1 = {0u, 0u, 0u, 0u}; f32x4 pn[4] = {(f32x4){0.f, 0.f, 0.f, 0.f}, (f32x4){0.f, 0.f, 0.f, 0.f}, (f32x4){0.f, 0.f, 0.f, 0.f}, (f32x4){0.f, 0.f, 0.f, 0.f}};
    v2u pnl[4], pog[4];
#pragma unroll
    for (int rb = 0; rb < 4; ++rb) { pnl[rb] = (v2u){0u, 0u}; pog[rb] = (v2u){0u, 0u}; }
    if (w >= 4) { const bf16* kct = (const bf16*)(F.ws + WS_MKC) + (size_t)u0 * 4096 + se * 64 + sd0; pk0 = *(const v4u*)kct; pk1 = *(const v4u*)(kct + 8);
        const float* ncp = SC + SC_NC / 4 + (size_t)u0 * 64 + sd0;
#pragma unroll
        for (int i = 0; i < 4; ++i) pn[i] = *(const f32x4*)(ncp + 4 * i);
    } else {
#pragma unroll
        for (int rb = 0; rb < 4; ++rb) { pnl[rb] = *(const v2u*)(MIX + (size_t)(b * SEQ + cw_) * D + 768 + 64 * h + 16 * rb + 4 * fq); pog[rb] = *(const v2u*)(P + (size_t)(b * SEQ + cw_) * PP + D_O + 64 * h + 16 * rb + 4 * fq); }
    }
    for (int n = 0; n < 64; ++n) {
        const int row0 = b * SEQ + n * 64, cur = n & 1;
        *(v4u*)(QS + t * T72 + cg * 16) = pq;
        if (tid < 64) { const float mt = fmaxf(pbb + m_st, pdm); swst[tid] = __expf(pbb + m_st - mt); ssloc[tid] = __expf(pdm - mt); semt[tid] = __expf(-mt); sden[tid] = pden; }
        const float m_new = fmaxf(pbl + m_st, pml), fa = __expf(pbl + m_st - m_new), fb = __expf(pml - m_new);
        m_st = m_new;
        if (w >= 4) {
            float k0[8], k1[8]; unpk8(pk0, k0); unpk8(pk1, k1);
            const float ncv[16] = {pn[0].x, pn[0].y, pn[0].z, pn[0].w, pn[1].x, pn[1].y, pn[1].z, pn[1].w, pn[2].x, pn[2].y, pn[2].z, pn[2].w, pn[3].x, pn[3].y, pn[3].z, pn[3].w};
            float o0[8], o1[8];
#pragma unroll
            for (int i = 0; i < 8; ++i) { Cm[i] = Cm[i] * fa + k0[i] * fb; Cm[8 + i] = Cm[8 + i] * fa + k1[i] * fb; nm[i] = nm[i] * fa + ncv[i] * fb; nm[8 + i] = nm[8 + i] * fa + ncv[8 + i] * fb; o0[i] = Cm[i]; o1[i] = Cm[8 + i]; }
            *(v4u*)(CT[cur ^ 1] + se * T72 + sd0 * 2) = pk8(o0); *(v4u*)(CT[cur ^ 1] + se * T72 + sd0 * 2 + 16) = pk8(o1);
            if (se < 16) {
#pragma unroll
                for (int i = 0; i < 8; ++i) { o0[i] = nm[i]; o1[i] = nm[8 + i]; }
                *(v4u*)(NB[cur ^ 1] + se * T72 + sd0 * 2) = pk8(o0); *(v4u*)(NB[cur ^ 1] + se * T72 + sd0 * 2 + 16) = pk8(o1); }
        } else {
#pragma unroll
            for (int rb = 0; rb < 4; ++rb) { NO[256 * (2 * rb)] = pnl[rb]; NO[256 * (2 * rb + 1)] = pog[rb]; }
        }
        if (n + 1 < 64) {
            pq = *(const v4u*)(P + (size_t)(row0 + 64 + t) * PP + D_Q + 64 * h + 8 * cg);
            if (tid < 64) { pbb = SC[SC_BB / 4 + tok0 + (n + 1) * 64 + tid]; pdm = SC[SC_DM / 4 + tok0 + (n + 1) * 64 + tid]; pden = SC[SC_DEN / 4 + tok0 + (n + 1) * 64 + tid]; }
            pml = SC[SC_MU / 4 + 2 * (u0 + n + 1)]; pbl = SC[SC_MU / 4 + 2 * (u0 + n + 1) + 1];
            if (w >= 4) { const bf16* kct = (const bf16*)(F.ws + WS_MKC) + (size_t)(u0 + n + 1) * 4096 + se * 64 + sd0; pk0 = *(const v4u*)kct; pk1 = *(const v4u*)(kct + 8);
                const float* ncp = SC + SC_NC / 4 + (size_t)(u0 + n + 1) * 64 + sd0;
#pragma unroll
                for (int i = 0; i < 4; ++i) pn[i] = *(const f32x4*)(ncp + 4 * i);
            } else {
#pragma unroll
                for (int rb = 0; rb < 4; ++rb) { pnl[rb] = *(const v2u*)(MIX + (size_t)(row0 + 64 + cw_) * D + 768 + 64 * h + 16 * rb + 4 * fq); pog[rb] = *(const v2u*)(P + (size_t)(row0 + 64 + cw_) * PP + D_O + 64 * h + 16 * rb + 4 * fq); }
            }
        }
        __syncthreads();
        if (w < 4) {
            f32x4 na[4][1], dd[1] = {(f32x4){0.f, 0.f, 0.f, 0.f}};
#pragma unroll
            for (int rb = 0; rb < 4; ++rb) { na[rb][0] = (f32x4){0.f, 0.f, 0.f, 0.f}; mma_nt<1, 2>(na[rb], CT[cur], T72, 16 * rb, QS, T72, 16 * w, lane); }
            mma_nt<1, 2>(dd, NB[cur], T72, 0, QS, T72, 16 * w, lane);
            const int c = cw_; const float ws_ = swst[c], sl = ssloc[c];
            const float den = ws_ * dd[0].x + sl * sden[c], inv = __builtin_amdgcn_rcpf(fmaxf(fabsf(den), semt[c]));
            float hv[4][4]; float ss = 0.f;
#pragma unroll
            for (int rb = 0; rb < 4; ++rb) { const v2u nl = NO[256 * (2 * rb)], og = NO[256 * (2 * rb + 1)];
                const float nlv[4] = {bf2f(nl.x & 0xffffu), bf2f(nl.x >> 16), bf2f(nl.y & 0xffffu), bf2f(nl.y >> 16)}, ogv[4] = {bf2f(og.x & 0xffffu), bf2f(og.x >> 16), bf2f(og.y & 0xffffu), bf2f(og.y >> 16)};
#pragma unroll
                for (int j = 0; j < 4; ++j) { hv[rb][j] = (ws_ * na[rb][0][j] + sl * nlv[j]) * inv * ogv[j]; ss += hv[rb][j] * hv[rb][j]; } }
            ss += __shfl_xor(ss, 16); ss += __shfl_xor(ss, 32);
            const float rr = rsqrt_f(ss * (1.f / 64.f) + EPS);
#pragma unroll
            for (int rb = 0; rb < 4; ++rb) *(v2u*)(MIX + (size_t)(row0 + c) * D + 768 + 64 * h + 16 * rb + 4 * fq) = pk4(hv[rb][0] * rr * ngv[rb][0], hv[rb][1] * rr * ngv[rb][1], hv[rb][2] * rr * ngv[rb][2], hv[rb][3] * rr * ngv[rb][3]);
        }
        __syncthreads();
    }
}
constexpr int AT_KROW = 80, AT_VT = 2 * 64 * AT_KROW, AT_SLOT = AT_VT + 8192, AT_OX = 40960;
typedef short v4i16_t __attribute__((ext_vector_type(4)));
__device__ __forceinline__ v2u vtr(const unsigned char* p) { return __builtin_bit_cast(v2u, __builtin_amdgcn_ds_read_tr16_b64_v4i16((LAS v4i16_t*)p)); }
static_assert(2 * AT_SLOT <= AT_OX, "attention LDS map");
struct AttnState { f32x16 o1a, o1b, o2a, o2b; float m1, l1, m2, l2; };
__device__ __forceinline__ void attn_softmax(f32x16& s0, f32x16& s1, float& m_run, float& l_run, f32x16& oa, f32x16& ob, bf16x8 (&pf)[4]) {
    float mx = fmaxf(s0[0], s1[0]);
#pragma unroll
    for (int i = 1; i < 16; ++i) mx = fmaxf(mx, fmaxf(s0[i], s1[i]));
    mx = fmaxf(mx, __shfl_xor(mx, 32));
    const float mn = fmaxf(m_run, mx), alpha = __builtin_amdgcn_exp2f(m_run - mn); m_run = mn;
    float rs = 0.f;
#pragma unroll
    for (int i = 0; i < 16; ++i) { s0[i] = __builtin_amdgcn_exp2f(s0[i] - mn); s1[i] = __builtin_amdgcn_exp2f(s1[i] - mn); rs += s0[i] + s1[i]; }
    l_run = l_run * alpha + rs;
#pragma unroll
    for (int i = 0; i < 16; ++i) { oa[i] *= alpha; ob[i] *= alpha; }
#pragma unroll
    for (int st = 0; st < 2; ++st) {
        v4u a, c;
        a.x = pk2(s0[8 * st + 0], s0[8 * st + 1]); a.y = pk2(s0[8 * st + 2], s0[8 * st + 3]); a.z = pk2(s0[8 * st + 4], s0[8 * st + 5]); a.w = pk2(s0[8 * st + 6], s0[8 * st + 7]);
        c.x = pk2(s1[8 * st + 0], s1[8 * st + 1]); c.y = pk2(s1[8 * st + 2], s1[8 * st + 3]); c.z = pk2(s1[8 * st + 4], s1[8 * st + 5]); c.w = pk2(s1[8 * st + 6], s1[8 * st + 7]);
        pf[st] = __builtin_bit_cast(bf16x8, a); pf[2 + st] = __builtin_bit_cast(bf16x8, c);
    }
}
__device__ __forceinline__ void attn_map(const unsigned char* kM, const unsigned char* vA, const bf16x8 Q0, const bf16x8 Q1, float& m_run, float& l_run, f32x16& oa, f32x16& ob) {
    bf16x8 p[4];
    {
        f32x16 sa, sb;
#pragma unroll
        for (int i = 0; i < 16; ++i) { sa[i] = 0.f; sb[i] = 0.f; }
        sa = __builtin_amdgcn_mfma_f32_32x32x16_bf16(*(const bf16x8*)(kM), Q0, sa, 0, 0, 0);
        sa = __builtin_amdgcn_mfma_f32_32x32x16_bf16(*(const bf16x8*)(kM + 32), Q1, sa, 0, 0, 0);
        sb = __builtin_amdgcn_mfma_f32_32x32x16_bf16(*(const bf16x8*)(kM + 32 * AT_KROW), Q0, sb, 0, 0, 0);
        sb = __builtin_amdgcn_mfma_f32_32x32x16_bf16(*(const bf16x8*)(kM + 32 * AT_KROW + 32), Q1, sb, 0, 0, 0);
        attn_softmax(sa, sb, m_run, l_run, oa, ob, p);
    }
#pragma unroll
    for (int ks = 0; ks < 4; ++ks) {
        const unsigned char* va = vA + ks * 1024;
        const v2u lo0 = vtr(va), hi0 = vtr(va + 512), lo1 = vtr(va + 4096), hi1 = vtr(va + 4096 + 512);
        const bf16x8 a0 = __builtin_bit_cast(bf16x8, (v4u){lo0.x, lo0.y, hi0.x, hi0.y}), a1 = __builtin_bit_cast(bf16x8, (v4u){lo1.x, lo1.y, hi1.x, hi1.y});
        oa = __builtin_amdgcn_mfma_f32_32x32x16_bf16(a0, p[ks], oa, 0, 0, 0);
        ob = __builtin_amdgcn_mfma_f32_32x32x16_bf16(a1, p[ks], ob, 0, 0, 0);
    }
}
__device__ __forceinline__ void attn_tile(const unsigned char* slot, int r32, int hh, const bf16x8 Qa0, const bf16x8 Qa1, const bf16x8 Qb0, const bf16x8 Qb1, AttnState& A) {
    const unsigned char* kA = slot + r32 * AT_KROW + hh * 16;
    const int lane_ = r32 + 32 * hh;
    const unsigned char* vA = slot + AT_VT + ((lane_ >> 4) & 1) * 32 + (lane_ & 3) * 8 + (4 * hh + ((lane_ & 15) >> 2)) * 64;
    attn_map(kA, vA, Qa0, Qa1, A.m1, A.l1, A.o1a, A.o1b);
    __builtin_amdgcn_sched_barrier(0);
    attn_map(kA + 64 * AT_KROW, vA, Qb0, Qb1, A.m2, A.l2, A.o2a, A.o2b);
}
__device__ __forceinline__ void attn_stage(unsigned char* slot, int kmap, int kkey, int kpc, int vg, int vkey, const v4u kreg, const v4u vreg) {
    *(v4u*)(slot + kmap * (64 * AT_KROW) + kkey * AT_KROW + kpc * 16) = kreg;
    *(v4u*)(slot + AT_VT + (vg >> 2) * 4096 + vkey * 64 + (vg & 3) * 16) = vreg;
}
__device__ __forceinline__ void attn_unit(Frame& F, const bf16* P, bf16* MIX, int b, int h, int qb, float lam, const float* normg, float oscale, unsigned char* lds) {
    const int tid = F.tid, lane = F.lane, w = F.wave, r32 = lane & 31, hh = lane >> 5;
    const int q0 = qb * 256 + w * 32;
    const int my_last = 4 * qb + (w >> 1), nt = 4 * qb + 4;
    const bf16* qrow = P + (size_t)(b * SEQ + q0 + r32) * PP + B_Q + 64 * h + 8 * hh;
    const bf16x8 Qa0 = *(const bf16x8*)qrow, Qa1 = *(const bf16x8*)(qrow + 16), Qb0 = *(const bf16x8*)(qrow + 32), Qb1 = *(const bf16x8*)(qrow + 48);
    AttnState A;
#pragma unroll
    for (int i = 0; i < 16; ++i) { A.o1a[i] = 0.f; A.o1b[i] = 0.f; A.o2a[i] = 0.f; A.o2b[i] = 0.f; }
    A.m1 = -1e30f; A.m2 = -1e30f; A.l1 = 0.f; A.l2 = 0.f;
    const int kmap = tid >> 8, kkey = (tid >> 2) & 63, kpc = tid & 3, vkey = tid >> 3, vg = tid & 7;
    const bf16* ksrc = P + (size_t)(b * SEQ + kkey) * PP + B_K + 32 * (2 * h + kmap) + 8 * kpc;
    const bf16* vsrc = P + (size_t)(b * SEQ + vkey) * PP + B_V + 64 * h + 8 * vg;
    const size_t tstep = (size_t)64 * PP;
    unsigned char* slot0 = lds; unsigned char* slot1 = lds + AT_SLOT;
    v4u kr0 = *(const v4u*)ksrc, vr0 = *(const v4u*)vsrc;
    v4u kr1 = *(const v4u*)(ksrc + tstep), vr1 = *(const v4u*)(vsrc + tstep);
    __syncthreads();
    attn_stage(slot0, kmap, kkey, kpc, vg, vkey, kr0, vr0);
    kr0 = *(const v4u*)(ksrc + 2 * tstep); vr0 = *(const v4u*)(vsrc + 2 * tstep);
    __syncthreads();
#define ATT_STEP(tj, SLOTC, SLOTN, KR, VR) do { \
        if ((tj) + 1 < nt) { attn_stage(SLOTN, kmap, kkey, kpc, vg, vkey, KR, VR); \
            if ((tj) + 3 < nt) { KR = *(const v4u*)(ksrc + (size_t)((tj) + 3) * tstep); VR = *(const v4u*)(vsrc + (size_t)((tj) + 3) * tstep); } } \
        if ((tj) <= my_last) attn_tile(SLOTC, r32, hh, Qa0, Qa1, Qb0, Qb1, A); \
        __syncthreads(); } while (0)
    for (int j = 0; j < nt; j += 2) {
        ATT_STEP(j, slot0, slot1, kr1, vr1);
        ATT_STEP(j + 1, slot1, slot0, kr0, vr0);
    }
#undef ATT_STEP
    const float i1 = 1.0f / (A.l1 + __shfl_xor(A.l1, 32)), i2 = lam / (A.l2 + __shfl_xor(A.l2, 32));
    float ss = 0.f;
#pragma unroll
    for (int i = 0; i < 16; ++i) { A.o1a[i] = A.o1a[i] * i1 - A.o2a[i] * i2; A.o1b[i] = A.o1b[i] * i1 - A.o2b[i] * i2; ss += A.o1a[i] * A.o1a[i] + A.o1b[i] * A.o1b[i]; }
    ss += __shfl_xor(ss, 32);
    const float r = oscale * rsqrt_f(ss * (1.f / 64.f) + EPS);
    bf16* orow = MIX + (size_t)(b * SEQ + q0 + r32) * D + 256 + 64 * h;
#pragma unroll
    for (int g4 = 0; g4 < 4; ++g4) { const int dv = 8 * g4 + 4 * hh;
        const f32x4 ga = *(const f32x4*)(normg + dv), gb = *(const f32x4*)(normg + 32 + dv);
        v2u wa, wb; wa.x = pk2(A.o1a[4 * g4] * r * ga.x, A.o1a[4 * g4 + 1] * r * ga.y); wa.y = pk2(A.o1a[4 * g4 + 2] * r * ga.z, A.o1a[4 * g4 + 3] * r * ga.w);
        wb.x = pk2(A.o1b[4 * g4] * r * gb.x, A.o1b[4 * g4 + 1] * r * gb.y); wb.y = pk2(A.o1b[4 * g4 + 2] * r * gb.z, A.o1b[4 * g4 + 3] * r * gb.w);
        *(v2u*)(orow + dv) = wa; *(v2u*)(orow + 32 + dv) = wb; }
}
__device__ __forceinline__ void attn_pull(Frame& F, int l, gu32* cnt8, int first, int limit) {
    const bf16* P = (const bf16*)(F.ws + WS_P); bf16* MIX = (bf16*)(F.ws + WS_XN);
    const float lambda_init = 0.8f - 0.6f * expf(-0.3f * (float)l);
    float d1 = 0.f, d2 = 0.f;
    if (F.lane < 32) { d1 = F.in[I_LQ1][l * 32 + F.lane] * F.in[I_LK1][l * 32 + F.lane]; d2 = F.in[I_LQ2][l * 32 + F.lane] * F.in[I_LK2][l * 32 + F.lane]; }
    const float lam = expf(wave_sum(d1)) - expf(wave_sum(d2)) + lambda_init;
    const float* normg = F.in[I_DNORM] + l * 64;
    const int x0 = (int)(xb_xcc_id() & 7u);
    for (int xo = 0; xo < 8; ++xo) {
        const int x = (x0 + xo) & 7; gu32* cnt = cnt8 + 64 * x;
        for (;;) {
            __syncthreads();
            if (F.tid == 0) F.MISC[16] = (unsigned)first + __hip_atomic_fetch_add(cnt, 1u, RLX_AGENT);
            __syncthreads();
            const int i = (int)F.MISC[16];
            if (i >= limit) break;
            const int qb = 15 - (i >> 2), bh = x + 8 * (i & 3);
            attn_unit(F, P, MIX, bh >> 2, bh & 3, qb, lam, normg, 1.0f - lambda_init, F.lds);
        }
    }
}
#if PROBE_SEL
#define STAMPX(id) do { if (F.tid == 0) ((unsigned long long*)(F.ws + WS_CTL + 512 * 1024))[(64 + (id)) * 256 + blockIdx.x] = __builtin_amdgcn_s_memrealtime(); } while (0)
#else
#define STAMPX(id) do { } while (0)
#endif
constexpr int ATT_B = 32;
constexpr int CW_ATT = 12288;
__device__ __forceinline__ void mixer_phaseA(Frame& F, int l) {
    const int bid = blockIdx.x, G = F.G;
    {
        float* cg_ = (float*)(F.lds + CW_GDN); float* cs_ = (float*)(F.lds + CW_SSD);
        const float* gw = F.in[I_GCONV] + (size_t)l * 3072; const float* sw = F.in[I_SCONVW] + (size_t)l * 3072; const float* sb = F.in[I_SCONVB] + (size_t)l * 768;
        for (int i = F.tid; i < 3072; i += 512) { cg_[i] = gw[i]; cs_[i] = sw[i]; }
        for (int i = F.tid; i < 768; i += 512) cs_[3072 + i] = sb[i];
        __syncthreads();
    }
    STAMPX(1); for (int u = bid; u < BATCH * 4 * 64; u += G) gdn_local_unit(F, l, u, F.lds);
    STAMPX(2); for (int u = bid; u < BATCH * 2 * 64; u += G) ssd_local_unit(F, l, u, F.lds);
    STAMPX(3); for (int u = bid; u < BATCH * 4 * 64; u += G) mlstm_local_unit(F, l, u, F.lds);
    STAMPX(4); attn_pull(F, l, F.ctl + CW_ATT + (2 * l + 1) * 512, ATT_B, 64);
    STAMPX(5);
}
__device__ __forceinline__ void mixer_phaseB(Frame& F, int l) {
    const int bid = blockIdx.x;
    STAMPX(8);
    if (bid < 32) gdn_chain(F, l, bid >> 2, bid & 3, F.lds);
    else if (bid < 48) ssd_chain(F, l, (bid - 32) >> 1, (bid - 32) & 1, F.lds);
    else if (bid < 80) mlstm_chain(F, l, (bid - 48) >> 2, (bid - 48) & 3, F.lds);
    STAMPX(9);
    attn_pull(F, l, F.ctl + CW_ATT + (2 * l) * 512, 0, ATT_B);
    STAMPX(10);
}
struct Args { const float* in[N_IN]; float* out; unsigned char* ws; int ph_lo, ph_hi, pad0, pad1; };
constexpr int N_SLOTS = 1 + NLAYER * 3 * 5;
__host__ __device__ constexpr bool slot_used(int p) { return p == 0 || ((((p - 1) / 5) % 3) == 1) || (((p - 1) % 5) != 1 && ((p - 1) % 5) != 2); }

__global__ void __launch_bounds__(NWAVES * 64, 2) mk_fwd(Args args) {
    extern __shared__ __attribute__((aligned(16))) unsigned char lds[];
    Frame F;
    F.lds = lds;
    F.MISC = (volatile LAS unsigned*)((LAS unsigned char*)lds + MISC_OFF);
    F.tid = threadIdx.x; F.lane = F.tid & 63; F.wave = __builtin_amdgcn_readfirstlane(F.tid >> 6);
    F.G = gridDim.x; { const int bx = blockIdx.x; F.vcu = (F.G % 8 == 0) ? (bx % 8) * (F.G / 8) + bx / 8 : bx; }
    F.in = args.in; F.out = args.out; F.ws = args.ws;
    F.ctl = (gu32*)(args.ws + WS_CTL);
    for (int u = F.tid; u < (LDS_BYTES - LDSCTL_OFF) / 4; u += NWAVES * 64) ((LAS unsigned*)((LAS unsigned char*)lds + LDSCTL_OFF))[u] = 0u;
    __syncthreads();
    XcdBarrier bar; bar.bar = (unsigned*)(F.ctl + CW_BAR); bar.x = 0; bar.st = nullptr;
    if (N_LAUNCHES == 1) bar = xcd_barrier_post((unsigned*)(F.ctl + CW_BAR), F.MISC + 8);
    const int lo = args.ph_lo, hi = args.ph_hi;
#define IN(k) (lo <= (k) && (k) < hi)
#if PROBE_SEL
    unsigned long long* const tsb = (unsigned long long*)(args.ws + WS_CTL + 512 * 1024);
#define STAMP(slot, which) do { if (F.tid == 0) tsb[((slot) * 2 + (which)) * 256 + blockIdx.x] = __builtin_amdgcn_s_memrealtime(); } while (0)
#else
#define STAMP(slot, which) do { } while (0)
#endif
#define SEAM(k) do { if ((k) + 1 < hi) { if (N_LAUNCHES == 1) xcd_barrier(bar); } } while (0)
    bf16* XN = (bf16*)(F.ws + WS_XN); bf16* Y = (bf16*)(F.ws + WS_Y); bf16* P = (bf16*)(F.ws + WS_P); float* SM = (float*)(F.ws + WS_SM);
    PG8_LAS unsigned char* ring = (PG8_LAS unsigned char*)lds + RING_OFF;

    if (IN(0)) {
        STAMP(0, 0); p0_prologue(F);
        post_rows(F, F.in[I_X], nullptr, 0.f, nullptr, nullptr, F.in[I_F1PRE], XN, false, false, true);
        STAMP(0, 1); SEAM(0);
    }
#define SUBBLOCK(l, sb) do { \
        unsigned char* wl = F.ws + WS_W + (size_t)(l) * W_LAYER; \
        constexpr int base = 1 + ((l) * 3 + (sb)) * 5; \
        if (IN(base)) { STAMP(base, 0); \
            if ((sb) != 1) { \
                pg8::Gemm g{XN, (const bf16*)(wl + ((sb) == 0 ? WL_GU1 : WL_GU2)), M, 2 * FF, D}; pg8::StaticOrder S; S.init(M, 2 * FF, F.G, (int)blockIdx.x); \
                pg8::EpiSwiglu E{P, FF}; \
                pg8::gemm_phase<pg8::EpiSwiglu, pg8::StaticOrder, PG8_ALIGN, PG8_SP2>(ring, g, S, E); \
            } else { \
                pg8::Gemm g{XN, (const bf16*)(wl + WL_IN), M, 4096, D}; pg8::StaticOrder S; S.init(M, 4096, F.G, (int)blockIdx.x); \
                pg8::EpiProj E{P, SM, (const float*)(F.ws + WS_ROPE), (const float*)(F.ws + WS_ROPE) + SEQ * 16}; \
                pg8::gemm_phase<pg8::EpiProj, pg8::StaticOrder, PG8_ALIGN, PG8_SP2>(ring, g, S, E); \
            } \
            STAMP(base, 1); SEAM(base); \
        } \
        if ((sb) == 1 && IN(base + 1)) { STAMP(base + 1, 0); mixer_phaseA(F, (l)); STAMP(base + 1, 1); SEAM(base + 1); } \
        if ((sb) == 1 && IN(base + 2)) { STAMP(base + 2, 0); mixer_phaseB(F, (l)); STAMP(base + 2, 1); SEAM(base + 2); } \
        if (IN(base + 3)) { STAMP(base + 3, 0); \
            const bf16* A = (sb) == 1 ? XN : P; const int K = (sb) == 1 ? D : FF; \
            const bf16* Bt = (const bf16*)(wl + ((sb) == 0 ? WL_D1 : (sb) == 1 ? WL_OUT : WL_D2)); \
            pg8::Gemm g{A, Bt, M, D, K}; pg8::StaticOrder S; S.init(M, D, F.G, (int)blockIdx.x); \
            pg8::EpiBf16<0> E{Y, D, nullptr, 0, 0, 1.f}; \
            pg8::gemm_phase<pg8::EpiBf16<0>, pg8::StaticOrder, PG8_ALIGN, PG8_SP2>(ring, g, S, E); \
            STAMP(base + 3, 1); SEAM(base + 3); \
        } \
        if (IN(base + 4)) { STAMP(base + 4, 0); \
            const float* xsrc = ((l) == 0 && (sb) == 0) ? F.in[I_X] : F.out; \
            const float* gpost = F.in[(sb) == 0 ? I_F1POST : (sb) == 1 ? I_MIXPOST : I_F2POST] + (l) * D; \
            constexpr bool last = ((l) == NLAYER - 1 && (sb) == 2); \
            const float* gpre = (sb) == 0 ? F.in[I_MIXPRE] + (l) * D : (sb) == 1 ? F.in[I_F2PRE] + (l) * D : F.in[I_F1PRE] + (last ? 0 : ((l) + 1) * D); \
            post_rows(F, xsrc, Y, (sb) == 1 ? 1.0f : 0.5f, gpost, F.out, gpre, XN, true, true, !last); \
            STAMP(base + 4, 1); SEAM(base + 4); \
        } } while (0)
    SUBBLOCK(0, 0); SUBBLOCK(0, 1); SUBBLOCK(0, 2); SUBBLOCK(1, 0); SUBBLOCK(1, 1); SUBBLOCK(1, 2);
#undef SUBBLOCK
#if PROBE_SEL
    if (N_LAUNCHES == 1) {
        asm volatile("s_waitcnt vmcnt(0)" ::: "memory");
        xcd_barrier(bar);
        if (blockIdx.x == 0 && F.tid == 0) {
            unsigned long long total = 0;
            for (int p = 0; p < N_SLOTS; ++p) {
                if (!slot_used(p)) continue;
                const int k = (p == 0) ? -1 : (p - 1) % 5; bool sel = false; int wsel = -1;
                if (PROBE_SEL == 1) sel = (k == 0 || k == 3);
                if (PROBE_SEL == 2) sel = (k == 1);
                if (PROBE_SEL == 3) sel = (k == 2);
                if (PROBE_SEL == 4) sel = (k == 4 || k == -1);
                if (PROBE_SEL == 5) { sel = (k == 2); wsel = 0; }
                if (PROBE_SEL == 6) { sel = (k == 2); wsel = 32; }
                if (PROBE_SEL == 7) { sel = (k == 2); wsel = 48; }
                if (PROBE_SEL == 8) { sel = (k == 2); wsel = 80; }
                if (!sel) continue;
                unsigned long long mn = ~0ull, mx = 0ull;
                for (int wg = 0; wg < (int)gridDim.x; ++wg) { if (wsel >= 0 && wg != wsel) continue;
                    const unsigned long long s = __hip_atomic_load(&tsb[(p * 2 + 0) * 256 + wg], RLX_AGENT), e2 = __hip_atomic_load(&tsb[(p * 2 + 1) * 256 + wg], RLX_AGENT);
                    mn = s < mn ? s : mn; mx = e2 > mx ? e2 : mx; }
                total += mx - mn;
            }
            if (PROBE_SEL == 99) { total = __hip_atomic_load(&tsb[(64 + PROBE_B) * 256 + PROBE_WG], RLX_AGENT) - __hip_atomic_load(&tsb[(64 + PROBE_A) * 256 + PROBE_WG], RLX_AGENT); }
            if (PROBE_SEL >= 10 && PROBE_SEL < 14) { total = __hip_atomic_load(&tsb[(64 + PROBE_SEL - 10 + 1) * 256 + 0], RLX_AGENT) - __hip_atomic_load(&tsb[(64 + PROBE_SEL - 10) * 256 + 0], RLX_AGENT); }
            const unsigned long long t0 = __builtin_amdgcn_s_memrealtime();
            while (__builtin_amdgcn_s_memrealtime() - t0 < total * PROBE_MULT) __builtin_amdgcn_s_sleep(8);
        }
    }
#endif
#undef IN
#undef SEAM
}

extern "C" void kernel_launch(void* const* d_in, const int* in_sizes, int n_in, void* d_out, int out_size, void* d_ws, size_t ws_size, hipStream_t stream) {
    static int grid = 0;
    if (grid == 0) {
        if (n_in != N_IN || in_sizes[0] != M * D || out_size != M * D || ws_size < WS_END) { fprintf(stderr, "kernel_launch: unexpected shapes (n_in %d, in0 %d, out %d, ws %zu); nothing launched\n", n_in, n_in > 0 ? in_sizes[0] : -1, out_size, ws_size); grid = -1; return; }
        int dev = 0, cus = 0, per_cu = 0;
        if (hipGetDevice(&dev) != hipSuccess || hipDeviceGetAttribute(&cus, hipDeviceAttributeMultiprocessorCount, dev) != hipSuccess) { grid = -1; return; }
        if (hipFuncSetAttribute((const void*)mk_fwd, hipFuncAttributeMaxDynamicSharedMemorySize, LDS_BYTES) != hipSuccess) { fprintf(stderr, "kernel_launch: hipFuncSetAttribute failed\n"); grid = -1; return; }
        if (hipOccupancyMaxActiveBlocksPerMultiprocessor(&per_cu, (const void*)mk_fwd, NWAVES * 64, LDS_BYTES) != hipSuccess || per_cu < 1) fprintf(stderr, "kernel_launch: occupancy query reports %d\n", per_cu);
        (void)hipGetLastError();
        grid = cus;
    }
    if (grid < 0) return;
    if (hipMemsetAsync((char*)d_ws + WS_CTL, 0, CTL_ZERO_BYTES, stream) != hipSuccess) return;
    Args a{};
    for (int i = 0; i < N_IN; ++i) a.in[i] = (const float*)d_in[i];
    a.out = (float*)d_out; a.ws = (unsigned char*)d_ws;
    if (N_LAUNCHES == 1) {
        a.ph_lo = 0; a.ph_hi = N_SLOTS;
        hipLaunchKernelGGL(mk_fwd, dim3(grid), dim3(NWAVES * 64), LDS_BYTES, stream, a);
    } else {
        for (int p = 0; p < N_SLOTS; ++p) { if (!slot_used(p)) continue; a.ph_lo = p; a.ph_hi = p + 1;
            hipLaunchKernelGGL(mk_fwd, dim3(grid), dim3(NWAVES * 64), LDS_BYTES, stream, a); }
    }
}
```

```cpp
#include <hip/hip_runtime.h>
#include <cstdio>
#include <cstdint>
#ifndef MK_N_LAUNCHES
#define MK_N_LAUNCHES 1
#endif
#ifndef PROBE_SEL
#define PROBE_SEL 0
#endif
#ifndef PROBE_MULT
#define PROBE_MULT 1
#endif
#ifndef PROBE_A
#define PROBE_A 0
#define PROBE_B 0
#define PROBE_WG 0
#endif
namespace pg8 {
#define PG8_LAS __attribute__((address_space(3)))
typedef unsigned short bf16_t;
typedef short bf16x8 __attribute__((ext_vector_type(8)));
typedef float f32x4 __attribute__((ext_vector_type(4)));
typedef unsigned u32x4 __attribute__((ext_vector_type(4)));
constexpr int BM = 256, BK = 64, HALF = 128, HTB = HALF * BK * 2  , STAGE_BYTES = 8 * HTB, NXCD = 8, WGM = 8;

__host__ __device__ __forceinline__ int lds_byte(int r, int c) { const int st = (r >> 4) * 2 + (c >> 5), rr = r & 15, cc = c & 31, ob = rr * 64 + cc * 2; return st * 1024 + (ob ^ (((ob >> 9) & 1) << 5)); }
__host__ __device__ __forceinline__ void stage_rc(int b, int& R, int& C) { const int st = b / 1024, sb = b % 1024, swz = sb ^ (((sb >> 9) & 1) << 5); R = (st >> 1) * 16 + swz / 64; C = (st & 1) * 32 + (swz % 64) / 2; }
__host__ __device__ __forceinline__ int perm32(int rho) { const int n = rho >> 4, i = rho & 15; return 8 * (i >> 2) + 4 * n + (i & 3); }

struct Unit { int pm, pn; };
struct Gemm { const bf16_t* A; const bf16_t* Bt; int M, N, K; };

struct StaticOrder {
    int nM, nN, nwg, G, c;
    __host__ __device__ void init(int M, int N, int G_, int c_) { nM = M / BM; nN = N / BM; nwg = nM * nN; G = G_; c = c_; }
    __host__ __device__ bool next(int i, Unit& u) const {
        const long L = (long)i * G + c; if (L >= nwg) return false;
        int wgid = (int)L; { const int q = nwg / NXCD, r = nwg % NXCD, xcd = wgid % NXCD, off = wgid / NXCD; wgid = (xcd < r ? xcd * (q + 1) : r * (q + 1) + (xcd - r) * q) + off; }
        const int nig = WGM * nN, gid = wgid / nig, fm = gid * WGM, gsz = (nM - fm) < WGM ? (nM - fm) : WGM;
        u.pm = fm + ((wgid % nig) % gsz); u.pn = (wgid % nig) / gsz; return true;
    }
    __device__ __forceinline__ void a_ready(const Unit&) const {}
    __device__ __forceinline__ void done(const Unit&) const {}
};

typedef float f32x2 __attribute__((ext_vector_type(2)));
typedef __bf16 nbf2p_t __attribute__((ext_vector_type(2)));
__device__ __forceinline__ unsigned cvt_pk_bf16(float lo, float hi) { const f32x2 f = {lo, hi}; const nbf2p_t b = __builtin_convertvector(f, nbf2p_t); return __builtin_bit_cast(unsigned, b); }
__device__ __forceinline__ f32x2 gelu_pk(f32x2 v) {
    const f32x2 av = __builtin_elementwise_abs(v), d = av * 0.2316418882f + 1.0f;
    f32x2 t; t.x = __builtin_amdgcn_rcpf(d.x); t.y = __builtin_amdgcn_rcpf(d.y);
    f32x2 q = t * 0.5307027145f + (-0.7265760135f); q = q * t + 0.7107068705f; q = q * t + (-0.142248368f); q = q * t + 0.127414796f; q = q * t;
    const f32x2 s = (v * v) * (-0.72134752044f);
    f32x2 e; e.x = __builtin_amdgcn_exp2f(s.x); e.y = __builtin_amdgcn_exp2f(s.y);
    const f32x2 m = v * (q * e), r = v - m;
    f32x2 o; o.x = v.x < 0.f ? m.x : r.x; o.y = v.y < 0.f ? m.y : r.y; return o;
}

template <int ACT  > struct EpiBf16 {
    static constexpr bool PERM = true, AFTER_DRAIN = false; static_assert(ACT == 0 || ACT == 1, "EpiBf16: ACT is 0 (none) or 1 (gelu_pk)");
    bf16_t* O; int ldc; const float* bias; int split_cols; size_t split_stride; float scale0;
    __device__ __forceinline__ void operator()(const f32x4 (&acc)[2][2][4][2], const Unit& u, int wr, int wc, int fr, int fq) const {
        const int row0 = u.pm * BM + wr * 64 + fr; int colt = u.pn * BM; bf16_t* base = O;
        float sc = 1.f; if (split_cols) { const int t = colt / split_cols; base += (size_t)t * split_stride; colt -= t * split_cols; if (t == 0) sc = scale0; }
        const int col0 = colt + wc * 32 + 8 * fq, bcol0 = u.pn * BM + wc * 32 + 8 * fq;
        f32x4 bv[2][2];
#pragma unroll
        for (int bj = 0; bj < 2; ++bj)
#pragma unroll
            for (int n = 0; n < 2; ++n) bv[bj][n] = bias ? *(const f32x4*)(bias + bcol0 + bj * HALF + 4 * n) : (f32x4){0.f, 0.f, 0.f, 0.f};
#pragma unroll
        for (int ai = 0; ai < 2; ++ai)
#pragma unroll
            for (int m = 0; m < 4; ++m) { bf16_t* rowp = base + (size_t)(row0 + ai * HALF + m * 16) * ldc + col0;
#pragma unroll
                for (int bj = 0; bj < 2; ++bj) { f32x4 v0 = acc[ai][bj][m][0] + bv[bj][0], v1 = acc[ai][bj][m][1] + bv[bj][1];
                    if (ACT == 1) { f32x2 a = gelu_pk((f32x2){v0[0], v0[1]}), b = gelu_pk((f32x2){v0[2], v0[3]}), c = gelu_pk((f32x2){v1[0], v1[1]}), d = gelu_pk((f32x2){v1[2], v1[3]});
                        v0 = (f32x4){a.x, a.y, b.x, b.y}; v1 = (f32x4){c.x, c.y, d.x, d.y}; }
                    v0 = v0 * sc; v1 = v1 * sc; u32x4 w; w.x = cvt_pk_bf16(v0[0], v0[1]); w.y = cvt_pk_bf16(v0[2], v0[3]); w.z = cvt_pk_bf16(v1[0], v1[1]); w.w = cvt_pk_bf16(v1[2], v1[3]);
                    *(u32x4*)(rowp + bj * HALF) = w; } }
    }
};

struct EpiSwiglu {
    static constexpr bool PERM = true, AFTER_DRAIN = false;
    bf16_t* O; int ldc;
    __device__ __forceinline__ void operator()(const f32x4 (&acc)[2][2][4][2], const Unit& u, int wr, int wc, int fr, int fq) const {
        const int row0 = u.pm * BM + wr * 64 + fr; const int col0 = u.pn * 128 + wc * 32 + 8 * fq;
#pragma unroll
        for (int ai = 0; ai < 2; ++ai)
#pragma unroll
            for (int m = 0; m < 4; ++m) { bf16_t* rowp = O + (size_t)(row0 + ai * HALF + m * 16) * ldc + col0;
                float h[8];
#pragma unroll
                for (int n = 0; n < 2; ++n)
#pragma unroll
                    for (int i = 0; i < 4; ++i) { const float g = acc[ai][0][m][n][i], up = acc[ai][1][m][n][i];
                        h[n * 4 + i] = g * __builtin_amdgcn_rcpf(1.0f + __expf(-g)) * up; }
                u32x4 w; w.x = cvt_pk_bf16(h[0], h[1]); w.y = cvt_pk_bf16(h[2], h[3]); w.z = cvt_pk_bf16(h[4], h[5]); w.w = cvt_pk_bf16(h[6], h[7]);
                *(u32x4*)rowp = w; }
    }
};
struct EpiProj {
    static constexpr bool PERM = true, AFTER_DRAIN = false;
    bf16_t* P; float* SM; const float* ct; const float* st;
    __device__ __forceinline__ void operator()(const f32x4 (&acc)[2][2][4][2], const Unit& u, int wr, int wc, int fr, int fq) const {
        const int row0 = u.pm * BM + wr * 64 + fr;
        if (u.pn == 4 || u.pn == 5) {
            const int col0 = u.pn * BM + wc * 32 + 8 * fq, fb = 8 * (fq & 1);
            const float sc = (u.pn == 4) ? 0.17677669529663687f * 1.4426950408889634f : 1.0f, sg = (fq < 2) ? -1.0f : 1.0f;
#pragma unroll
            for (int ai = 0; ai < 2; ++ai)
#pragma unroll
                for (int m = 0; m < 4; ++m) { const int row = row0 + ai * HALF + m * 16, pos = row & 4095;
                    bf16_t* rowp = P + (size_t)row * 3840 + col0;
                    const f32x4 c0 = *(const f32x4*)(ct + pos * 16 + fb), c1 = *(const f32x4*)(ct + pos * 16 + fb + 4), s0 = *(const f32x4*)(st + pos * 16 + fb) * sg, s1 = *(const f32x4*)(st + pos * 16 + fb + 4) * sg;
#pragma unroll
                    for (int bj = 0; bj < 2; ++bj) { const f32x4 v0 = acc[ai][bj][m][0], v1 = acc[ai][bj][m][1];
                        f32x4 p0, p1;
#pragma unroll
                        for (int i = 0; i < 4; ++i) { p0[i] = __shfl_xor(v0[i], 32); p1[i] = __shfl_xor(v1[i], 32); }
                        const f32x4 o0 = (v0 * c0 + p0 * s0) * sc, o1 = (v1 * c1 + p1 * s1) * sc;
                        u32x4 w; w.x = cvt_pk_bf16(o0[0], o0[1]); w.y = cvt_pk_bf16(o0[2], o0[3]); w.z = cvt_pk_bf16(o1[0], o1[1]); w.w = cvt_pk_bf16(o1[2], o1[3]);
                        *(u32x4*)(rowp + bj * HALF) = w; } }
        } else if (u.pn < 15) {
            const int col0 = u.pn * BM + wc * 32 + 8 * fq;
#pragma unroll
            for (int ai = 0; ai < 2; ++ai)
#pragma unroll
                for (int m = 0; m < 4; ++m) { bf16_t* rowp = P + (size_t)(row0 + ai * HALF + m * 16) * 3840 + col0;
#pragma unroll
                    for (int bj = 0; bj < 2; ++bj) { const f32x4 v0 = acc[ai][bj][m][0], v1 = acc[ai][bj][m][1];
                        u32x4 w; w.x = cvt_pk_bf16(v0[0], v0[1]); w.y = cvt_pk_bf16(v0[2], v0[3]); w.z = cvt_pk_bf16(v1[0], v1[1]); w.w = cvt_pk_bf16(v1[2], v1[3]);
                        *(u32x4*)(rowp + bj * HALF) = w; } }
        } else if (wc == 0) {
#pragma unroll
            for (int ai = 0; ai < 2; ++ai)
#pragma unroll
                for (int m = 0; m < 4; ++m) { float* rowp = SM + (size_t)(row0 + ai * HALF + m * 16) * 32 + 8 * fq;
                    *(f32x4*)rowp = acc[ai][0][m][0]; *(f32x4*)(rowp + 4) = acc[ai][0][m][1]; }
        }
    }
};
template <class Epi, class Sched, bool ALIGN_EPI = false, bool SP2 = false>
__device__ __forceinline__ void gemm_phase(PG8_LAS unsigned char* lds, const Gemm g, const Sched& S, const Epi& E) {
    const int tid = threadIdx.x, wid = __builtin_amdgcn_readfirstlane(tid >> 6), lane = tid & 63, wr = wid >> 2, wc = wid & 3, fr = lane & 15, fq = lane >> 4;
    const int K = g.K, nt = K / BK;
    unsigned voffA[2], voffB[2];
#pragma unroll
    for (int i = 0; i < 2; ++i) { int R, C; stage_rc(tid * 16 + i * 8192, R, C); const int Rb = Epi::PERM ? ((R & ~31) + perm32(R & 31)) : R;
        voffA[i] = (unsigned)(R * K + C) * 2u; voffB[i] = (unsigned)(Rb * K + C) * 2u; }
    const size_t kstep = (size_t)(BK * 2);
    const size_t hstep = (size_t)HALF * K * 2;
    const size_t tstep = 2 * hstep;
    const unsigned ldsw = (unsigned)wid * 1024u;
    const int aoff = lds_byte(wr * 64 + fr, fq * 8), boff = lds_byte(wc * 32 + fr, fq * 8);
#define PG8_SA(b, h) (((b) * 2 + (h)) * HTB)
#define PG8_SB(b, h) ((4 + (b) * 2 + (h)) * HTB)
#define PG8_STAGE(bufoff, gbase, voff) do { _Pragma("unroll") for (int _i = 0; _i < 2; ++_i) \
        __builtin_amdgcn_global_load_lds((const unsigned*)((const char*)(gbase) + (voff)[_i]), (PG8_LAS unsigned*)(lds + (bufoff) + ldsw + _i * 8192), 16, 0, 0); } while (0)
#define PG8_LDA(dst, b, h) do { _Pragma("unroll") for (int m = 0; m < 4; ++m) _Pragma("unroll") for (int k = 0; k < 2; ++k) dst[m][k] = *(const PG8_LAS bf16x8*)(lds + PG8_SA(b, h) + aoff + m * 2048 + k * 1024); } while (0)
#define PG8_LDB(dst, b, h) do { _Pragma("unroll") for (int n = 0; n < 2; ++n) _Pragma("unroll") for (int k = 0; k < 2; ++k) dst[n][k] = *(const PG8_LAS bf16x8*)(lds + PG8_SB(b, h) + boff + n * 2048 + k * 1024); } while (0)
#define PG8_MMA(ai, bj, At, Bt) do { __builtin_amdgcn_s_setprio(1); _Pragma("unroll") for (int m = 0; m < 4; ++m) _Pragma("unroll") for (int n = 0; n < 2; ++n) _Pragma("unroll") for (int k = 0; k < 2; ++k) \
        acc[ai][bj][m][n] = __builtin_amdgcn_mfma_f32_16x16x32_bf16(Bt[n][k], At[m][k], acc[ai][bj][m][n], 0, 0, 0); __builtin_amdgcn_s_setprio(0); } while (0)
#define PG8_WAIT_V(n) asm volatile("s_waitcnt vmcnt(" #n ")" ::: "memory")
#define PG8_WAIT_L(n) asm volatile("s_waitcnt lgkmcnt(" #n ")" ::: "memory")
#define PG8_BAR __builtin_amdgcn_s_barrier()
#define PG8_SCHED __builtin_amdgcn_sched_barrier(0)
    Unit cur, nxt; int ui = 0;
    if (!S.next(0, cur)) return;
    f32x4 acc[2][2][4][2];
#pragma unroll
    for (int a = 0; a < 2; ++a)
#pragma unroll
        for (int b = 0; b < 2; ++b)
#pragma unroll
            for (int m = 0; m < 4; ++m)
#pragma unroll
                for (int n = 0; n < 2; ++n) acc[a][b][m][n] = (f32x4){0.f, 0.f, 0.f, 0.f};
    bf16x8 At[4][2], B0[2][2], B1[2][2];
    const char* cA = (const char*)g.A + (size_t)cur.pm * tstep; const char* cB = (const char*)g.Bt + (size_t)cur.pn * tstep;
    S.a_ready(cur);
    if constexpr (SP2) {
        PG8_STAGE(PG8_SB(0, 0), cB, voffB); PG8_STAGE(PG8_SB(0, 1), cB + hstep, voffB); PG8_STAGE(PG8_SA(0, 0), cA, voffA); PG8_STAGE(PG8_SA(0, 1), cA + hstep, voffA);
        if (wr == 1) PG8_BAR;
        PG8_WAIT_V(2); PG8_BAR;
        PG8_STAGE(PG8_SB(1, 0), cB + kstep, voffB); PG8_STAGE(PG8_SA(1, 0), cA + kstep, voffA); PG8_STAGE(PG8_SB(1, 1), cB + hstep + kstep, voffB);
        PG8_WAIT_V(6); PG8_BAR;
    } else {
        PG8_STAGE(PG8_SB(0, 0), cB, voffB); PG8_STAGE(PG8_SA(0, 0), cA, voffA); PG8_STAGE(PG8_SB(0, 1), cB + hstep, voffB); PG8_STAGE(PG8_SA(0, 1), cA + hstep, voffA);
        if (wr == 1) PG8_BAR;
        PG8_WAIT_V(4); PG8_BAR;
        PG8_STAGE(PG8_SB(1, 0), cB + kstep, voffB); PG8_STAGE(PG8_SA(1, 0), cA + kstep, voffA); PG8_STAGE(PG8_SB(1, 1), cB + hstep + kstep, voffB);
        PG8_WAIT_V(6); PG8_BAR;
    }
    for (;;) {
        const bool has_next = S.next(ui + 1, nxt);
        const char* nA = has_next ? (const char*)g.A + (size_t)nxt.pm * tstep : cA; const char* nB = has_next ? (const char*)g.Bt + (size_t)nxt.pn * tstep : cB;
        for (int t = 0; t < nt; t += 2) {
            const bool last = (t == nt - 2);
            const char* a1 = cA + (size_t)(t + 1) * kstep;
            const char* a2 = last ? nA : cA + (size_t)(t + 2) * kstep; const char* b2 = last ? nB : cB + (size_t)(t + 2) * kstep;
            const char* a3 = a2 + kstep; const char* b3 = b2 + kstep;
            if (last && has_next) S.a_ready(nxt);
            if constexpr (SP2) {
            PG8_LDB(B0, 0, 0); PG8_LDB(B1, 0, 1); PG8_SCHED; PG8_LDA(At, 0, 0); PG8_STAGE(PG8_SA(1, 1), a1 + hstep, voffA);
            PG8_WAIT_V(8); PG8_WAIT_L(0); PG8_BAR; PG8_MMA(0, 0, At, B0); PG8_MMA(0, 1, At, B1); PG8_BAR; PG8_SCHED;
            PG8_LDA(At, 0, 1); PG8_STAGE(PG8_SB(0, 0), b2, voffB); PG8_STAGE(PG8_SB(0, 1), b2 + hstep, voffB); PG8_STAGE(PG8_SA(0, 0), a2, voffA);
            PG8_WAIT_V(8); PG8_WAIT_L(0); PG8_BAR; PG8_MMA(1, 0, At, B0); PG8_MMA(1, 1, At, B1); PG8_BAR; PG8_SCHED;
            PG8_LDB(B0, 1, 0); PG8_LDB(B1, 1, 1); PG8_SCHED; PG8_LDA(At, 1, 0); PG8_STAGE(PG8_SA(0, 1), a2 + hstep, voffA);
            PG8_WAIT_V(8); PG8_WAIT_L(0); PG8_BAR; PG8_MMA(0, 0, At, B0); PG8_MMA(0, 1, At, B1); PG8_BAR; PG8_SCHED;
            PG8_LDA(At, 1, 1); PG8_STAGE(PG8_SB(1, 0), b3, voffB); PG8_STAGE(PG8_SB(1, 1), b3 + hstep, voffB); PG8_STAGE(PG8_SA(1, 0), a3, voffA);
            PG8_WAIT_V(8); PG8_WAIT_L(0); PG8_BAR; PG8_MMA(1, 0, At, B0); PG8_MMA(1, 1, At, B1); PG8_BAR; PG8_SCHED;
            } else {
            PG8_LDB(B0, 0, 0); PG8_SCHED; PG8_LDA(At, 0, 0); PG8_STAGE(PG8_SA(1, 1), a1 + hstep, voffA);
            PG8_WAIT_L(8); PG8_BAR; PG8_WAIT_L(0); PG8_MMA(0, 0, At, B0); PG8_BAR; PG8_SCHED;
            PG8_LDB(B1, 0, 1); PG8_STAGE(PG8_SB(0, 0), b2, voffB);
            PG8_BAR; PG8_WAIT_L(0); PG8_MMA(0, 1, At, B1); PG8_BAR;
            PG8_LDA(At, 0, 1); PG8_STAGE(PG8_SA(0, 0), a2, voffA);
            PG8_BAR; PG8_WAIT_L(0); PG8_MMA(1, 0, At, B0); PG8_BAR; PG8_SCHED;
            PG8_STAGE(PG8_SB(0, 1), b2 + hstep, voffB);
            PG8_WAIT_V(6); PG8_BAR; PG8_MMA(1, 1, At, B1); PG8_BAR;
            PG8_LDB(B0, 1, 0); PG8_SCHED; PG8_LDA(At, 1, 0); PG8_STAGE(PG8_SA(0, 1), a2 + hstep, voffA);
            PG8_WAIT_L(8); PG8_BAR; PG8_WAIT_L(0); PG8_MMA(0, 0, At, B0); PG8_BAR; PG8_SCHED;
            PG8_LDB(B1, 1, 1); PG8_STAGE(PG8_SB(1, 0), b3, voffB);
            PG8_BAR; PG8_WAIT_L(0); PG8_MMA(0, 1, At, B1); PG8_BAR;
            PG8_LDA(At, 1, 1); PG8_STAGE(PG8_SA(1, 0), a3, voffA);
            PG8_BAR; PG8_WAIT_L(0); PG8_MMA(1, 0, At, B0); PG8_BAR; PG8_SCHED;
            PG8_STAGE(PG8_SB(1, 1), b3 + hstep, voffB);
            PG8_WAIT_V(6); PG8_BAR; PG8_MMA(1, 1, At, B1); PG8_BAR;
            }
        }
        if constexpr (ALIGN_EPI) { if (wr == 0) PG8_BAR; }
        if constexpr (!Epi::AFTER_DRAIN) { E(acc, cur, wr, wc, fr, fq); S.done(cur); }
        if (!has_next) break;
#pragma unroll
        for (int a = 0; a < 2; ++a)
#pragma unroll
            for (int b = 0; b < 2; ++b)
#pragma unroll
                for (int m = 0; m < 4; ++m)
#pragma unroll
                    for (int n = 0; n < 2; ++n) acc[a][b][m][n] = (f32x4){0.f, 0.f, 0.f, 0.f};
        cur = nxt; cA = nA; cB = nB; ++ui;
        if constexpr (ALIGN_EPI) { if (wr == 1) PG8_BAR; }
    }
    PG8_WAIT_V(0);
    if constexpr (!ALIGN_EPI) { if (wr == 0) PG8_BAR; }
    PG8_BAR;
    if constexpr (Epi::AFTER_DRAIN) { E.fused(acc, cur, wr, wc, fr, fq, lds, wid, lane); S.done(cur); }
#undef PG8_SA
#undef PG8_SB
#undef PG8_STAGE
#undef PG8_LDA
#undef PG8_LDB
#undef PG8_MMA
#undef PG8_WAIT_V
#undef PG8_WAIT_L
#undef PG8_BAR
#undef PG8_SCHED
}
}
#ifndef PG8_SP2
#define PG8_SP2 true
#endif
#ifndef PG8_ALIGN
#define PG8_ALIGN true
#endif
constexpr int N_LAUNCHES = MK_N_LAUNCHES;
constexpr int NWAVES = 8;
constexpr int BATCH = 8, SEQ = 4096, D = 1024, FF = 2816, NLAYER = 2;
constexpr int M = BATCH * SEQ;
constexpr int INC = 3860;
constexpr int PP = 3840;
constexpr int A_Q = 0, A_K = 256, A_V = 512, A_G = 768, B_Q = 1024, B_K = 1280, B_V = 1536, C_Z = 1792, C_XBC = 2048, D_Q = 2816, D_K = 3072, D_V = 3328, D_O = 3584;
constexpr int SM_BETA = 0, SM_A = 4, SM_DT = 8, SM_I = 12, SM_F = 16;
constexpr float EPS = 1e-6f;
enum { I_X = 0, I_F1PRE, I_F1G, I_F1U, I_F1D, I_F1POST, I_MIXPRE, I_WIN, I_GCONV, I_GALOG, I_GDTB, I_GNORM, I_LQ1, I_LK1, I_LQ2, I_LK2, I_DNORM,
       I_SCONVW, I_SCONVB, I_SALOG, I_SDTB, I_SD, I_SNORM, I_MIB, I_MFB, I_MNORM, I_WOUT, I_MIXPOST, I_F2PRE, I_F2G, I_F2U, I_F2D, I_F2POST, N_IN };
constexpr size_t MiB = 1u << 20;
constexpr size_t WS_CTL = 0, CTL_ZERO_BYTES = 1 * MiB;
constexpr size_t WS_ROPE = 1 * MiB;
constexpr size_t WS_W = 2 * MiB;
constexpr size_t W_GU = (size_t)2 * FF * D * 2, W_DN = (size_t)D * FF * 2, W_IN = (size_t)4096 * D * 2, W_OUT = (size_t)D * D * 2;
constexpr size_t WL_GU1 = 0, WL_D1 = WL_GU1 + W_GU, WL_IN = WL_D1 + W_DN, WL_OUT = WL_IN + W_IN, WL_GU2 = WL_OUT + W_OUT, WL_D2 = WL_GU2 + W_GU, W_LAYER = WL_D2 + W_DN;
static_assert(W_LAYER == 43 * MiB, "weights per layer");
constexpr size_t WS_XN = 88 * MiB;
constexpr size_t WS_Y = 152 * MiB;
constexpr size_t WS_P = 216 * MiB;
constexpr size_t WS_SM = 456 * MiB;
constexpr size_t WS_END = 512 * MiB;
static_assert(WS_W + 2 * W_LAYER <= WS_XN && WS_P + (size_t)M * PP * 2 <= WS_SM, "d_ws map");
constexpr int CW_TMO = 0, CW_CODE = 1, CW_BAR = 4096;
constexpr int CW_SEAM = 16384, SEAM_BANK = 128 * 64;
constexpr int RING_OFF = 0, RING_BYTES = 131072;
constexpr int LDSCTL_OFF = 158720, MISC_OFF = LDSCTL_OFF + 320;
constexpr int LDS_BYTES = 163840;
#define GAS __attribute__((address_space(1)))
#define LAS __attribute__((address_space(3)))
typedef unsigned short bf16;
typedef unsigned v4u __attribute__((ext_vector_type(4)));
typedef unsigned v2u __attribute__((ext_vector_type(2)));
typedef float f32x4 __attribute__((ext_vector_type(4)));
typedef float f32x16 __attribute__((ext_vector_type(16)));
typedef short bf16x8 __attribute__((ext_vector_type(8)));
typedef short s16x4 __attribute__((ext_vector_type(4)));
typedef GAS unsigned gu32;
#define RLX_AGENT __ATOMIC_RELAXED, __HIP_MEMORY_SCOPE_AGENT
#define LDS_WAIT() asm volatile("s_waitcnt lgkmcnt(0)" ::: "memory")
#define VM_WAIT() asm volatile("s_waitcnt vmcnt(0)" ::: "memory")
typedef __bf16 nbf2_t __attribute__((ext_vector_type(2)));
typedef float nf2_t __attribute__((ext_vector_type(2)));
__device__ __forceinline__ unsigned pk2(float lo, float hi) { const nf2_t f = {lo, hi}; const nbf2_t b = __builtin_convertvector(f, nbf2_t); return __builtin_bit_cast(unsigned, b); }
__device__ __forceinline__ unsigned f2bf(float f) { return (unsigned)__builtin_bit_cast(unsigned short, (__bf16)f); }
__device__ __forceinline__ float bf2f(unsigned v) { return __builtin_bit_cast(float, v << 16); }
__device__ __forceinline__ float silu_f(float x) { return x * __builtin_amdgcn_rcpf(1.0f + __expf(-x)); }
__device__ __forceinline__ float sigmoid_f(float x) { return __builtin_amdgcn_rcpf(1.0f + __expf(-x)); }
__device__ __forceinline__ float rsqrt_f(float x) { return __builtin_amdgcn_rsqf(x); }
__device__ __forceinline__ float softplus_f(float x) { return x > 20.f ? x : log1pf(__expf(x)); }
__device__ __forceinline__ float wave_sum(float v) {
#pragma unroll
    for (int o = 1; o < 64; o <<= 1) v += __shfl_xor(v, o);
    return v;
}
#define XB_TMO      128
#define XB_XCNT(j)  (256  + 64 * (j))
#define XB_XSUB(j)  (1280 + 64 * (j))
#define XB_XGEN(j)  (2304 + 64 * (j))
#define XB_TOP      3328
#define XB_TOPGEN   3392
#define XCD_BAR_WORDS 3456
#define XB_SPIN_CAP (1u << 18)

__device__ __forceinline__ unsigned xb_ld(unsigned* p)              { return __hip_atomic_load(p, __ATOMIC_RELAXED, __HIP_MEMORY_SCOPE_AGENT); }
__device__ __forceinline__ unsigned xb_add(unsigned* p, unsigned v) { return __hip_atomic_fetch_add(p, v, __ATOMIC_RELAXED, __HIP_MEMORY_SCOPE_AGENT); }
__device__ __forceinline__ unsigned xb_xcc_id() { return (unsigned)__builtin_amdgcn_s_getreg((3 << 11) | 20) & 0xFu; }
#define XB_SPIN(cond, bar) do { unsigned _sp = 0; while (cond) { __builtin_amdgcn_s_sleep(1); \
    if ((++_sp & 255u) == 0u) { if (xb_ld(&(bar)[XB_TMO])) break; if (_sp > XB_SPIN_CAP) { atomicAdd(&(bar)[XB_TMO], 1u); break; } } } } while (0)

struct XcdBarrier {
    unsigned* bar; unsigned x;
    volatile LAS unsigned* st;
};

__device__ __forceinline__ XcdBarrier xcd_barrier_post(unsigned* bar, volatile LAS unsigned* st) {
    XcdBarrier b; b.bar = bar; b.x = xb_xcc_id(); b.st = st;
    if (threadIdx.x == 0) (void)xb_add(&bar[XB_XCNT(b.x)], 1u);
    return b;
}
__device__ __forceinline__ void xcd_barrier_complete(unsigned* bar, unsigned x, unsigned& nloc, unsigned& nx) {
    const unsigned G = gridDim.x * gridDim.y * gridDim.z;
    unsigned sum, cnt, mine, sp = 0u;
    for (;;) {
        sum = 0u; cnt = 0u; mine = 0u;
#pragma unroll
        for (unsigned j = 0; j < 16; ++j) { const unsigned c = xb_ld(&bar[XB_XCNT(j)]); sum += c; cnt += (c > 0u) ? 1u : 0u; mine = (j == x) ? c : mine; }
        if (sum == G) break;
        __builtin_amdgcn_s_sleep(1);
        if ((++sp & 255u) == 0u) { if (xb_ld(&bar[XB_TMO])) break; if (sp > XB_SPIN_CAP) { atomicAdd(&bar[XB_TMO], 1u); break; } }
    }
    nloc = mine > 0u ? mine : 1u; nx = cnt > 0u ? cnt : 1u;
}

__device__ __forceinline__ void xcd_barrier(const XcdBarrier& b) {
    asm volatile("s_waitcnt vmcnt(0)" ::: "memory");
    __syncthreads();
    if (threadIdx.x == 0) {
        unsigned* bar = b.bar;
        __builtin_amdgcn_s_waitcnt(0);
        unsigned nloc = b.st[0], nx = b.st[1];
        if (nloc == 0u) { xcd_barrier_complete(bar, b.x, nloc, nx); b.st[0] = nloc; b.st[1] = nx; }
        const unsigned old = xb_add(&bar[XB_XSUB(b.x)], 1u);
        const unsigned gen = old / nloc;
        if (old + 1u == (gen + 1u) * nloc) {
            __builtin_amdgcn_fence(__ATOMIC_RELEASE, "agent");
            asm volatile("s_waitcnt vmcnt(0)" ::: "memory");
            const unsigned og = xb_add(&bar[XB_TOP], 1u);
            const unsigned tg = og / nx;
            if (og + 1u == (tg + 1u) * nx) xb_add(&bar[XB_TOPGEN], 1u);
            else XB_SPIN(xb_ld(&bar[XB_TOPGEN]) == tg, bar);
            __builtin_amdgcn_fence(__ATOMIC_ACQUIRE, "agent");
            xb_add(&bar[XB_XGEN(b.x)], 1u);
            asm volatile("s_waitcnt vmcnt(0)" ::: "memory");
        } else {
            XB_SPIN(xb_ld(&bar[XB_XGEN(b.x)]) == gen, bar);
            __builtin_amdgcn_fence(__ATOMIC_ACQUIRE, "agent");
            asm volatile("s_waitcnt vmcnt(0)" ::: "memory");
        }
    }
    __syncthreads();
}
struct Frame {
    unsigned char* lds;
    volatile LAS unsigned* MISC;
    gu32* ctl;
    int tid, lane, wave;
    int vcu, G;
    const float* const* in;
    float* out; unsigned char* ws;
};
__device__ const double ROPE_INVF[16] = {1.0, 0.5623413251903491, 0.31622776601683794, 0.1778279410038923, 0.1, 0.05623413251903491, 0.03162277660168379, 0.01778279410038923,
    0.01, 0.005623413251903491, 0.0031622776601683794, 0.0017782794100389228, 0.001, 0.0005623413251903491, 0.00031622776601683794, 0.00017782794100389227};

template <int MODE> __device__ __forceinline__ int rowmap(int n) {
    if (MODE == 0) return n;
    if (MODE == 1) return (n >> 7) * 256 + (n & 127);
    if (MODE == 2) return (n >> 7) * 256 + 128 + (n & 127);
    if (n < 1024) return n;
    if (n < 1032) return 3840 + (n - 1024);
    if (n < 2824) return n - 8;
    if (n < 2828) return 3848 + (n - 2824);
    if (n < 3852) return n - 12;
    return n;
}
template <int MODE> __device__ __forceinline__ void p0_transpose_item(const float* W, int K, int N, bf16* WT, float* scr, int item, int lane) {
    const int nblk = (N + 31) / 32, kb = item / nblk, nb = item % nblk, k0 = 64 * kb, n0 = 32 * nb;
    const int nn = n0 + (lane & 31);
#pragma unroll 8
    for (int i = 0; i < 32; ++i) { const int kk = 2 * i + (lane >> 5); scr[kk * 33 + (lane & 31)] = nn < N ? W[(size_t)(k0 + kk) * N + nn] : 0.f; }
    LDS_WAIT(); asm volatile("" ::: "memory");
    const int c = lane & 7;
#pragma unroll
    for (int j = 0; j < 4; ++j) { const int n = (lane >> 3) + 8 * j; const float* s = scr + (8 * c) * 33 + n;
        v4u o; o.x = pk2(s[0 * 33], s[1 * 33]); o.y = pk2(s[2 * 33], s[3 * 33]); o.z = pk2(s[4 * 33], s[5 * 33]); o.w = pk2(s[6 * 33], s[7 * 33]);
        if (n0 + n < N) *(v4u*)(WT + (size_t)rowmap<MODE>(n0 + n) * K + k0 + 8 * c) = o; }
    LDS_WAIT(); asm volatile("" ::: "memory");
}
__device__ __forceinline__ void p0_prologue(Frame& F) {
    float* scr = (float*)(F.lds + RING_OFF + F.wave * 16384);
    const int gw = F.vcu * NWAVES + F.wave, NGW = F.G * NWAVES;
    constexpr int I_GATE = (D / 64) * (FF / 32), I_DOWN = (FF / 64) * (D / 32), I_IN = (D / 64) * ((INC + 31) / 32), I_OUT = (D / 64) * (D / 32);
    constexpr int PER_LAYER = 4 * I_GATE + 2 * I_DOWN + I_IN + I_OUT;
    for (int it = gw; it < NLAYER * PER_LAYER; it += NGW) {
        const int l = it / PER_LAYER; int r = it % PER_LAYER;
        unsigned char* wl = F.ws + WS_W + (size_t)l * W_LAYER;
        if (r < I_GATE) { p0_transpose_item<1>(F.in[I_F1G] + (size_t)l * D * FF, D, FF, (bf16*)(wl + WL_GU1), scr, r, F.lane); continue; } r -= I_GATE;
        if (r < I_GATE) { p0_transpose_item<2>(F.in[I_F1U] + (size_t)l * D * FF, D, FF, (bf16*)(wl + WL_GU1), scr, r, F.lane); continue; } r -= I_GATE;
        if (r < I_DOWN) { p0_transpose_item<0>(F.in[I_F1D] + (size_t)l * D * FF, FF, D, (bf16*)(wl + WL_D1), scr, r, F.lane); continue; } r -= I_DOWN;
        if (r < I_IN)   { p0_transpose_item<3>(F.in[I_WIN] + (size_t)l * D * INC, D, INC, (bf16*)(wl + WL_IN), scr, r, F.lane); continue; } r -= I_IN;
        if (r < I_OUT)  { p0_transpose_item<0>(F.in[I_WOUT] + (size_t)l * D * D, D, D, (bf16*)(wl + WL_OUT), scr, r, F.lane); continue; } r -= I_OUT;
        if (r < I_GATE) { p0_transpose_item<1>(F.in[I_F2G] + (size_t)l * D * FF, D, FF, (bf16*)(wl + WL_GU2), scr, r, F.lane); continue; } r -= I_GATE;
        if (r < I_GATE) { p0_transpose_item<2>(F.in[I_F2U] + (size_t)l * D * FF, D, FF, (bf16*)(wl + WL_GU2), scr, r, F.lane); continue; } r -= I_GATE;
        p0_transpose_item<0>(F.in[I_F2D] + (size_t)l * D * FF, FF, D, (bf16*)(wl + WL_D2), scr, r, F.lane);
    }
    const int gt = F.vcu * NWAVES * 64 + F.tid, NGT = F.G * NWAVES * 64;
    for (int i = gt; i < NLAYER * 236 * 128; i += NGT) { const int l = i / (236 * 128), r = i % (236 * 128);
        *(v4u*)(F.ws + WS_W + (size_t)l * W_LAYER + WL_IN + (size_t)INC * D * 2 + (size_t)r * 16) = (v4u){0u, 0u, 0u, 0u}; }
    float* ct = (float*)(F.ws + WS_ROPE); float* st = ct + SEQ * 16;
    for (int i = gt; i < SEQ * 16; i += NGT) { const int pos = i >> 4, f = i & 15;
        const double rev = (double)pos * ROPE_INVF[f] * 0.15915494309189535; const float fr = (float)(rev - __builtin_floor(rev));
        ct[i] = __builtin_amdgcn_cosf(fr); st[i] = __builtin_amdgcn_sinf(fr); }
}
__device__ __forceinline__ void post_rows(Frame& F, const float* xsrc, const bf16* Y, float coef, const float* g_post, float* xdst, const float* g_pre, bf16* XN, bool has_y, bool write_x, bool write_xn) {
    const int gw = F.vcu * NWAVES + F.wave, NGW = F.G * NWAVES;
    f32x4 gp[4], gn[4];
#pragma unroll
    for (int j = 0; j < 4; ++j) { gp[j] = has_y ? *(const f32x4*)(g_post + 4 * F.lane + 256 * j) : (f32x4){0.f, 0.f, 0.f, 0.f}; gn[j] = write_xn ? *(const f32x4*)(g_pre + 4 * F.lane + 256 * j) : (f32x4){0.f, 0.f, 0.f, 0.f}; }
    for (int m = gw; m < M; m += NGW) {
        f32x4 v[4];
#pragma unroll
        for (int j = 0; j < 4; ++j) v[j] = *(const f32x4*)(xsrc + (size_t)m * D + 4 * F.lane + 256 * j);
        if (has_y) {
            f32x4 y[4]; float s = 0.f;
#pragma unroll
            for (int j = 0; j < 4; ++j) { const v2u w = *(const v2u*)(Y + (size_t)m * D + 4 * F.lane + 256 * j);
                y[j] = (f32x4){bf2f(w.x & 0xffffu), bf2f(w.x >> 16), bf2f(w.y & 0xffffu), bf2f(w.y >> 16)};
                s += (y[j].x * y[j].x + y[j].y * y[j].y) + (y[j].z * y[j].z + y[j].w * y[j].w); }
            const float r = coef / sqrtf(wave_sum(s) * (1.f / D) + EPS);
#pragma unroll
            for (int j = 0; j < 4; ++j) v[j] = v[j] + y[j] * gp[j] * r;
        }
        if (write_x) {
#pragma unroll
            for (int j = 0; j < 4; ++j) *(f32x4*)(xdst + (size_t)m * D + 4 * F.lane + 256 * j) = v[j];
        }
        if (write_xn) {
            float s2 = 0.f;
#pragma unroll
            for (int j = 0; j < 4; ++j) s2 += (v[j].x * v[j].x + v[j].y * v[j].y) + (v[j].z * v[j].z + v[j].w * v[j].w);
            const float r2 = 1.f / sqrtf(wave_sum(s2) * (1.f / D) + EPS);
#pragma unroll
            for (int j = 0; j < 4; ++j) { const f32x4 o = v[j] * gn[j] * r2; v2u w; w.x = pk2(o.x, o.y); w.y = pk2(o.z, o.w);
                *(v2u*)(XN + (size_t)m * D + 4 * F.lane + 256 * j) = w; }
        }
    }
}
__device__ __forceinline__ void rope_phase(Frame& F, bf16* P) {
    const float* ct = (const float*)(F.ws + WS_ROPE); const float* st = ct + SEQ * 16;
    const int gt = F.vcu * NWAVES * 64 + F.tid, NGT = F.G * NWAVES * 64;
    for (int it = gt; it < M * 16; it += NGT) {
        const int row = it >> 4, hd = it & 15, pos = row & (SEQ - 1);
        bf16* p = P + (size_t)row * PP + B_Q + 32 * hd;
        const float sc = hd < 8 ? 0.17677669529663687f * 1.4426950408889634f : 1.0f;
        v4u a0 = *(v4u*)p, a1 = *(v4u*)(p + 8), b0 = *(v4u*)(p + 16), b1 = *(v4u*)(p + 24);
        unsigned t1[8] = {a0.x, a0.y, a0.z, a0.w, a1.x, a1.y, a1.z, a1.w}, t2[8] = {b0.x, b0.y, b0.z, b0.w, b1.x, b1.y, b1.z, b1.w};
        unsigned o1[8], o2[8];
#pragma unroll
        for (int i = 0; i < 8; ++i) {
            const float c0 = ct[pos * 16 + 2 * i], c1 = ct[pos * 16 + 2 * i + 1], s0 = st[pos * 16 + 2 * i], s1 = st[pos * 16 + 2 * i + 1];
            const float x0 = bf2f(t1[i] & 0xffffu), x1 = bf2f(t1[i] >> 16), y0 = bf2f(t2[i] & 0xffffu), y1 = bf2f(t2[i] >> 16);
            o1[i] = pk2((x0 * c0 - y0 * s0) * sc, (x1 * c1 - y1 * s1) * sc);
            o2[i] = pk2((y0 * c0 + x0 * s0) * sc, (y1 * c1 + x1 * s1) * sc);
        }
        *(v4u*)p = (v4u){o1[0], o1[1], o1[2], o1[3]}; *(v4u*)(p + 8) = (v4u){o1[4], o1[5], o1[6], o1[7]};
        *(v4u*)(p + 16) = (v4u){o2[0], o2[1], o2[2], o2[3]}; *(v4u*)(p + 24) = (v4u){o2[4], o2[5], o2[6], o2[7]};
    }
}
#define LBAR() do { asm volatile("s_waitcnt lgkmcnt(0)" ::: "memory"); __builtin_amdgcn_s_barrier(); asm volatile("" ::: "memory"); } while (0)
template <int NT, int KS> __device__ __forceinline__ void mma_nt(f32x4 (&acc)[NT], const unsigned char* X, int ldx, int x0, const unsigned char* Y, int ldy, int y0, int lane) {
    const int fr = lane & 15, fq = lane >> 4;
#pragma unroll
    for (int ks = 0; ks < KS; ++ks) {
        const bf16x8 a = *(const bf16x8*)(X + (x0 + fr) * ldx + (ks * 32 + 8 * fq) * 2);
#pragma unroll
        for (int t = 0; t < NT; ++t) { const bf16x8 b = *(const bf16x8*)(Y + (y0 + 16 * t + fr) * ldy + (ks * 32 + 8 * fq) * 2);
            acc[t] = __builtin_amdgcn_mfma_f32_16x16x32_bf16(a, b, acc[t], 0, 0, 0); }
    }
}
__device__ __forceinline__ v2u pk4(float a, float b, float c, float d) { v2u w; w.x = pk2(a, b); w.y = pk2(c, d); return w; }
__device__ __forceinline__ v4u pk8(const float (&v)[8]) { v4u w; w.x = pk2(v[0], v[1]); w.y = pk2(v[2], v[3]); w.z = pk2(v[4], v[5]); w.w = pk2(v[6], v[7]); return w; }
__device__ __forceinline__ void unpk8(const v4u w, float (&v)[8]) { v[0] = bf2f(w.x & 0xffffu); v[1] = bf2f(w.x >> 16); v[2] = bf2f(w.y & 0xffffu); v[3] = bf2f(w.y >> 16); v[4] = bf2f(w.z & 0xffffu); v[5] = bf2f(w.z >> 16); v[6] = bf2f(w.w & 0xffffu); v[7] = bf2f(w.w >> 16); }
__device__ __forceinline__ float wave_scan_add(float v, int lane) {
#pragma unroll
    for (int o = 1; o < 64; o <<= 1) { const float t = __shfl_up(v, o); if (lane >= o) v += t; }
    return v;
}
__device__ __forceinline__ float wave_scan_max(float v, int lane) {
#pragma unroll
    for (int o = 1; o < 64; o <<= 1) { const float t = __shfl_up(v, o); if (lane >= o) v = fmaxf(v, t); }
    return v;
}
__device__ __forceinline__ float wave_max(float v) {
#pragma unroll
    for (int o = 1; o < 64; o <<= 1) v = fmaxf(v, __shfl_xor(v, o));
    return v;
}
__device__ __forceinline__ void conv8(const bf16* src, int row, int pos, const float* w, int wstride, float (&out)[8]) {
    v4u raw[4];
#pragma unroll
    for (int j = 0; j < 4; ++j) { const int rr = (pos + j - 3 >= 0) ? row + j - 3 : row; raw[j] = *(const v4u*)(src + (size_t)rr * PP); }
#pragma unroll
    for (int i = 0; i < 8; ++i) out[i] = 0.f;
#pragma unroll
    for (int j = 0; j < 4; ++j) {
        const float msk = (pos + j - 3 >= 0) ? 1.f : 0.f;
        float r[8]; unpk8(raw[j], r);
        const f32x4 w0 = *(const f32x4*)(w + j * wstride) * msk, w1 = *(const f32x4*)(w + j * wstride + 4) * msk;
        out[0] += w0.x * r[0]; out[1] += w0.y * r[1]; out[2] += w0.z * r[2]; out[3] += w0.w * r[3];
        out[4] += w1.x * r[4]; out[5] += w1.y * r[5]; out[6] += w1.z * r[6]; out[7] += w1.w * r[7];
    }
}
__device__ __forceinline__ void conv8_load(const bf16* src, int row, int pos, v4u (&raw)[4]) {
#pragma unroll
    for (int j = 0; j < 4; ++j) { const int rr = (pos + j - 3 >= 0) ? row + j - 3 : row; raw[j] = *(const v4u*)(src + (size_t)rr * PP); }
}
__device__ __forceinline__ void conv8_fin(const v4u (&raw)[4], int pos, const float* w, int wstride, float (&out)[8]) {
#pragma unroll
    for (int i = 0; i < 8; ++i) out[i] = 0.f;
#pragma unroll
    for (int j = 0; j < 4; ++j) {
        const float msk = (pos + j - 3 >= 0) ? 1.f : 0.f;
        float r[8]; unpk8(raw[j], r);
        const f32x4 w0 = *(const f32x4*)(w + j * wstride) * msk, w1 = *(const f32x4*)(w + j * wstride + 4) * msk;
        out[0] += w0.x * r[0]; out[1] += w0.y * r[1]; out[2] += w0.z * r[2]; out[3] += w0.w * r[3];
        out[4] += w1.x * r[4]; out[5] += w1.y * r[5]; out[6] += w1.z * r[6]; out[7] += w1.w * r[7];
    }
}
constexpr int CW_GDN = 131072, CW_SSD = 131072 + 12288;
constexpr size_t WS_GT = WS_Y;
constexpr size_t WS_SST = 460 * MiB;
constexpr size_t WS_MKC = 492 * MiB;
constexpr size_t WS_SCAL = 508 * MiB;
constexpr size_t SC_GL = 0, SC_ACS = 8192, SC_BB = SC_ACS + 524288, SC_DM = SC_BB + 524288, SC_DEN = SC_DM + 524288, SC_NC = SC_DEN + 524288, SC_MU = SC_NC + 524288, SC_END = SC_MU + 16384;
static_assert(WS_SCAL + SC_END <= 511 * MiB, "scalars");
constexpr size_t WS_CSIDE = 511 * MiB;
constexpr int T72 = 144;
__device__ __forceinline__ void gdn_local_unit(Frame& F, int l, int u, unsigned char* lds) {
    const int tid = F.tid, lane = F.lane, w = F.wave, fr = lane & 15, fq = lane >> 4;
    const int b = u >> 8, h = (u >> 6) & 3, n = u & 63, row0 = b * SEQ + n * 64;
    const bf16* P = (const bf16*)(F.ws + WS_P); const float* SM = (const float*)(F.ws + WS_SM); bf16* MIX = (bf16*)(F.ws + WS_XN);
    bf16* GT = (bf16*)(F.ws + WS_GT) + (size_t)u * 4 * 4096;
    unsigned char* KN = lds; unsigned char* QN = lds + 9216; float* RHS = (float*)(lds + 18432); float* Lm = (float*)(lds + 51200); unsigned char* KDT = lds + 67584;
    unsigned char* LN = lds + 76800; unsigned char* XT = lds + 86016; unsigned char* DINV = lds + 104448; unsigned char* RT = lds + 109568 + w * 1280;
    float* sbeta = (float*)(lds + 119808); float* sgc = (float*)(lds + 120064);
    const float* cwl = (const float*)(lds + CW_GDN);
    if (w == 0) {
        const float* sm = SM + (size_t)(row0 + lane) * 32;
        const float Aneg = -expf(F.in[I_GALOG][l * 4 + h]), dtb = F.in[I_GDTB][l * 4 + h];
        const float g = Aneg * softplus_f(sm[SM_A + h] + dtb);
        const float gc = wave_scan_add(g, lane);
        sbeta[lane] = sigmoid_f(sm[SM_BETA + h]); sgc[lane] = gc;
        if (lane == 63) ((float*)(F.ws + WS_SCAL + SC_GL))[u] = expf(gc);
    }
    const int t = tid >> 3, cg = tid & 7, pos = n * 64 + t;
    float q8[8], k8[8], v8[8];
    {
        v4u rq[4], rk[4], rv[4];
        conv8_load(P + A_Q + 64 * h + 8 * cg, row0 + t, pos, rq); conv8_load(P + A_K + 64 * h + 8 * cg, row0 + t, pos, rk); conv8_load(P + A_V + 64 * h + 8 * cg, row0 + t, pos, rv);
        for (int i = tid; i < 4608; i += 512) ((unsigned*)XT)[i] = 0u;
        conv8_fin(rq, pos, cwl + 64 * h + 8 * cg, 768, q8); conv8_fin(rk, pos, cwl + 256 + 64 * h + 8 * cg, 768, k8); conv8_fin(rv, pos, cwl + 512 + 64 * h + 8 * cg, 768, v8);
    }
    float sq = 0.f, sk = 0.f;
#pragma unroll
    for (int i = 0; i < 8; ++i) { q8[i] = silu_f(q8[i]); k8[i] = silu_f(k8[i]); v8[i] = silu_f(v8[i]); sq += q8[i] * q8[i]; sk += k8[i] * k8[i]; }
    sq += __shfl_xor(sq, 1); sq += __shfl_xor(sq, 2); sq += __shfl_xor(sq, 4);
    sk += __shfl_xor(sk, 1); sk += __shfl_xor(sk, 2); sk += __shfl_xor(sk, 4);
    const float rq_ = 0.125f * rsqrt_f(sq + EPS), rk_ = rsqrt_f(sk + EPS);
#pragma unroll
    for (int i = 0; i < 8; ++i) { q8[i] *= rq_; k8[i] *= rk_; }
    LBAR();
    {
        const float be = sbeta[t], gct = sgc[t], eg = __expf(gct), egl = __expf(sgc[63] - gct);
        *(v4u*)(KN + t * T72 + cg * 16) = pk8(k8); *(v4u*)(QN + t * T72 + cg * 16) = pk8(q8);
        float tmp[8];
#pragma unroll
        for (int i = 0; i < 8; ++i) tmp[i] = q8[i] * eg;
        *(v4u*)(GT + 2 * 4096 + t * 64 + cg * 8) = pk8(tmp);
#pragma unroll
        for (int i = 0; i < 8; ++i) { RHS[t * 128 + 8 * cg + i] = v8[i] * be; RHS[t * 128 + 64 + 8 * cg + i] = k8[i] * be * eg;
            *(unsigned short*)(KDT + (8 * cg + i) * T72 + t * 2) = (unsigned short)f2bf(k8[i] * egl); }
    }
    LBAR();
    {
        const int m0 = 16 * (w & 3) + 4 * fq;
        f32x4 acc[4];
#pragma unroll
        for (int tt = 0; tt < 4; ++tt) acc[tt] = (f32x4){0.f, 0.f, 0.f, 0.f};
        mma_nt<4, 2>(acc, KN, T72, 16 * (w & 3), (w < 4) ? KN : QN, T72, 0, lane);
        const float gm0 = sgc[m0], gm1 = sgc[m0 + 1], gm2 = sgc[m0 + 2], gm3 = sgc[m0 + 3];
#pragma unroll
        for (int tt = 0; tt < 4; ++tt) { const int c = 16 * tt + fr; const float gcc = sgc[c];
            if (w < 4) { const float be = sbeta[c];
                f32x4 o; o.x = (m0 < c) ? be * acc[tt].x * __expf(gcc - gm0) : 0.f; o.y = (m0 + 1 < c) ? be * acc[tt].y * __expf(gcc - gm1) : 0.f;
                o.z = (m0 + 2 < c) ? be * acc[tt].z * __expf(gcc - gm2) : 0.f; o.w = (m0 + 3 < c) ? be * acc[tt].w * __expf(gcc - gm3) : 0.f;
                *(f32x4*)(Lm + c * 64 + m0) = o; *(v2u*)(LN + c * T72 + m0 * 2) = pk4(-o.x, -o.y, -o.z, -o.w);
            } else {
                const float a0 = (m0 <= c) ? acc[tt].x * __expf(gcc - gm0) : 0.f, a1 = (m0 + 1 <= c) ? acc[tt].y * __expf(gcc - gm1) : 0.f;
                const float a2 = (m0 + 2 <= c) ? acc[tt].z * __expf(gcc - gm2) : 0.f, a3 = (m0 + 3 <= c) ? acc[tt].w * __expf(gcc - gm3) : 0.f;
                *(v2u*)(GT + 1 * 4096 + c * 64 + m0) = pk4(a0, a1, a2, a3);
            } }
    }
    LBAR();
    if (w < 4) {
        if (lane < 16) {
            float x[16];
#pragma unroll
            for (int r = 0; r < 16; ++r) { float s = (r == lane) ? 1.f : 0.f;
#pragma unroll
                for (int m = 0; m < r; ++m) s -= Lm[(16 * w + r) * 64 + 16 * w + m] * x[m];
                x[r] = s; }
#pragma unroll
            for (int r = 0; r < 16; ++r) *(unsigned short*)(DINV + w * 1280 + r * 80 + lane * 2) = (unsigned short)f2bf(x[r]);
        } else if (lane < 32) {
#pragma unroll
            for (int r = 0; r < 16; ++r) *(unsigned short*)(DINV + w * 1280 + r * 80 + lane * 2) = 0;
        }
    } else {
        for (int i = tid - 256; i < 512; i += 256) { const int d = i >> 3, pc = i & 7; *(v4u*)(GT + 3 * 4096 + d * 64 + pc * 8) = *(const v4u*)(KDT + d * T72 + pc * 16); }
    }
    if (lane >= 16 && lane < 32) {
#pragma unroll
        for (int r = 0; r < 16; ++r) *(unsigned short*)(RT + r * 80 + lane * 2) = 0;
    }
    LBAR();
    {
#pragma unroll
        for (int bi = 0; bi < 4; ++bi) {
            f32x4 a[1];
#pragma unroll
            for (int j = 0; j < 4; ++j) a[0][j] = RHS[(16 * bi + 4 * fq + j) * 128 + 16 * w + fr];
            if (bi > 0) mma_nt<1, 2>(a, LN, T72, 16 * bi, XT, T72, 16 * w, lane);
            *(v2u*)(RT + fr * 80 + (4 * fq) * 2) = pk4(a[0].x, a[0].y, a[0].z, a[0].w);
            f32x4 x[1] = {(f32x4){0.f, 0.f, 0.f, 0.f}};
            mma_nt<1, 1>(x, DINV + bi * 1280, 80, 0, RT, 80, 0, lane);
            *(v2u*)(XT + (16 * w + fr) * T72 + (16 * bi + 4 * fq) * 2) = pk4(x[0].x, x[0].y, x[0].z, x[0].w);
        }
    }
    LBAR();
    {
        float u8[8], w8[8];
#pragma unroll
        for (int i = 0; i < 8; ++i) { u8[i] = bf2f(*(const unsigned short*)(XT + (8 * cg + i) * T72 + t * 2)); w8[i] = -bf2f(*(const unsigned short*)(XT + (64 + 8 * cg + i) * T72 + t * 2)); }
        *(v4u*)(MIX + (size_t)(row0 + t) * D + 64 * h + 8 * cg) = pk8(u8);
        *(v4u*)(GT + t * 64 + 8 * cg) = pk8(w8);
    }
    {
        bf16* gp = (bf16*)P + (size_t)(row0 + t) * PP + A_G + 64 * h + 8 * cg; float gv[8]; unpk8(*(const v4u*)gp, gv);
#pragma unroll
        for (int i = 0; i < 8; ++i) gv[i] = silu_f(gv[i]);
        *(v4u*)gp = pk8(gv);
    }
    LBAR();
}
__device__ __forceinline__ void gdn_chain(Frame& F, int l, int b, int h, unsigned char* lds) {
    const int tid = F.tid, lane = F.lane, w = F.wave, fr = lane & 15, fq = lane >> 4, wm = w >> 1, wn = w & 1;
    const bf16* P = (const bf16*)(F.ws + WS_P); bf16* MIX = (bf16*)(F.ws + WS_XN);
    const float* GL = (const float*)(F.ws + WS_SCAL + SC_GL);
    unsigned char* WN = lds; unsigned char* AT = lds + 9216; unsigned char* QD = lds + 18432; unsigned char* KDT = lds + 27648; unsigned char* UU = lds + 36864;
    unsigned char* ST0 = lds + 46080; unsigned char* VNT = lds + 64512; float* O = (float*)(lds + 73728);
    const int r = tid >> 3, pc = tid & 7;
    for (int i = tid; i < 9216 / 4; i += 512) ((unsigned*)ST0)[i] = 0u;
    f32x4 S[2] = {(f32x4){0.f, 0.f, 0.f, 0.f}, (f32x4){0.f, 0.f, 0.f, 0.f}};
    float ng[8];
#pragma unroll
    for (int i = 0; i < 8; ++i) ng[i] = F.in[I_GNORM][l * 64 + 8 * pc + i];
    const int u0 = (b * 4 + h) * 64;
    const bf16* gt = (const bf16*)(F.ws + WS_GT) + (size_t)u0 * 4 * 4096 + r * 64 + pc * 8;
    v4u pw = *(const v4u*)(gt), pa = *(const v4u*)(gt + 4096), pq = *(const v4u*)(gt + 2 * 4096), pk = *(const v4u*)(gt + 3 * 4096);
    v4u pu = *(const v4u*)(MIX + (size_t)(b * SEQ + r) * D + 64 * h + 8 * pc);
    float gl = GL[u0];
    for (int n = 0; n < 64; ++n) {
        const int row0 = b * SEQ + n * 64, cur = n & 1;
        unsigned char* STc = ST0 + cur * 9216; unsigned char* STn = ST0 + (cur ^ 1) * 9216;
        *(v4u*)(WN + r * T72 + pc * 16) = pw; *(v4u*)(AT + r * T72 + pc * 16) = pa; *(v4u*)(QD + r * T72 + pc * 16) = pq; *(v4u*)(KDT + r * T72 + pc * 16) = pk; *(v4u*)(UU + r * T72 + pc * 16) = pu;
        const float glc = gl;
        const v4u gate = *(const v4u*)(P + (size_t)(row0 + r) * PP + A_G + 64 * h + 8 * pc);
        if (n + 1 < 64) { const bf16* g2 = gt + (size_t)(n + 1) * 4 * 4096;
            pw = *(const v4u*)(g2); pa = *(const v4u*)(g2 + 4096); pq = *(const v4u*)(g2 + 2 * 4096); pk = *(const v4u*)(g2 + 3 * 4096);
            pu = *(const v4u*)(MIX + (size_t)(row0 + 64 + r) * D + 64 * h + 8 * pc); gl = GL[u0 + n + 1]; }
        LBAR();
        {
            f32x4 a1[2];
#pragma unroll
            for (int t = 0; t < 2; ++t) { const int e = 32 * wn + 16 * t + fr;
#pragma unroll
                for (int j = 0; j < 4; ++j) a1[t][j] = bf2f(*(const unsigned short*)(UU + (16 * wm + 4 * fq + j) * T72 + e * 2)); }
            mma_nt<2, 2>(a1, WN, T72, 16 * wm, STc, T72, 32 * wn, lane);
#pragma unroll
            for (int t = 0; t < 2; ++t) *(v2u*)(VNT + (32 * wn + 16 * t + fr) * T72 + (16 * wm + 4 * fq) * 2) = pk4(a1[t].x, a1[t].y, a1[t].z, a1[t].w);
        }
        LBAR();
        {
            f32x4 o[2] = {(f32x4){0.f, 0.f, 0.f, 0.f}, (f32x4){0.f, 0.f, 0.f, 0.f}};
            mma_nt<2, 2>(o, QD, T72, 16 * wm, STc, T72, 32 * wn, lane);
            mma_nt<2, 2>(o, AT, T72, 16 * wm, VNT, T72, 32 * wn, lane);
#pragma unroll
            for (int t = 0; t < 2; ++t)
#pragma unroll
                for (int j = 0; j < 4; ++j) O[(16 * wm + 4 * fq + j) * 65 + 32 * wn + 16 * t + fr] = o[t][j];
            S[0] = S[0] * glc; S[1] = S[1] * glc;
            mma_nt<2, 2>(S, KDT, T72, 16 * wm, VNT, T72, 32 * wn, lane);
#pragma unroll
            for (int t = 0; t < 2; ++t) *(v2u*)(STn + (32 * wn + 16 * t + fr) * T72 + (16 * wm + 4 * fq) * 2) = pk4(S[t].x, S[t].y, S[t].z, S[t].w);
        }
        LBAR();
        {
            float ov[8], gv[8]; float ss = 0.f;
#pragma unroll
            for (int i = 0; i < 8; ++i) { ov[i] = O[r * 65 + 8 * pc + i]; ss += ov[i] * ov[i]; }
            ss += __shfl_xor(ss, 1); ss += __shfl_xor(ss, 2); ss += __shfl_xor(ss, 4);
            const float rr = rsqrt_f(ss * (1.f / 64.f) + EPS);
            unpk8(gate, gv);
#pragma unroll
            for (int i = 0; i < 8; ++i) ov[i] = ov[i] * rr * ng[i] * gv[i];
            *(v4u*)(MIX + (size_t)(row0 + r) * D + 64 * h + 8 * pc) = pk8(ov);
        }
    }
    LBAR();
}
constexpr int T136 = 272;
__device__ __forceinline__ void ssd_local_unit(Frame& F, int l, int u, unsigned char* lds) {
    const int tid = F.tid, lane = F.lane, w = F.wave, fr = lane & 15, fq = lane >> 4;
    const int b = u >> 7, g = (u >> 6) & 1, n = u & 63, row0 = b * SEQ + n * 64;
    const bf16* P = (const bf16*)(F.ws + WS_P); const float* SM = (const float*)(F.ws + WS_SM); bf16* MIX = (bf16*)(F.ws + WS_XN);
    unsigned char* CM = lds; unsigned char* BM = lds + 17408; unsigned char* BMT = lds + 34816; unsigned char* XDT = lds + 53248; unsigned char* XST = lds + 71680; unsigned char* LD = lds + 90112;
    float* sacs = (float*)(lds + 108544); float* sdt = (float*)(lds + 109056);
    if (w < 2) {
        const int h = 2 * g + w;
        const float dt = softplus_f(SM[(size_t)(row0 + lane) * 32 + SM_DT + h] + F.in[I_SDTB][l * 4 + h]);
        const float acs = wave_scan_add(dt * (-expf(F.in[I_SALOG][l * 4 + h])), lane);
        sdt[w * 64 + lane] = dt; sacs[w * 64 + lane] = acs;
        ((float*)(F.ws + WS_SCAL + SC_ACS))[(size_t)(b * 4 + h) * SEQ + n * 64 + lane] = acs;
    }
    const int t = tid >> 3, cg = tid & 7, pos = n * 64 + t;
    const float* cwl = (const float*)(lds + CW_SSD);
    float val[6][8];
#pragma unroll
    for (int kb = 0; kb < 6; kb += 3) {
        v4u raw[3][4];
#pragma unroll
        for (int k2 = 0; k2 < 3; ++k2) { const int k = kb + k2, chg = cg + 8 * k, ch = (k < 2) ? (128 * g + 8 * chg) : (k < 4) ? (256 + 128 * g + 8 * (chg - 16)) : (512 + 128 * g + 8 * (chg - 32));
            conv8_load(P + C_XBC + ch, row0 + t, pos, raw[k2]); }
#pragma unroll
        for (int k2 = 0; k2 < 3; ++k2) { const int k = kb + k2, chg = cg + 8 * k, ch = (k < 2) ? (128 * g + 8 * chg) : (k < 4) ? (256 + 128 * g + 8 * (chg - 16)) : (512 + 128 * g + 8 * (chg - 32));
            conv8_fin(raw[k2], pos, cwl + ch, 768, val[k]);
            const f32x4 b0 = *(const f32x4*)(cwl + 3072 + ch), b1 = *(const f32x4*)(cwl + 3072 + ch + 4);
            val[k][0] = silu_f(val[k][0] + b0.x); val[k][1] = silu_f(val[k][1] + b0.y); val[k][2] = silu_f(val[k][2] + b0.z); val[k][3] = silu_f(val[k][3] + b0.w);
            val[k][4] = silu_f(val[k][4] + b1.x); val[k][5] = silu_f(val[k][5] + b1.y); val[k][6] = silu_f(val[k][6] + b1.z); val[k][7] = silu_f(val[k][7] + b1.w); }
        asm volatile("" ::: "memory");
    }
    LBAR();
#pragma unroll
    for (int k = 0; k < 6; ++k) {
        const int chg = cg + 8 * k;
        if (k < 2) { const int hh = k, p0 = 8 * cg; const float dt = sdt[hh * 64 + t], ds = expf(sacs[hh * 64 + 63] - sacs[hh * 64 + t]);
#pragma unroll
            for (int i = 0; i < 8; ++i) { const float xd = val[k][i] * dt;
                *(unsigned short*)(XDT + hh * 9216 + (p0 + i) * T72 + t * 2) = (unsigned short)f2bf(xd);
                *(unsigned short*)(XST + hh * 9216 + (p0 + i) * T72 + t * 2) = (unsigned short)f2bf(xd * ds); }
        } else if (k < 4) { const int n0 = 8 * (chg - 16);
            *(v4u*)(BM + t * T136 + n0 * 2) = pk8(val[k]);
#pragma unroll
            for (int i = 0; i < 8; ++i) *(unsigned short*)(BMT + (n0 + i) * T72 + t * 2) = (unsigned short)f2bf(val[k][i]);
        } else { const int n0 = 8 * (chg - 32); const v4u cv = pk8(val[k]); *(v4u*)(CM + t * T136 + n0 * 2) = cv;
            if (t <= 60) *(v4u*)((bf16*)P + (size_t)(row0 + t) * PP + C_XBC + 512 + 128 * g + n0) = cv;
            else *(v4u*)((bf16*)(F.ws + WS_CSIDE) + ((size_t)u * 3 + (t - 61)) * 128 + n0) = cv; }
    }
    {
        bf16* zp = (bf16*)P + (size_t)(row0 + t) * PP + C_Z + 128 * g + 16 * cg; float z0[8], z1[8]; unpk8(*(const v4u*)zp, z0); unpk8(*(const v4u*)(zp + 8), z1);
#pragma unroll
        for (int i = 0; i < 8; ++i) { z0[i] = silu_f(z0[i]); z1[i] = silu_f(z1[i]); }
        *(v4u*)zp = pk8(z0); *(v4u*)(zp + 8) = pk8(z1);
    }
    LBAR();
    {
        f32x4 acc[2] = {(f32x4){0.f, 0.f, 0.f, 0.f}, (f32x4){0.f, 0.f, 0.f, 0.f}};
        mma_nt<2, 4>(acc, BM, T136, 16 * (w & 3), CM, T136, 32 * (w >> 2), lane);
        const int m0 = 16 * (w & 3) + 4 * fq;
#pragma unroll
        for (int hh = 0; hh < 2; ++hh) { const float Dh = F.in[I_SD][l * 4 + 2 * g + hh];
#pragma unroll
            for (int tt = 0; tt < 2; ++tt) { const int lr = 32 * (w >> 2) + 16 * tt + fr; const float al = sacs[hh * 64 + lr];
                float o[4];
#pragma unroll
                for (int j = 0; j < 4; ++j) { const int m = m0 + j; o[j] = (m <= lr) ? acc[tt][j] * __expf(al - sacs[hh * 64 + m]) : 0.f; if (m == lr) o[j] += Dh / sdt[hh * 64 + lr]; }
                *(v2u*)(LD + hh * 9216 + lr * T72 + m0 * 2) = pk4(o[0], o[1], o[2], o[3]); } }
    }
    LBAR();
    {
        const int hh = w >> 2, h = 2 * g + hh;
        f32x4 ya[4];
#pragma unroll
        for (int tt = 0; tt < 4; ++tt) ya[tt] = (f32x4){0.f, 0.f, 0.f, 0.f};
        mma_nt<4, 2>(ya, XDT + hh * 9216, T72, 16 * (w & 3), LD + hh * 9216, T72, 0, lane);
#pragma unroll
        for (int tt = 0; tt < 4; ++tt) *(v2u*)(MIX + (size_t)(row0 + 16 * tt + fr) * D + 512 + 64 * h + 16 * (w & 3) + 4 * fq) = pk4(ya[tt].x, ya[tt].y, ya[tt].z, ya[tt].w);
        bf16* STT = (bf16*)(F.ws + WS_SST) + ((size_t)(b * 4 + h) * 64 + n) * 8192;
#pragma unroll
        for (int k2 = 0; k2 < 2; ++k2) { const int rb = (w & 3) + 4 * k2;
            f32x4 sa[4];
#pragma unroll
            for (int tt = 0; tt < 4; ++tt) sa[tt] = (f32x4){0.f, 0.f, 0.f, 0.f};
            mma_nt<4, 2>(sa, BMT, T72, 16 * rb, XST + hh * 9216, T72, 0, lane);
#pragma unroll
            for (int tt = 0; tt < 4; ++tt) *(v2u*)(STT + (16 * tt + fr) * 128 + 16 * rb + 4 * fq) = pk4(sa[tt].x, sa[tt].y, sa[tt].z, sa[tt].w); }
    }
    LBAR();
}
__device__ __forceinline__ void ssd_chain(Frame& F, int l, int b, int g, unsigned char* lds) {
    const int tid = F.tid, lane = F.lane, w = F.wave, fr = lane & 15, fq = lane >> 4;
    const bf16* P = (const bf16*)(F.ws + WS_P); bf16* MIX = (bf16*)(F.ws + WS_XN);
    const float* ACS = (const float*)(F.ws + WS_SCAL + SC_ACS);
    unsigned char* CM = lds; unsigned char* PV = lds + 17408; float* YZ = (float*)(lds + 52224); float* seacs = (float*)(lds + 85248); float* sdal = (float*)(lds + 85760);
    v2u* PZ = (v2u*)(lds + 86016) + tid;
    float prev[2][2][8];
#pragma unroll
    for (int hh = 0; hh < 2; ++hh)
#pragma unroll
        for (int i = 0; i < 2; ++i)
#pragma unroll
            for (int e = 0; e < 8; ++e) prev[hh][i][e] = 0.f;
    const bf16* stt = (const bf16*)(F.ws + WS_SST) + (size_t)(b * 4 + 2 * g) * 64 * 8192;
    const int t = tid >> 3, cg = tid & 7;
    const int hhw = w >> 2, hw = 2 * g + hhw, p0 = 16 * (w & 3) + 4 * fq;
    v4u pst[2][2], craw[2]; v2u ppv[4], zzv[4]; float acsv = 0.f;
    const bf16* cside = (const bf16*)(F.ws + WS_CSIDE) + (size_t)(b * 2 + g) * 64 * 3 * 128;
#pragma unroll
    for (int hh = 0; hh < 2; ++hh)
#pragma unroll
        for (int i = 0; i < 2; ++i) pst[hh][i] = (v4u){0u, 0u, 0u, 0u};
#pragma unroll
    for (int k = 0; k < 2; ++k) craw[k] = (t <= 60) ? *(const v4u*)(P + (size_t)(b * SEQ + t) * PP + C_XBC + 512 + 128 * g + 8 * (cg + 8 * k)) : *(const v4u*)(cside + (size_t)(t - 61) * 128 + 8 * (cg + 8 * k));
    if (tid < 128) acsv = ACS[(size_t)(b * 4 + 2 * g + (tid >> 6)) * SEQ + (tid & 63)];
#pragma unroll
    for (int tt = 0; tt < 4; ++tt) { const int lr = 16 * tt + fr;
        ppv[tt] = *(const v2u*)(MIX + (size_t)(b * SEQ + lr) * D + 512 + 64 * hw + p0); zzv[tt] = *(const v2u*)(P + (size_t)(b * SEQ + lr) * PP + C_Z + 64 * hw + p0); }
    float ngv[16];
#pragma unroll
    for (int i = 0; i < 16; ++i) ngv[i] = F.in[I_SNORM][l * 256 + 128 * g + 16 * cg + i];
    for (int n = 0; n < 64; ++n) {
        const int row0 = b * SEQ + n * 64, pos = n * 64 + t;
        {
#pragma unroll
            for (int hh = 0; hh < 2; ++hh) { const float da = (n > 0) ? sdal[2 * ((n - 1) & 1) + hh] : 0.f;
#pragma unroll
                for (int i = 0; i < 2; ++i) { float s8[8]; unpk8(pst[hh][i], s8);
#pragma unroll
                    for (int e = 0; e < 8; ++e) prev[hh][i][e] = prev[hh][i][e] * da + s8[e];
                    const int q = tid + 512 * i; *(v4u*)(PV + hh * 17408 + (q >> 4) * T136 + (q & 15) * 16) = pk8(prev[hh][i]); } }
        }
#pragma unroll
        for (int k = 0; k < 2; ++k) *(v4u*)(CM + t * T136 + (cg + 8 * k) * 16) = craw[k];
#pragma unroll
        for (int tt = 0; tt < 4; ++tt) { PZ[512 * (2 * tt)] = ppv[tt]; PZ[512 * (2 * tt + 1)] = zzv[tt]; }
        if (tid < 128) { const float ea = __expf(acsv); seacs[tid] = ea; if ((tid & 63) == 63) sdal[2 * (n & 1) + (tid >> 6)] = ea; }
#pragma unroll
        for (int hh = 0; hh < 2; ++hh)
#pragma unroll
            for (int i = 0; i < 2; ++i) pst[hh][i] = *(const v4u*)(stt + ((size_t)hh * 64 + n) * 8192 + (size_t)(tid + 512 * i) * 8);
        if (n + 1 < 64) {
#pragma unroll
            for (int k = 0; k < 2; ++k) craw[k] = (t <= 60) ? *(const v4u*)(P + (size_t)(row0 + 64 + t) * PP + C_XBC + 512 + 128 * g + 8 * (cg + 8 * k)) : *(const v4u*)(cside + ((size_t)(n + 1) * 3 + (t - 61)) * 128 + 8 * (cg + 8 * k));
            if (tid < 128) acsv = ACS[(size_t)(b * 4 + 2 * g + (tid >> 6)) * SEQ + (n + 1) * 64 + (tid & 63)];
#pragma unroll
            for (int tt = 0; tt < 4; ++tt) { const int lr = 16 * tt + fr;
                ppv[tt] = *(const v2u*)(MIX + (size_t)(row0 + 64 + lr) * D + 512 + 64 * hw + p0); zzv[tt] = *(const v2u*)(P + (size_t)(row0 + 64 + lr) * PP + C_Z + 64 * hw + p0); }
        }
        LBAR();
        {
            f32x4 ya[4];
#pragma unroll
            for (int tt = 0; tt < 4; ++tt) ya[tt] = (f32x4){0.f, 0.f, 0.f, 0.f};
            mma_nt<4, 4>(ya, PV + hhw * 17408, T136, 16 * (w & 3), CM, T136, 0, lane);
#pragma unroll
            for (int tt = 0; tt < 4; ++tt) { const int lr = 16 * tt + fr; const v2u pp = PZ[512 * (2 * tt)], zz = PZ[512 * (2 * tt + 1)];
                const float ea = seacs[hhw * 64 + lr];
                const float y0 = ea * ya[tt].x + bf2f(pp.x & 0xffffu), y1 = ea * ya[tt].y + bf2f(pp.x >> 16), y2 = ea * ya[tt].z + bf2f(pp.y & 0xffffu), y3 = ea * ya[tt].w + bf2f(pp.y >> 16);
                float* yz = YZ + lr * 129 + 64 * hhw + p0;
                yz[0] = y0 * bf2f(zz.x & 0xffffu); yz[1] = y1 * bf2f(zz.x >> 16); yz[2] = y2 * bf2f(zz.y & 0xffffu); yz[3] = y3 * bf2f(zz.y >> 16); }
        }
        LBAR();
        {
            float v[16]; float ss = 0.f;
#pragma unroll
            for (int i = 0; i < 16; ++i) { v[i] = YZ[t * 129 + 16 * cg + i]; ss += v[i] * v[i]; }
            ss += __shfl_xor(ss, 1); ss += __shfl_xor(ss, 2); ss += __shfl_xor(ss, 4);
            const float rr = rsqrt_f(ss * (1.f / 128.f) + EPS);
            float o0[8], o1[8];
#pragma unroll
            for (int i = 0; i < 8; ++i) { o0[i] = v[i] * rr * ngv[i]; o1[i] = v[8 + i] * rr * ngv[8 + i]; }
            bf16* op = MIX + (size_t)(row0 + t) * D + 512 + 128 * g + 16 * cg;
            *(v4u*)op = pk8(o0); *(v4u*)(op + 8) = pk8(o1);
        }
    }
    LBAR();
}
__device__ __forceinline__ void mlstm_local_unit(Frame& F, int l, int u, unsigned char* lds) {
    const int tid = F.tid, lane = F.lane, w = F.wave, fr = lane & 15, fq = lane >> 4;
    const int b = u >> 8, h = (u >> 6) & 3, n = u & 63, row0 = b * SEQ + n * 64;
    const bf16* P = (const bf16*)(F.ws + WS_P); const float* SM = (const float*)(F.ws + WS_SM); bf16* MIX = (bf16*)(F.ws + WS_XN);
    float* SC = (float*)(F.ws + WS_SCAL);
    unsigned char* QS = lds; unsigned char* KS = lds + 9216; unsigned char* VT = lds + 18432; unsigned char* KWT = lds + 27648; unsigned char* SS = lds + 36864; unsigned char* ONES = lds + 46080;
    float* sbb = (float*)(lds + 48384); float* sli = (float*)(lds + 48640); float* sdm = (float*)(lds + 48896); float* skw = (float*)(lds + 49152);
    const size_t tok = (size_t)(b * 4 + h) * SEQ + n * 64;
    if (w == 0) {
        const float* sm = SM + (size_t)(row0 + lane) * 32;
        const float li = sm[SM_I + h] + F.in[I_MIB][l * 4 + h], lf = -softplus_f(-(sm[SM_F + h] + F.in[I_MFB][l * 4 + h]));
        const float bb = wave_scan_add(lf, lane);
        const float dm = bb + wave_scan_max(li - bb, lane);
        const float bl = __shfl(bb, 63), ge = bl - bb + li, mloc = wave_max(ge);
        sbb[lane] = bb; sli[lane] = li; sdm[lane] = dm; skw[lane] = expf(ge - mloc);
        SC[SC_BB / 4 + tok + lane] = bb; SC[SC_DM / 4 + tok + lane] = dm;
        if (lane == 0) { SC[SC_MU / 4 + 2 * u] = mloc; SC[SC_MU / 4 + 2 * u + 1] = bl; }
    }
    if (tid < 16 * 9) ((v4u*)ONES)[tid] = (v4u){0x3f803f80u, 0x3f803f80u, 0x3f803f80u, 0x3f803f80u};
    const int t = tid >> 3, cg = tid & 7;
    const bf16* prow = P + (size_t)(row0 + t) * PP + 64 * h + 8 * cg;
    const v4u qv = *(const v4u*)(prow + D_Q), kv = *(const v4u*)(prow + D_K), vv = *(const v4u*)(prow + D_V);
    float k8[8], v8[8]; unpk8(kv, k8); unpk8(vv, v8);
    {
        float o8[8]; unpk8(*(const v4u*)(prow + D_O), o8);
#pragma unroll
        for (int i = 0; i < 8; ++i) o8[i] = sigmoid_f(o8[i]);
        *(v4u*)((bf16*)prow + D_O) = pk8(o8);
    }
    *(v4u*)(QS + t * T72 + cg * 16) = qv;
#pragma unroll
    for (int i = 0; i < 8; ++i) k8[i] *= 0.125f;
    *(v4u*)(KS + t * T72 + cg * 16) = pk8(k8);
#pragma unroll
    for (int i = 0; i < 8; ++i) *(unsigned short*)(VT + (8 * cg + i) * T72 + t * 2) = (unsigned short)f2bf(v8[i]);
    LBAR();
    { const float kw = skw[t];
#pragma unroll
      for (int i = 0; i < 8; ++i) *(unsigned short*)(KWT + (8 * cg + i) * T72 + t * 2) = (unsigned short)f2bf(k8[i] * kw); }
    {
        f32x4 acc[2] = {(f32x4){0.f, 0.f, 0.f, 0.f}, (f32x4){0.f, 0.f, 0.f, 0.f}};
        mma_nt<2, 2>(acc, KS, T72, 16 * (w & 3), QS, T72, 32 * (w >> 2), lane);
        const int m0 = 16 * (w & 3) + 4 * fq;
#pragma unroll
        for (int tt = 0; tt < 2; ++tt) { const int c = 32 * (w >> 2) + 16 * tt + fr; const float base = sbb[c] - sdm[c];
            float o[4];
#pragma unroll
            for (int j = 0; j < 4; ++j) { const int m = m0 + j; o[j] = (m <= c) ? acc[tt][j] * __expf(base - sbb[m] + sli[m]) : 0.f; }
            *(v2u*)(SS + c * T72 + m0 * 2) = pk4(o[0], o[1], o[2], o[3]); }
    }
    LBAR();
    {
        const int e0 = 16 * (w & 3) + 4 * fq;
        f32x4 na[2] = {(f32x4){0.f, 0.f, 0.f, 0.f}, (f32x4){0.f, 0.f, 0.f, 0.f}};
        mma_nt<2, 2>(na, VT, T72, 16 * (w & 3), SS, T72, 32 * (w >> 2), lane);
#pragma unroll
        for (int tt = 0; tt < 2; ++tt) *(v2u*)(MIX + (size_t)(row0 + 32 * (w >> 2) + 16 * tt + fr) * D + 768 + 64 * h + e0) = pk4(na[tt].x, na[tt].y, na[tt].z, na[tt].w);
        f32x4 ka[2] = {(f32x4){0.f, 0.f, 0.f, 0.f}, (f32x4){0.f, 0.f, 0.f, 0.f}};
        mma_nt<2, 2>(ka, KWT, T72, 16 * (w & 3), VT, T72, 32 * (w >> 2), lane);
        bf16* KCT = (bf16*)(F.ws + WS_MKC) + (size_t)u * 4096;
#pragma unroll
        for (int tt = 0; tt < 2; ++tt) *(v2u*)(KCT + (32 * (w >> 2) + 16 * tt + fr) * 64 + e0) = pk4(ka[tt].x, ka[tt].y, ka[tt].z, ka[tt].w);
        if (w < 4) {
            f32x4 da[1] = {(f32x4){0.f, 0.f, 0.f, 0.f}}, nn[1] = {(f32x4){0.f, 0.f, 0.f, 0.f}};
            mma_nt<1, 2>(da, ONES, T72, 0, SS, T72, 16 * w, lane);
            mma_nt<1, 2>(nn, KWT, T72, 16 * w, ONES, T72, 0, lane);
            if (fq == 0) SC[SC_DEN / 4 + tok + 16 * w + fr] = da[0].x;
            if (fr == 0) *(f32x4*)(SC + SC_NC / 4 + (size_t)u * 64 + 16 * w + 4 * fq) = nn[0];
        }
    }
    LBAR();
}
__device__ __forceinline__ void mlstm_chain(Frame& F, int l, int b, int h, unsigned char* lds) {
    const int tid = F.tid, lane = F.lane, w = F.wave, fr = lane & 15, fq = lane >> 4;
    const bf16* P = (const bf16*)(F.ws + WS_P); bf16* MIX = (bf16*)(F.ws + WS_XN);
    const float* SC = (const float*)(F.ws + WS_SCAL);
    unsigned char* QS = lds; unsigned char* CT0 = lds + 9216; unsigned char* NB0 = lds + 27648;
    float* swst = (float*)(lds + 32256); float* ssloc = (float*)(lds + 32512); float* semt = (float*)(lds + 32768); float* sden = (float*)(lds + 33024);
    v2u* NO = (v2u*)(lds + 33280) + (tid & 255);
    const int u0 = (b * 4 + h) * 64; const size_t tok0 = (size_t)(b * 4 + h) * SEQ;
    for (int i = tid; i < (9216 + 2304) / 4; i += 512) { if (i < 2304) ((unsigned*)CT0)[i] = 0u; else ((unsigned*)NB0)[i - 2304] = 0u; }
    const int se = (tid - 256) >> 2, sd0 = 16 * ((tid - 256) & 3);
    float Cm[16], nm[16];
#pragma unroll
    for (int i = 0; i < 16; ++i) { Cm[i] = 0.f; nm[i] = 0.f; }
    float m_st = 0.f;
    const int t = tid >> 3, cg = tid & 7, cw_ = 16 * (w & 3) + fr;
    float ngv[4][4];
#pragma unroll
    for (int rb = 0; rb < 4; ++rb)
#pragma unroll
        for (int j = 0; j < 4; ++j) ngv[rb][j] = F.in[I_MNORM][l * 256 + 64 * h + 16 * rb + 4 * fq + j];
    v4u pq = *(const v4u*)(P + (size_t)(b * SEQ + t) * PP + D_Q + 64 * h + 8 * cg);
    float pbb = 0.f, pdm = 0.f, pden = 0.f;
    if (tid < 64) { pbb = SC[SC_BB / 4 + tok0 + tid]; pdm = SC[SC_DM / 4 + tok0 + tid]; pden = SC[SC_DEN / 4 + tok0 + tid]; }
    float pml = SC[SC_MU / 4 + 2 * u0], pbl = SC[SC_MU / 4 + 2 * u0 + 1];
    v4u pk0 = {0u, 0u, 0u, 0u}, pk1 = {0u, 0u, 0u, 0u}; f32x4 pn[4] = {(f32x4){0.f, 0.f, 0.f, 0.f}, (f32x4){0.f, 0.f, 0.f, 0.f}, (f32x4){0.f, 0.f, 0.f, 0.f}, (f32x4){0.f, 0.f, 0.f, 0.f}};
    v2u pnl[4], pog[4];
#pragma unroll
    for (int rb = 0; rb < 4; ++rb) { pnl[rb] = (v2u){0u, 0u}; pog[rb] = (v2u){0u, 0u}; }
    if (w >= 4) { const bf16* kct = (const bf16*)(F.ws + WS_MKC) + (size_t)u0 * 4096 + se * 64 + sd0; pk0 = *(const v4u*)kct; pk1 = *(const v4u*)(kct + 8);
        const float* ncp = SC + SC_NC / 4 + (size_t)u0 * 64 + sd0;
#pragma unroll
        for (int i = 0; i < 4; ++i) pn[i] = *(const f32x4*)(ncp + 4 * i);
    } else {
#pragma unroll
        for (int rb = 0; rb < 4; ++rb) { pnl[rb] = *(const v2u*)(MIX + (size_t)(b * SEQ + cw_) * D + 768 + 64 * h + 16 * rb + 4 * fq); pog[rb] = *(const v2u*)(P + (size_t)(b * SEQ + cw_) * PP + D_O + 64 * h + 16 * rb + 4 * fq); }
    }
    for (int n = 0; n < 64; ++n) {
        const int row0 = b * SEQ + n * 64, cur = n & 1;
        unsigned char* CTc = CT0 + cur * 9216; unsigned char* CTn = CT0 + (cur ^ 1) * 9216; unsigned char* NBc = NB0 + cur * 2304; unsigned char* NBn = NB0 + (cur ^ 1) * 2304;
        *(v4u*)(QS + t * T72 + cg * 16) = pq;
        if (tid < 64) { const float mt = fmaxf(pbb + m_st, pdm); swst[tid] = __expf(pbb + m_st - mt); ssloc[tid] = __expf(pdm - mt); semt[tid] = __expf(-mt); sden[tid] = pden; }
        const float m_new = fmaxf(pbl + m_st, pml), fa = __expf(pbl + m_st - m_new), fb = __expf(pml - m_new);
        m_st = m_new;
        if (w >= 4) {
            float k0[8], k1[8]; unpk8(pk0, k0); unpk8(pk1, k1);
            const float ncv[16] = {pn[0].x, pn[0].y, pn[0].z, pn[0].w, pn[1].x, pn[1].y, pn[1].z, pn[1].w, pn[2].x, pn[2].y, pn[2].z, pn[2].w, pn[3].x, pn[3].y, pn[3].z, pn[3].w};
            float o0[8], o1[8];
#pragma unroll
            for (int i = 0; i < 8; ++i) { Cm[i] = Cm[i] * fa + k0[i] * fb; Cm[8 + i] = Cm[8 + i] * fa + k1[i] * fb; nm[i] = nm[i] * fa + ncv[i] * fb; nm[8 + i] = nm[8 + i] * fa + ncv[8 + i] * fb; o0[i] = Cm[i]; o1[i] = Cm[8 + i]; }
            *(v4u*)(CTn + se * T72 + sd0 * 2) = pk8(o0); *(v4u*)(CTn + se * T72 + sd0 * 2 + 16) = pk8(o1);
            if (se < 16) {
#pragma unroll
                for (int i = 0; i < 8; ++i) { o0[i] = nm[i]; o1[i] = nm[8 + i]; }
                *(v4u*)(NBn + se * T72 + sd0 * 2) = pk8(o0); *(v4u*)(NBn + se * T72 + sd0 * 2 + 16) = pk8(o1); }
        } else {
#pragma unroll
            for (int rb = 0; rb < 4; ++rb) { NO[256 * (2 * rb)] = pnl[rb]; NO[256 * (2 * rb + 1)] = pog[rb]; }
        }
        if (n + 1 < 64) {
            pq = *(const v4u*)(P + (size_t)(row0 + 64 + t) * PP + D_Q + 64 * h + 8 * cg);
            if (tid < 64) { pbb = SC[SC_BB / 4 + tok0 + (n + 1) * 64 + tid]; pdm = SC[SC_DM / 4 + tok0 + (n + 1) * 64 + tid]; pden = SC[SC_DEN / 4 + tok0 + (n + 1) * 64 + tid]; }
            pml = SC[SC_MU / 4 + 2 * (u0 + n + 1)]; pbl = SC[SC_MU / 4 + 2 * (u0 + n + 1) + 1];
            if (w >= 4) { const bf16* kct = (const bf16*)(F.ws + WS_MKC) + (size_t)(u0 + n + 1) * 4096 + se * 64 + sd0; pk0 = *(const v4u*)kct; pk1 = *(const v4u*)(kct + 8);
                const float* ncp = SC + SC_NC / 4 + (size_t)(u0 + n + 1) * 64 + sd0;
#pragma unroll
                for (int i = 0; i < 4; ++i) pn[i] = *(const f32x4*)(ncp + 4 * i);
            } else {
#pragma unroll
                for (int rb = 0; rb < 4; ++rb) { pnl[rb] = *(const v2u*)(MIX + (size_t)(row0 + 64 + cw_) * D + 768 + 64 * h + 16 * rb + 4 * fq); pog[rb] = *(const v2u*)(P + (size_t)(row0 + 64 + cw_) * PP + D_O + 64 * h + 16 * rb + 4 * fq); }
            }
        }
        LBAR();
        if (w < 4) {
            f32x4 na[4][1], dd[1] = {(f32x4){0.f, 0.f, 0.f, 0.f}};
#pragma unroll
            for (int rb = 0; rb < 4; ++rb) { na[rb][0] = (f32x4){0.f, 0.f, 0.f, 0.f}; mma_nt<1, 2>(na[rb], CTc, T72, 16 * rb, QS, T72, 16 * w, lane); }
            mma_nt<1, 2>(dd, NBc, T72, 0, QS, T72, 16 * w, lane);
            const int c = cw_; const float ws_ = swst[c], sl = ssloc[c];
            const float den = ws_ * dd[0].x + sl * sden[c], inv = __builtin_amdgcn_rcpf(fmaxf(fabsf(den), semt[c]));
            float hv[4][4]; float ss = 0.f;
#pragma unroll
            for (int rb = 0; rb < 4; ++rb) { const v2u nl = NO[256 * (2 * rb)], og = NO[256 * (2 * rb + 1)];
                const float nlv[4] = {bf2f(nl.x & 0xffffu), bf2f(nl.x >> 16), bf2f(nl.y & 0xffffu), bf2f(nl.y >> 16)}, ogv[4] = {bf2f(og.x & 0xffffu), bf2f(og.x >> 16), bf2f(og.y & 0xffffu), bf2f(og.y >> 16)};
#pragma unroll
                for (int j = 0; j < 4; ++j) { hv[rb][j] = (ws_ * na[rb][0][j] + sl * nlv[j]) * inv * ogv[j]; ss += hv[rb][j] * hv[rb][j]; } }
            ss += __shfl_xor(ss, 16); ss += __shfl_xor(ss, 32);
            const float rr = rsqrt_f(ss * (1.f / 64.f) + EPS);
#pragma unroll
            for (int rb = 0; rb < 4; ++rb) *(v2u*)(MIX + (size_t)(row0 + c) * D + 768 + 64 * h + 16 * rb + 4 * fq) = pk4(hv[rb][0] * rr * ngv[rb][0], hv[rb][1] * rr * ngv[rb][1], hv[rb][2] * rr * ngv[rb][2], hv[rb][3] * rr * ngv[rb][3]);
        }
        LBAR();
    }
}
constexpr int AT_KROW = 64, AT_VT = 2 * 64 * AT_KROW, AT_SLOT = AT_VT + 8192, AT_NSLOT = 4, AT_OX = AT_NSLOT * AT_SLOT;
typedef short v4i16_t __attribute__((ext_vector_type(4)));
__device__ __forceinline__ v2u vtr(const unsigned char* p) { return __builtin_bit_cast(v2u, __builtin_amdgcn_ds_read_tr16_b64_v4i16((LAS v4i16_t*)p)); }
static_assert(AT_SLOT == 16384, "attention LDS map");
struct AttnState { f32x16 o1a, o1b, o2a, o2b; float m1, l1, m2, l2; };
__device__ __forceinline__ void attn_softmax(f32x16& s0, f32x16& s1, float& m_run, float& l_run, f32x16& oa, f32x16& ob, bf16x8 (&pf)[4]) {
#pragma unroll
    for (int i = 0; i < 16; ++i) { s0[i] -= m_run; s1[i] -= m_run; }
    float ma = __builtin_fmaxf(__builtin_fmaxf(s0[0], s1[0]), s0[1]), mb = __builtin_fmaxf(__builtin_fmaxf(s1[1], s0[2]), s1[2]);
#pragma unroll
    for (int i = 3; i < 15; i += 2) { ma = __builtin_fmaxf(__builtin_fmaxf(ma, s0[i]), s1[i]); mb = __builtin_fmaxf(__builtin_fmaxf(mb, s0[i + 1]), s1[i + 1]); }
    float mx = __builtin_fmaxf(__builtin_fmaxf(ma, mb), __builtin_fmaxf(s0[15], s1[15]));
    mx = __builtin_fmaxf(mx, __shfl_xor(mx, 32));
    if (!__all(__builtin_fabsf(mx) <= 8.0f)) {
        const float dlt = mx, alpha = __builtin_amdgcn_exp2f(-dlt);
        m_run += dlt; l_run *= alpha;
#pragma unroll
        for (int i = 0; i < 16; ++i) { s0[i] -= dlt; s1[i] -= dlt; oa[i] *= alpha; ob[i] *= alpha; }
    }
    float rs = 0.f;
#pragma unroll
    for (int i = 0; i < 16; ++i) { s0[i] = __builtin_amdgcn_exp2f(s0[i]); s1[i] = __builtin_amdgcn_exp2f(s1[i]); rs += s0[i] + s1[i]; }
    l_run += rs;
#pragma unroll
    for (int st = 0; st < 2; ++st) {
        v4u a, c;
        a.x = pk2(s0[8 * st + 0], s0[8 * st + 1]); a.y = pk2(s0[8 * st + 2], s0[8 * st + 3]); a.z = pk2(s0[8 * st + 4], s0[8 * st + 5]); a.w = pk2(s0[8 * st + 6], s0[8 * st + 7]);
        c.x = pk2(s1[8 * st + 0], s1[8 * st + 1]); c.y = pk2(s1[8 * st + 2], s1[8 * st + 3]); c.z = pk2(s1[8 * st + 4], s1[8 * st + 5]); c.w = pk2(s1[8 * st + 6], s1[8 * st + 7]);
        pf[st] = __builtin_bit_cast(bf16x8, a); pf[2 + st] = __builtin_bit_cast(bf16x8, c);
    }
}
__device__ __forceinline__ void attn_map(const unsigned char* kM, const unsigned char* vA, const bf16x8 Q0, const bf16x8 Q1, float& m_run, float& l_run, f32x16& oa, f32x16& ob) {
    bf16x8 p[4];
    {
        f32x16 sa, sb;
#pragma unroll
        for (int i = 0; i < 16; ++i) { sa[i] = 0.f; sb[i] = 0.f; }
        sa = __builtin_amdgcn_mfma_f32_32x32x16_bf16(*(const bf16x8*)(kM), Q0, sa, 0, 0, 0);
        sa = __builtin_amdgcn_mfma_f32_32x32x16_bf16(*(const bf16x8*)(kM + 32), Q1, sa, 0, 0, 0);
        sb = __builtin_amdgcn_mfma_f32_32x32x16_bf16(*(const bf16x8*)(kM + 32 * AT_KROW), Q0, sb, 0, 0, 0);
        sb = __builtin_amdgcn_mfma_f32_32x32x16_bf16(*(const bf16x8*)(kM + 32 * AT_KROW + 32), Q1, sb, 0, 0, 0);
        attn_softmax(sa, sb, m_run, l_run, oa, ob, p);
    }
#pragma unroll
    for (int ks = 0; ks < 4; ++ks) {
        const unsigned char* va = vA + ks * 1024;
        const v2u lo0 = vtr(va), hi0 = vtr(va + 512), lo1 = vtr(va + 4096), hi1 = vtr(va + 4096 + 512);
        const bf16x8 a0 = __builtin_bit_cast(bf16x8, (v4u){lo0.x, lo0.y, hi0.x, hi0.y}), a1 = __builtin_bit_cast(bf16x8, (v4u){lo1.x, lo1.y, hi1.x, hi1.y});
        oa = __builtin_amdgcn_mfma_f32_32x32x16_bf16(a0, p[ks], oa, 0, 0, 0);
        ob = __builtin_amdgcn_mfma_f32_32x32x16_bf16(a1, p[ks], ob, 0, 0, 0);
    }
}
__device__ __forceinline__ void attn_tile(const unsigned char* slot, int r32, int hh, const bf16x8 Qa0, const bf16x8 Qa1, const bf16x8 Qb0, const bf16x8 Qb1, AttnState& A) {
    const unsigned char* kA = slot + r32 * AT_KROW + hh * 16;
    const int lane_ = r32 + 32 * hh;
    const unsigned char* vA = slot + AT_VT + ((lane_ >> 4) & 1) * 32 + (lane_ & 3) * 8 + (4 * hh + ((lane_ & 15) >> 2)) * 64;
    attn_map(kA, vA, Qa0, Qa1, A.m1, A.l1, A.o1a, A.o1b);
    __builtin_amdgcn_sched_barrier(0);
    attn_map(kA + 64 * AT_KROW, vA, Qb0, Qb1, A.m2, A.l2, A.o2a, A.o2b);
}
__device__ __forceinline__ void attn_unit(Frame& F, const bf16* P, bf16* MIX, int b, int h, int qb, float lam, const float* normg, float oscale, unsigned char* lds) {
    const int lane = F.lane, w = F.wave, r32 = lane & 31, hh = lane >> 5;
    const int q0 = qb * 256 + w * 32;
    const int my_last = 4 * qb + (w >> 1), nt = 4 * qb + 4;
    const bf16* qrow = P + (size_t)(b * SEQ + q0 + r32) * PP + B_Q + 64 * h + 8 * hh;
    bf16x8 Qa0 = *(const bf16x8*)qrow, Qa1 = *(const bf16x8*)(qrow + 16), Qb0 = *(const bf16x8*)(qrow + 32), Qb1 = *(const bf16x8*)(qrow + 48);
    AttnState A;
#pragma unroll
    for (int i = 0; i < 16; ++i) { A.o1a[i] = 0.f; A.o1b[i] = 0.f; A.o2a[i] = 0.f; A.o2b[i] = 0.f; }
    A.m1 = 0.f; A.m2 = 0.f; A.l1 = 0.f; A.l2 = 0.f;
    const int dkey = 16 * (w & 3) + (lane >> 2);
    const bf16* ksrc = P + (size_t)(b * SEQ + dkey) * PP + B_K + 32 * (2 * h + (w >> 2)) + 8 * (lane & 3);
    const bf16* vsrc = P + (size_t)(b * SEQ + dkey) * PP + B_V + 64 * h + 32 * (w >> 2) + 8 * (lane & 3);
    const size_t tstep = (size_t)64 * PP;
    LAS unsigned char* ring = (LAS unsigned char*)lds + w * 1024;
#define ATT_GLDS(gp, ldsaddr) do { unsigned sv_; asm volatile("s_mov_b32 %0, m0\n\ts_mov_b32 m0, %2\n\ts_nop 0\n\tglobal_load_lds_dwordx4 %1, off\n\ts_mov_b32 m0, %0" : "=&s"(sv_) : "v"(gp), "s"(ldsaddr) : "memory"); } while (0)
    const unsigned ring_u = (unsigned)__builtin_amdgcn_readfirstlane((int)(unsigned)(size_t)ring);
#define ATT_ISSUE(t) do { const unsigned sl_ = ring_u + (unsigned)(((t) & (AT_NSLOT - 1)) * AT_SLOT); \
        ATT_GLDS(ksrc + (size_t)(t) * tstep, sl_); ATT_GLDS(vsrc + (size_t)(t) * tstep, sl_ + (unsigned)AT_VT); } while (0)
    {
        v4u qa0 = __builtin_bit_cast(v4u, Qa0), qa1 = __builtin_bit_cast(v4u, Qa1), qb0 = __builtin_bit_cast(v4u, Qb0), qb1 = __builtin_bit_cast(v4u, Qb1);
        asm volatile("" : "+v"(qa0), "+v"(qa1), "+v"(qb0), "+v"(qb1) :: "memory");
        Qa0 = __builtin_bit_cast(bf16x8, qa0); Qa1 = __builtin_bit_cast(bf16x8, qa1); Qb0 = __builtin_bit_cast(bf16x8, qb0); Qb1 = __builtin_bit_cast(bf16x8, qb1);
    }
    LBAR();
    ATT_ISSUE(0); ATT_ISSUE(1); ATT_ISSUE(2);
    for (int j = 0; j < nt; ++j) {
        if (j + 2 < nt) asm volatile("s_waitcnt vmcnt(4)" ::: "memory"); else if (j + 1 < nt) asm volatile("s_waitcnt vmcnt(2)" ::: "memory"); else asm volatile("s_waitcnt vmcnt(0)" ::: "memory");
        LBAR();
        if (j + 3 < nt) ATT_ISSUE(j + 3);
        if (j <= my_last) attn_tile(lds + (j & (AT_NSLOT - 1)) * AT_SLOT, r32, hh, Qa0, Qa1, Qb0, Qb1, A);
    }
#undef ATT_ISSUE
#undef ATT_GLDS
    const float i1 = 1.0f / (A.l1 + __shfl_xor(A.l1, 32)), i2 = lam / (A.l2 + __shfl_xor(A.l2, 32));
    float ss = 0.f;
#pragma unroll
    for (int i = 0; i < 16; ++i) { A.o1a[i] = A.o1a[i] * i1 - A.o2a[i] * i2; A.o1b[i] = A.o1b[i] * i1 - A.o2b[i] * i2; ss += A.o1a[i] * A.o1a[i] + A.o1b[i] * A.o1b[i]; }
    ss += __shfl_xor(ss, 32);
    const float r = oscale * rsqrt_f(ss * (1.f / 64.f) + EPS);
    bf16* orow = MIX + (size_t)(b * SEQ + q0 + r32) * D + 256 + 64 * h;
#pragma unroll
    for (int g4 = 0; g4 < 4; ++g4) { const int dv = 8 * g4 + 4 * hh;
        const f32x4 ga = *(const f32x4*)(normg + dv), gb = *(const f32x4*)(normg + 32 + dv);
        v2u wa, wb; wa.x = pk2(A.o1a[4 * g4] * r * ga.x, A.o1a[4 * g4 + 1] * r * ga.y); wa.y = pk2(A.o1a[4 * g4 + 2] * r * ga.z, A.o1a[4 * g4 + 3] * r * ga.w);
        wb.x = pk2(A.o1b[4 * g4] * r * gb.x, A.o1b[4 * g4 + 1] * r * gb.y); wb.y = pk2(A.o1b[4 * g4 + 2] * r * gb.z, A.o1b[4 * g4 + 3] * r * gb.w);
        *(v2u*)(orow + dv) = wa; *(v2u*)(orow + 32 + dv) = wb; }
}
__device__ __forceinline__ void attn_pull(Frame& F, int l, gu32* cnt8, int first, int limit) {
    const bf16* P = (const bf16*)(F.ws + WS_P); bf16* MIX = (bf16*)(F.ws + WS_XN);
    const float lambda_init = 0.8f - 0.6f * expf(-0.3f * (float)l);
    float d1 = 0.f, d2 = 0.f;
    if (F.lane < 32) { d1 = F.in[I_LQ1][l * 32 + F.lane] * F.in[I_LK1][l * 32 + F.lane]; d2 = F.in[I_LQ2][l * 32 + F.lane] * F.in[I_LK2][l * 32 + F.lane]; }
    const float lam = expf(wave_sum(d1)) - expf(wave_sum(d2)) + lambda_init;
    const float* normg = F.in[I_DNORM] + l * 64;
    const int x0 = (int)(xb_xcc_id() & 7u);
    for (int xo = 0; xo < 8; ++xo) {
        const int x = (x0 + xo) & 7; gu32* cnt = cnt8 + 64 * x;
        for (;;) {
            LBAR();
            if (F.tid == 0) F.MISC[16] = (unsigned)first + __hip_atomic_fetch_add(cnt, 1u, RLX_AGENT);
            LBAR();
            const int i = (int)F.MISC[16];
            if (i >= limit) break;
            const int qb = 15 - (i >> 2), bh = x + 8 * (i & 3);
#if PROBE_SEL
            const bool st_ = (i == first);
            if (st_ && F.tid == 0) ((unsigned long long*)(F.ws + WS_CTL + 512 * 1024))[(64 + 12) * 256 + blockIdx.x] = __builtin_amdgcn_s_memrealtime();
#endif
            attn_unit(F, P, MIX, bh >> 2, bh & 3, qb, lam, normg, 1.0f - lambda_init, F.lds);
#if PROBE_SEL
            if (st_ && F.tid == 0) ((unsigned long long*)(F.ws + WS_CTL + 512 * 1024))[(64 + 13) * 256 + blockIdx.x] = __builtin_amdgcn_s_memrealtime();
#endif
        }
    }
}
#if PROBE_SEL
#define STAMPX(id) do { if (F.tid == 0) ((unsigned long long*)(F.ws + WS_CTL + 512 * 1024))[(64 + (id)) * 256 + blockIdx.x] = __builtin_amdgcn_s_memrealtime(); } while (0)
#else
#define STAMPX(id) do { } while (0)
#endif
constexpr int ATT_B = 64;
constexpr int CW_ATT = 12288;
__device__ __forceinline__ void mixer_phaseA(Frame& F, int l) {
    const int bid = blockIdx.x, G = F.G;
    {
        float* cg_ = (float*)(F.lds + CW_GDN); float* cs_ = (float*)(F.lds + CW_SSD);
        const float* gw = F.in[I_GCONV] + (size_t)l * 3072; const float* sw = F.in[I_SCONVW] + (size_t)l * 3072; const float* sb = F.in[I_SCONVB] + (size_t)l * 768;
        for (int i = F.tid; i < 3072; i += 512) { cg_[i] = gw[i]; cs_[i] = sw[i]; }
        for (int i = F.tid; i < 768; i += 512) cs_[3072 + i] = sb[i];
        __syncthreads();
    }
    STAMPX(1); for (int u = bid; u < BATCH * 4 * 64; u += G) gdn_local_unit(F, l, u, F.lds);
    STAMPX(2); for (int u = bid; u < BATCH * 2 * 64; u += G) ssd_local_unit(F, l, u, F.lds);
    STAMPX(3); for (int u = bid; u < BATCH * 4 * 64; u += G) mlstm_local_unit(F, l, u, F.lds);
    STAMPX(4); attn_pull(F, l, F.ctl + CW_ATT + (2 * l + 1) * 512, ATT_B, 64);
    STAMPX(5);
}
__device__ __forceinline__ void mixer_phaseB(Frame& F, int l) {
    const int bid = blockIdx.x;
    STAMPX(8);
    if (bid < 32) gdn_chain(F, l, bid >> 2, bid & 3, F.lds);
    else if (bid < 48) ssd_chain(F, l, (bid - 32) >> 1, (bid - 32) & 1, F.lds);
    else if (bid < 80) mlstm_chain(F, l, (bid - 48) >> 2, (bid - 48) & 3, F.lds);
    STAMPX(9);
    attn_pull(F, l, F.ctl + CW_ATT + (2 * l) * 512, 0, ATT_B);
    STAMPX(10);
}
struct Args { const float* in[N_IN]; float* out; unsigned char* ws; int ph_lo, ph_hi, pad0, pad1; };
constexpr int N_SLOTS = 1 + NLAYER * 3 * 5;
__host__ __device__ constexpr bool slot_used(int p) { return p == 0 || ((((p - 1) / 5) % 3) == 1) || (((p - 1) % 5) != 1 && ((p - 1) % 5) != 2); }

__global__ void __launch_bounds__(NWAVES * 64, 2) mk_fwd(Args args) {
    extern __shared__ __attribute__((aligned(16))) unsigned char lds[];
    Frame F;
    F.lds = lds;
    F.MISC = (volatile LAS unsigned*)((LAS unsigned char*)lds + MISC_OFF);
    F.tid = threadIdx.x; F.lane = F.tid & 63; F.wave = __builtin_amdgcn_readfirstlane(F.tid >> 6);
    F.G = gridDim.x; { const int bx = blockIdx.x; F.vcu = (F.G % 8 == 0) ? (bx % 8) * (F.G / 8) + bx / 8 : bx; }
    F.in = args.in; F.out = args.out; F.ws = args.ws;
    F.ctl = (gu32*)(args.ws + WS_CTL);
    for (int u = F.tid; u < (LDS_BYTES - LDSCTL_OFF) / 4; u += NWAVES * 64) ((LAS unsigned*)((LAS unsigned char*)lds + LDSCTL_OFF))[u] = 0u;
    __syncthreads();
    XcdBarrier bar; bar.bar = (unsigned*)(F.ctl + CW_BAR); bar.x = 0; bar.st = nullptr;
    if (N_LAUNCHES == 1) bar = xcd_barrier_post((unsigned*)(F.ctl + CW_BAR), F.MISC + 8);
    const int lo = args.ph_lo, hi = args.ph_hi;
#define IN(k) (lo <= (k) && (k) < hi)
#if PROBE_SEL
    unsigned long long* const tsb = (unsigned long long*)(args.ws + WS_CTL + 512 * 1024);
#define STAMP(slot, which) do { if (F.tid == 0) tsb[((slot) * 2 + (which)) * 256 + blockIdx.x] = __builtin_amdgcn_s_memrealtime(); } while (0)
#else
#define STAMP(slot, which) do { } while (0)
#endif
#define SEAM(k) do { if ((k) + 1 < hi) { if (N_LAUNCHES == 1) xcd_barrier(bar); } } while (0)
    bf16* XN = (bf16*)(F.ws + WS_XN); bf16* Y = (bf16*)(F.ws + WS_Y); bf16* P = (bf16*)(F.ws + WS_P); float* SM = (float*)(F.ws + WS_SM);
    PG8_LAS unsigned char* ring = (PG8_LAS unsigned char*)lds + RING_OFF;

    if (IN(0)) {
        STAMP(0, 0); p0_prologue(F);
        post_rows(F, F.in[I_X], nullptr, 0.f, nullptr, nullptr, F.in[I_F1PRE], XN, false, false, true);
        STAMP(0, 1); SEAM(0);
    }
#define SUBBLOCK(l, sb) do { \
        unsigned char* wl = F.ws + WS_W + (size_t)(l) * W_LAYER; \
        constexpr int base = 1 + ((l) * 3 + (sb)) * 5; \
        if (IN(base)) { STAMP(base, 0); \
            if ((sb) != 1) { \
                pg8::Gemm g{XN, (const bf16*)(wl + ((sb) == 0 ? WL_GU1 : WL_GU2)), M, 2 * FF, D}; pg8::StaticOrder S; S.init(M, 2 * FF, F.G, (int)blockIdx.x); \
                pg8::EpiSwiglu E{P, FF}; \
                pg8::gemm_phase<pg8::EpiSwiglu, pg8::StaticOrder, PG8_ALIGN, PG8_SP2>(ring, g, S, E); \
            } else { \
                pg8::Gemm g{XN, (const bf16*)(wl + WL_IN), M, 4096, D}; pg8::StaticOrder S; S.init(M, 4096, F.G, (int)blockIdx.x); \
                pg8::EpiProj E{P, SM, (const float*)(F.ws + WS_ROPE), (const float*)(F.ws + WS_ROPE) + SEQ * 16}; \
                pg8::gemm_phase<pg8::EpiProj, pg8::StaticOrder, PG8_ALIGN, PG8_SP2>(ring, g, S, E); \
            } \
            STAMP(base, 1); SEAM(base); \
        } \
        if ((sb) == 1 && IN(base + 1)) { STAMP(base + 1, 0); mixer_phaseA(F, (l)); STAMP(base + 1, 1); SEAM(base + 1); } \
        if ((sb) == 1 && IN(base + 2)) { STAMP(base + 2, 0); mixer_phaseB(F, (l)); STAMP(base + 2, 1); SEAM(base + 2); } \
        if (IN(base + 3)) { STAMP(base + 3, 0); \
            const bf16* A = (sb) == 1 ? XN : P; const int K = (sb) == 1 ? D : FF; \
            const bf16* Bt = (const bf16*)(wl + ((sb) == 0 ? WL_D1 : (sb) == 1 ? WL_OUT : WL_D2)); \
            pg8::Gemm g{A, Bt, M, D, K}; pg8::StaticOrder S; S.init(M, D, F.G, (int)blockIdx.x); \
            pg8::EpiBf16<0> E{Y, D, nullptr, 0, 0, 1.f}; \
            pg8::gemm_phase<pg8::EpiBf16<0>, pg8::StaticOrder, PG8_ALIGN, PG8_SP2>(ring, g, S, E); \
            STAMP(base + 3, 1); SEAM(base + 3); \
        } \
        if (IN(base + 4)) { STAMP(base + 4, 0); \
            const float* xsrc = ((l) == 0 && (sb) == 0) ? F.in[I_X] : F.out; \
            const float* gpost = F.in[(sb) == 0 ? I_F1POST : (sb) == 1 ? I_MIXPOST : I_F2POST] + (l) * D; \
            constexpr bool last = ((l) == NLAYER - 1 && (sb) == 2); \
            const float* gpre = (sb) == 0 ? F.in[I_MIXPRE] + (l) * D : (sb) == 1 ? F.in[I_F2PRE] + (l) * D : F.in[I_F1PRE] + (last ? 0 : ((l) + 1) * D); \
            post_rows(F, xsrc, Y, (sb) == 1 ? 1.0f : 0.5f, gpost, F.out, gpre, XN, true, true, !last); \
            STAMP(base + 4, 1); SEAM(base + 4); \
        } } while (0)
    SUBBLOCK(0, 0); SUBBLOCK(0, 1); SUBBLOCK(0, 2); SUBBLOCK(1, 0); SUBBLOCK(1, 1); SUBBLOCK(1, 2);
#undef SUBBLOCK
#if PROBE_SEL
    if (N_LAUNCHES == 1) {
        asm volatile("s_waitcnt vmcnt(0)" ::: "memory");
        xcd_barrier(bar);
        if (blockIdx.x == 0 && F.tid == 0) {
            unsigned long long total = 0;
            for (int p = 0; p < N_SLOTS; ++p) {
                if (!slot_used(p)) continue;
                const int k = (p == 0) ? -1 : (p - 1) % 5; bool sel = false; int wsel = -1;
                if (PROBE_SEL == 1) sel = (k == 0 || k == 3);
                if (PROBE_SEL == 2) sel = (k == 1);
                if (PROBE_SEL == 3) sel = (k == 2);
                if (PROBE_SEL == 4) sel = (k == 4 || k == -1);
                if (PROBE_SEL == 5) { sel = (k == 2); wsel = 0; }
                if (PROBE_SEL == 6) { sel = (k == 2); wsel = 32; }
                if (PROBE_SEL == 7) { sel = (k == 2); wsel = 48; }
                if (PROBE_SEL == 8) { sel = (k == 2); wsel = 80; }
                if (!sel) continue;
                unsigned long long mn = ~0ull, mx = 0ull;
                for (int wg = 0; wg < (int)gridDim.x; ++wg) { if (wsel >= 0 && wg != wsel) continue;
                    const unsigned long long s = __hip_atomic_load(&tsb[(p * 2 + 0) * 256 + wg], RLX_AGENT), e2 = __hip_atomic_load(&tsb[(p * 2 + 1) * 256 + wg], RLX_AGENT);
                    mn = s < mn ? s : mn; mx = e2 > mx ? e2 : mx; }
                total += mx - mn;
            }
            if (PROBE_SEL == 99) { total = __hip_atomic_load(&tsb[(64 + PROBE_B) * 256 + PROBE_WG], RLX_AGENT) - __hip_atomic_load(&tsb[(64 + PROBE_A) * 256 + PROBE_WG], RLX_AGENT); }
            if (PROBE_SEL >= 10 && PROBE_SEL < 14) { total = __hip_atomic_load(&tsb[(64 + PROBE_SEL - 10 + 1) * 256 + 0], RLX_AGENT) - __hip_atomic_load(&tsb[(64 + PROBE_SEL - 10) * 256 + 0], RLX_AGENT); }
            const unsigned long long t0 = __builtin_amdgcn_s_memrealtime();
            while (__builtin_amdgcn_s_memrealtime() - t0 < total * PROBE_MULT) __builtin_amdgcn_s_sleep(8);
        }
    }
#endif
#undef IN
#undef SEAM
}

extern "C" void kernel_launch(void* const* d_in, const int* in_sizes, int n_in, void* d_out, int out_size, void* d_ws, size_t ws_size, hipStream_t stream) {
    static int grid = 0;
    if (grid == 0) {
        if (n_in != N_IN || in_sizes[0] != M * D || out_size != M * D || ws_size < WS_END) { fprintf(stderr, "kernel_launch: unexpected shapes (n_in %d, in0 %d, out %d, ws %zu); nothing launched\n", n_in, n_in > 0 ? in_sizes[0] : -1, out_size, ws_size); grid = -1; return; }
        int dev = 0, cus = 0, per_cu = 0;
        if (hipGetDevice(&dev) != hipSuccess || hipDeviceGetAttribute(&cus, hipDeviceAttributeMultiprocessorCount, dev) != hipSuccess) { grid = -1; return; }
        if (hipFuncSetAttribute((const void*)mk_fwd, hipFuncAttributeMaxDynamicSharedMemorySize, LDS_BYTES) != hipSuccess) { fprintf(stderr, "kernel_launch: hipFuncSetAttribute failed\n"); grid = -1; return; }
        if (hipOccupancyMaxActiveBlocksPerMultiprocessor(&per_cu, (const void*)mk_fwd, NWAVES * 64, LDS_BYTES) != hipSuccess || per_cu < 1) fprintf(stderr, "kernel_launch: occupancy query reports %d\n", per_cu);
        (void)hipGetLastError();
        grid = cus;
    }
    if (grid < 0) return;
    if (hipMemsetAsync((char*)d_ws + WS_CTL, 0, CTL_ZERO_BYTES, stream) != hipSuccess) return;
    Args a{};
    for (int i = 0; i < N_IN; ++i) a.in[i] = (const float*)d_in[i];
    a.out = (float*)d_out; a.ws = (unsigned char*)d_ws;
    if (N_LAUNCHES == 1) {
        a.ph_lo = 0; a.ph_hi = N_SLOTS;
        hipLaunchKernelGGL(mk_fwd, dim3(grid), dim3(NWAVES * 64), LDS_BYTES, stream, a);
    } else {
        for (int p = 0; p < N_SLOTS; ++p) { if (!slot_used(p)) continue; a.ph_lo = p; a.ph_hi = p + 1;
            hipLaunchKernelGGL(mk_fwd, dim3(grid), dim3(NWAVES * 64), LDS_BYTES, stream, a); }
    }
}
```
